# Optimizing an MI355X kernel written in HIP

```python
import math
import jax
import jax.numpy as jnp
from jax import lax
import numpy as np

D_MODEL = 2048
BATCH = 4
SEQ = 4096
DEPTH = 2

GRID_W = 64
CTX_LEN = 256
N_MOD = 6
N_BRANCH = 3
BRANCH_W = D_MODEL // 2
ML_HEADS = 4
ML_DV = BRANCH_W // ML_HEADS
ML_DQK = ML_DV // 2
ML_CHUNK = 64
MLA_HEADS = 8
MLA_Q_LORA = 512
MLA_KV_LORA = 512
MLA_NOPE = 128
MLA_ROPE = 64
MLA_DV = BRANCH_W // MLA_HEADS
MLA_DQK = MLA_NOPE + MLA_ROPE
ATTN_BLOCK = 128
ROPE_THETA = 10000.0
S5_WIDTH = BRANCH_W
S5_GROUP = 16
S5_GROUPS = S5_WIDTH // S5_GROUP
S5_STATE = 64
D_FF = 4 * D_MODEL
EPS = 1e-6
NEG_BIG = -1e30
IN_SIZES = (ML_HEADS * ML_DQK, ML_HEADS * ML_DQK, ML_HEADS * ML_DV, ML_HEADS * ML_DV, 4 * ML_HEADS, MLA_Q_LORA, MLA_KV_LORA, MLA_ROPE, S5_WIDTH, N_BRANCH * D_MODEL)
D_IN = sum(IN_SIZES)

kernel_name = 'hybrid_mlstm_mla_s5_dit_trunk'


def rms_norm(x, g):
    xf = x.astype(jnp.float32)
    y = xf * lax.rsqrt(jnp.mean(xf * xf, axis=-1, keepdims=True) + EPS)
    return (y * g.astype(jnp.float32)).astype(x.dtype)


def modulate(h, shift, scale):
    return h * (1.0 + scale) + shift


def split_cols(z):
    bounds = np.cumsum(IN_SIZES)[:-1].tolist()
    return jnp.split(z, bounds, axis=-1)


def flip_time(a, direction, axis):
    return jnp.flip(a, axis=axis) if direction == 1 else a


def axial_rope_tables(n_tokens):
    rows = n_tokens // GRID_W
    row = jnp.repeat(jnp.arange(rows, dtype=jnp.float32), GRID_W)
    col = jnp.tile(jnp.arange(GRID_W, dtype=jnp.float32), rows)
    n_freq = MLA_ROPE // 4
    inv_freq = ROPE_THETA ** (-jnp.arange(n_freq, dtype=jnp.float32) / n_freq)
    ang_r = row[:, None] * inv_freq
    ang_c = col[:, None] * inv_freq
    return (jnp.cos(ang_r), jnp.sin(ang_r), jnp.cos(ang_c), jnp.sin(ang_c))


def rotate_half_pairs(x, cos, sin):
    m = x.shape[-1] // 2
    x1, x2 = x[..., :m], x[..., m:]
    c, s = cos[:, None, :], sin[:, None, :]
    return jnp.concatenate([x1 * c - x2 * s, x2 * c + x1 * s], axis=-1)


def axial_rope(x, rope):
    cos_r, sin_r, cos_c, sin_c = rope
    xf = x.astype(jnp.float32)
    half = MLA_ROPE // 2
    out = jnp.concatenate([rotate_half_pairs(xf[..., :half], cos_r, sin_r), rotate_half_pairs(xf[..., half:], cos_c, sin_c)], axis=-1)
    return out.astype(x.dtype)


def mlstm_prep(q, k, v, gates, gate_b):
    b, t, _ = q.shape

    def heads(a, dh):
        return a.reshape(b, t, ML_HEADS, dh).transpose(0, 2, 1, 3).astype(jnp.float32)

    qh = heads(q, ML_DQK) * (ML_DQK ** -0.5)
    kh = heads(k, ML_DQK)
    vh = heads(v, ML_DV)
    g = (gates.reshape(b, t, 4, ML_HEADS).astype(jnp.float32) + gate_b.astype(jnp.float32)).transpose(2, 0, 3, 1)
    log_gates = ((g[0], jax.nn.log_sigmoid(g[1])), (g[2], jax.nn.log_sigmoid(g[3])))
    return qh, kh, vh, log_gates


def mlstm_chunkwise(q, k, v, log_i, log_f, state):
    b, h, t, _ = q.shape
    nc = t // ML_CHUNK

    def chunks(a):
        return jnp.moveaxis(a.reshape(a.shape[:2] + (nc, ML_CHUNK) + a.shape[3:]), 2, 0)

    causal = jnp.tril(jnp.ones((ML_CHUNK, ML_CHUNK), dtype=bool))

    def step(carry, inp):
        c_mat, n_vec, m = carry
        qc, kc, vc, lic, lfc = inp
        cum_f = jnp.cumsum(lfc, axis=-1)
        log_w = jnp.where(causal, cum_f[..., :, None] - cum_f[..., None, :] + lic[..., None, :], NEG_BIG)
        log_inter = cum_f + m[..., None]
        m_t = jnp.maximum(log_inter, jnp.max(log_w, axis=-1))
        w_inter = jnp.exp(log_inter - m_t)
        s = jnp.einsum('bhtd,bhsd->bhts', qc, kc) * jnp.exp(log_w - m_t[..., None])
        num = w_inter[..., None] * jnp.einsum('bhtd,bhdv->bhtv', qc, c_mat) + jnp.einsum('bhts,bhsv->bhtv', s, vc)
        den = w_inter * jnp.einsum('bhtd,bhd->bht', qc, n_vec) + jnp.sum(s, axis=-1)
        h_out = num / jnp.maximum(jnp.abs(den), jnp.exp(-m_t))[..., None]
        log_to_end = cum_f[..., -1:] - cum_f + lic
        m_new = jnp.maximum(cum_f[..., -1] + m, jnp.max(log_to_end, axis=-1))
        decay = jnp.exp(cum_f[..., -1] + m - m_new)
        w_end = jnp.exp(log_to_end - m_new[..., None])
        c_mat = decay[..., None, None] * c_mat + jnp.einsum('bhs,bhsd,bhsv->bhdv', w_end, kc, vc)
        n_vec = decay[..., None] * n_vec + jnp.einsum('bhs,bhsd->bhd', w_end, kc)
        return (c_mat, n_vec, m_new), h_out

    state, hs = lax.scan(step, state, (chunks(q), chunks(k), chunks(v), chunks(log_i), chunks(log_f)))
    hs = jnp.moveaxis(hs, 0, 2).reshape(b, h, t, v.shape[-1])
    return hs, state


def mlstm_bidir(ctx_in, lat_in):
    qc, kc, vc, gc = ctx_in
    qx, kx, vx, gx = lat_in
    b = qx.shape[0]
    h_ctx = jnp.zeros(qc.shape[:3] + (ML_DV,), jnp.float32)
    h_lat = jnp.zeros(qx.shape[:3] + (ML_DV,), jnp.float32)
    for d in range(2):
        state0 = (jnp.zeros((b, ML_HEADS, ML_DQK, ML_DV), jnp.float32), jnp.zeros((b, ML_HEADS, ML_DQK), jnp.float32), jnp.zeros((b, ML_HEADS), jnp.float32))
        hc, state_ctx = mlstm_chunkwise(flip_time(qc, d, 2), flip_time(kc, d, 2), flip_time(vc, d, 2), flip_time(gc[d][0], d, 2), flip_time(gc[d][1], d, 2), state0)
        hx, _ = mlstm_chunkwise(flip_time(qx, d, 2), flip_time(kx, d, 2), flip_time(vx, d, 2), flip_time(gx[d][0], d, 2), flip_time(gx[d][1], d, 2), state_ctx)
        h_ctx = h_ctx + flip_time(hc, d, 2)
        h_lat = h_lat + flip_time(hx, d, 2)
    return h_ctx, h_lat


def mlstm_out(h, o, norm_g):
    b, _, t, _ = h.shape
    hn = rms_norm(h.transpose(0, 2, 1, 3), norm_g).reshape(b, t, ML_HEADS * ML_DV)
    return (hn * jax.nn.sigmoid(o.astype(jnp.float32))).astype(o.dtype)


def mla_qkv(q_a, kv_a, k_pe, qa_g, kva_g, w_uq, w_ukv, qn_g, kn_g, rope):
    b, t, _ = q_a.shape
    q = (rms_norm(q_a, qa_g) @ w_uq).reshape(b, t, MLA_HEADS, MLA_DQK)
    kv = (rms_norm(kv_a, kva_g) @ w_ukv).reshape(b, t, MLA_HEADS, MLA_NOPE + MLA_DV)
    k_pe = jnp.broadcast_to(k_pe[:, :, None, :], (b, t, MLA_HEADS, MLA_ROPE))
    k = jnp.concatenate([kv[..., :MLA_NOPE], k_pe], axis=-1)
    v = kv[..., MLA_NOPE:]
    q = rms_norm(q, qn_g)
    k = rms_norm(k, kn_g)
    if rope is not None:
        q = jnp.concatenate([q[..., :MLA_NOPE], axial_rope(q[..., MLA_NOPE:], rope)], axis=-1)
        k = jnp.concatenate([k[..., :MLA_NOPE], axial_rope(k[..., MLA_NOPE:], rope)], axis=-1)
    return q, k, v


def attend(q, k, v):
    s = jnp.einsum('bqhd,bkhd->bhqk', q, k).astype(jnp.float32) * (MLA_DQK ** -0.5)
    p = jax.nn.softmax(s, axis=-1).astype(v.dtype)
    return jnp.einsum('bhqk,bkhd->bqhd', p, v)


def latent_attention(q, k_ctx, v_ctx, k_lat, v_lat):
    k = jnp.concatenate([k_ctx, k_lat], axis=1)
    v = jnp.concatenate([v_ctx, v_lat], axis=1)
    b, t, h, d = q.shape
    nb = t // ATTN_BLOCK
    qb = jnp.moveaxis(q.reshape(b, nb, ATTN_BLOCK, h, d), 1, 0)
    out = lax.map(lambda qi: attend(qi, k, v), qb)
    return jnp.moveaxis(out, 0, 1).reshape(b, t, MLA_HEADS * MLA_DV)


def s5_discretize(a_re, a_im, log_dt, b_re, b_im):
    lam = lax.complex(jnp.minimum(a_re.astype(jnp.float32), -1e-4), a_im.astype(jnp.float32))
    dt = jnp.exp(log_dt.astype(jnp.float32))[:, None]
    lam_bar = jnp.exp(lam * dt)
    b_bar = ((lam_bar - 1.0) / lam)[..., None] * lax.complex(b_re.astype(jnp.float32), b_im.astype(jnp.float32))
    return lam_bar, b_bar


def ssm_combine(e1, e2):
    a1, b1 = e1
    a2, b2 = e2
    return a2 * a1, a2 * b1 + b2


def s5_states(u, lam_bar, b_bar, x0):
    bu = jnp.einsum('gnc,btgc->btgn', b_bar, u)
    bu = bu.at[:, 0].add(lam_bar * x0)
    a = jnp.broadcast_to(lam_bar, bu.shape)
    _, xs = lax.associative_scan(ssm_combine, (a, bu), axis=1)
    return xs


def s5_readout(xs, c_mat):
    return jnp.einsum('gcn,btgn->btgc', c_mat, xs).real


def s5_mixer(u_c, u_x, a_re, a_im, log_dt, b_re, b_im, c_re, c_im, d_skip, w_glu, b_glu, with_ctx_out):
    def grouped(u):
        return u.astype(jnp.float32).reshape(u.shape[0], u.shape[1], S5_GROUPS, S5_GROUP)

    uc, ux = grouped(u_c), grouped(u_x)
    dg = d_skip.astype(jnp.float32).reshape(S5_GROUPS, S5_GROUP)
    yx = dg * ux
    yc = dg * uc if with_ctx_out else None
    for d in range(2):
        lam_bar, b_bar = s5_discretize(a_re[d], a_im[d], log_dt[d], b_re[d], b_im[d])
        c_mat = lax.complex(c_re[d].astype(jnp.float32), c_im[d].astype(jnp.float32))
        x0 = jnp.zeros((uc.shape[0], S5_GROUPS, S5_STATE), jnp.complex64)
        xs_c = s5_states(flip_time(uc, d, 1), lam_bar, b_bar, x0)
        xs_x = s5_states(flip_time(ux, d, 1), lam_bar, b_bar, xs_c[:, -1])
        yx = yx + flip_time(s5_readout(xs_x, c_mat), d, 1)
        if with_ctx_out:
            yc = yc + flip_time(s5_readout(xs_c, c_mat), d, 1)

    def glu(y):
        g = jax.nn.gelu(y.reshape(y.shape[0], y.shape[1], S5_WIDTH)).astype(u_x.dtype)
        return g * jax.nn.sigmoid(g @ w_glu + b_glu)

    return glu(yx), (glu(yc) if with_ctx_out else None)


def merge_branches(branches, gate_pre, w_branch, w_out):
    stacked = jnp.stack(branches, axis=-2)
    b, t = stacked.shape[0], stacked.shape[1]
    gates = jax.nn.sigmoid(gate_pre.reshape(b, t, N_BRANCH, D_MODEL).astype(jnp.float32)).astype(stacked.dtype)
    proj = jnp.einsum('btrc,rcd->btrd', stacked, w_branch)
    return jnp.sum(gates * proj, axis=-2) @ w_out


def sq_relu_mlp(h, w1, w2):
    return jnp.square(jax.nn.relu(h @ w1)) @ w2


def token_mixers(hx, hc, w_in, b_in, ml_gate_b, ml_norm_g, mla_qa_g, mla_kva_g, mla_w_uq, mla_w_ukv, mla_qn_g, mla_kn_g, s5_a_re, s5_a_im, s5_log_dt, s5_b_re, s5_b_im, s5_c_re, s5_c_im, s5_d, s5_w_glu, s5_b_glu, w_branch, w_out, rope, with_ctx_out):
    zx = split_cols(hx @ w_in + b_in)
    zc = split_cols(hc @ w_in + b_in)
    ml_c = mlstm_prep(zc[0], zc[1], zc[2], zc[4], ml_gate_b)
    ml_x = mlstm_prep(zx[0], zx[1], zx[2], zx[4], ml_gate_b)
    h_a_c, h_a_x = mlstm_bidir(ml_c, ml_x)
    a_x = mlstm_out(h_a_x, zx[3], ml_norm_g)
    q_c, k_c, v_c = mla_qkv(zc[5], zc[6], zc[7], mla_qa_g, mla_kva_g, mla_w_uq, mla_w_ukv, mla_qn_g, mla_kn_g, None)
    q_x, k_x, v_x = mla_qkv(zx[5], zx[6], zx[7], mla_qa_g, mla_kva_g, mla_w_uq, mla_w_ukv, mla_qn_g, mla_kn_g, rope)
    b_x = latent_attention(q_x, k_c, v_c, k_x, v_x)
    c_x, c_c = s5_mixer(zc[8], zx[8], s5_a_re, s5_a_im, s5_log_dt, s5_b_re, s5_b_im, s5_c_re, s5_c_im, s5_d, s5_w_glu, s5_b_glu, with_ctx_out)
    out_x = merge_branches((a_x, b_x, c_x), zx[9], w_branch, w_out)
    if not with_ctx_out:
        return out_x, None
    a_c = mlstm_out(h_a_c, zc[3], ml_norm_g)
    b_c = attend(q_c, k_c, v_c).reshape(q_c.shape[0], q_c.shape[1], MLA_HEADS * MLA_DV)
    out_c = merge_branches((a_c, b_c, c_c), zc[9], w_branch, w_out)
    return out_x, out_c


def setup_inputs(seed: int = 0) -> dict:
    key = jax.random.key(seed)
    ks = jax.random.split(key, 32)
    f32 = jnp.float32

    def nrm(k, shape, scale):
        return scale * jax.random.normal(k, shape, f32)

    L, D, H = DEPTH, D_MODEL, ML_HEADS
    G, N, GC = S5_GROUPS, S5_STATE, S5_GROUP
    f_bias = jnp.linspace(3.0, 6.0, H, dtype=f32)
    gate_base = jnp.stack([jnp.zeros((H,), f32), f_bias, jnp.zeros((H,), f32), f_bias])
    return {
        'x': nrm(ks[0], (BATCH, SEQ, D), 1.0),
        'c': nrm(ks[1], (BATCH, D), 1.0),
        'ctx': nrm(ks[2], (BATCH, CTX_LEN, D), 1.0),
        'c_ctx': nrm(ks[3], (D,), 1.0),
        'w_mod': nrm(ks[4], (L, D, N_MOD * D), 0.5 * D ** -0.5),
        'b_mod': nrm(ks[5], (L, N_MOD * D), 0.01),
        'norm_g': 1.0 + nrm(ks[6], (L, 2, D), 0.02),
        'w_in': nrm(ks[7], (L, D, D_IN), D ** -0.5),
        'b_in': nrm(ks[8], (L, D_IN), 0.01),
        'ml_gate_b': gate_base[None] + nrm(ks[9], (L, 4, H), 0.1),
        'ml_norm_g': 1.0 + nrm(ks[10], (L, H, ML_DV), 0.02),
        'mla_qa_g': 1.0 + nrm(ks[11], (L, MLA_Q_LORA), 0.02),
        'mla_kva_g': 1.0 + nrm(ks[12], (L, MLA_KV_LORA), 0.02),
        'mla_w_uq': nrm(ks[13], (L, MLA_Q_LORA, MLA_HEADS * MLA_DQK), MLA_Q_LORA ** -0.5),
        'mla_w_ukv': nrm(ks[14], (L, MLA_KV_LORA, MLA_HEADS * (MLA_NOPE + MLA_DV)), MLA_KV_LORA ** -0.5),
        'mla_qn_g': 1.0 + nrm(ks[15], (L, MLA_DQK), 0.02),
        'mla_kn_g': 1.0 + nrm(ks[16], (L, MLA_DQK), 0.02),
        's5_a_re': -0.5 + nrm(ks[17], (L, 2, G, N), 0.01),
        's5_a_im': math.pi * jnp.arange(N, dtype=f32) + nrm(ks[18], (L, 2, G, N), 0.01),
        's5_log_dt': jax.random.uniform(ks[19], (L, 2, G), f32, math.log(1e-3), math.log(1e-1)),
        's5_b_re': nrm(ks[20], (L, 2, G, N, GC), (2.0 * GC) ** -0.5),
        's5_b_im': nrm(ks[21], (L, 2, G, N, GC), (2.0 * GC) ** -0.5),
        's5_c_re': nrm(ks[22], (L, 2, G, GC, N), N ** -0.5),
        's5_c_im': nrm(ks[23], (L, 2, G, GC, N), N ** -0.5),
        's5_d': nrm(ks[24], (L, S5_WIDTH), 1.0),
        's5_w_glu': nrm(ks[25], (L, S5_WIDTH, S5_WIDTH), S5_WIDTH ** -0.5),
        's5_b_glu': nrm(ks[26], (L, S5_WIDTH), 0.01),
        'w_branch': nrm(ks[27], (L, N_BRANCH, BRANCH_W, D), BRANCH_W ** -0.5),
        'w_out': nrm(ks[28], (L, D, D), D ** -0.5),
        'w_ff1': nrm(ks[29], (L, D, D_FF), D ** -0.5),
        'w_ff2': nrm(ks[30], (L, D_FF, D), D_FF ** -0.5),
    }


def reference(x, c, ctx, c_ctx, w_mod, b_mod, norm_g, w_in, b_in, ml_gate_b, ml_norm_g, mla_qa_g, mla_kva_g, mla_w_uq, mla_w_ukv, mla_qn_g, mla_kn_g, s5_a_re, s5_a_im, s5_log_dt, s5_b_re, s5_b_im, s5_c_re, s5_c_im, s5_d, s5_w_glu, s5_b_glu, w_branch, w_out, w_ff1, w_ff2):
    batch = x.shape[0]
    rope = axial_rope_tables(x.shape[1])
    sc = jax.nn.silu(c)
    scc = jax.nn.silu(c_ctx)
    for l in range(DEPTH):
        with_ctx_out = l < DEPTH - 1
        mx = (sc @ w_mod[l] + b_mod[l]).reshape(batch, N_MOD, D_MODEL).transpose(1, 0, 2)[:, :, None, :]
        mc = (scc @ w_mod[l] + b_mod[l]).reshape(N_MOD, 1, 1, D_MODEL)
        hx = modulate(rms_norm(x, norm_g[l, 0]), mx[0], mx[1])
        hc = modulate(rms_norm(ctx, norm_g[l, 0]), mc[0], mc[1])
        out_x, out_c = token_mixers(hx, hc, w_in[l], b_in[l], ml_gate_b[l], ml_norm_g[l], mla_qa_g[l], mla_kva_g[l], mla_w_uq[l], mla_w_ukv[l], mla_qn_g[l], mla_kn_g[l], s5_a_re[l], s5_a_im[l], s5_log_dt[l], s5_b_re[l], s5_b_im[l], s5_c_re[l], s5_c_im[l], s5_d[l], s5_w_glu[l], s5_b_glu[l], w_branch[l], w_out[l], rope, with_ctx_out)
        x = x + mx[2] * out_x
        hx = modulate(rms_norm(x, norm_g[l, 1]), mx[3], mx[4])
        x = x + mx[5] * sq_relu_mlp(hx, w_ff1[l], w_ff2[l])
        if with_ctx_out:
            ctx = ctx + mc[2] * out_c
            hc = modulate(rms_norm(ctx, norm_g[l, 1]), mc[3], mc[4])
            ctx = ctx + mc[5] * sq_relu_mlp(hc, w_ff1[l], w_ff2[l])
    return x
```

```cpp
#include <hip/hip_runtime.h>
#include <hip/hip_cooperative_groups.h>
#include <cstdio>
#include <cstdint>
namespace cg = cooperative_groups;

typedef unsigned short bf16_t;
typedef short bf16x8 __attribute__((ext_vector_type(8)));
typedef float f32x4 __attribute__((ext_vector_type(4)));
typedef float f32x2 __attribute__((ext_vector_type(2)));
typedef unsigned u32x4 __attribute__((ext_vector_type(4)));
typedef unsigned u32x2 __attribute__((ext_vector_type(2)));
#define LAS __attribute__((address_space(3)))
#define GAS __attribute__((address_space(1)))

constexpr int DM = 2048, NB = 4, SEQ = 4096, CTXL = 256, NLAT = NB * SEQ, NCTX = NB * CTXL, MROWS = NLAT + NCTX;
constexpr int DIN = 11344, DFF = 8192;
constexpr int NZ1 = 4352;
constexpr int LDZ = 4096;
constexpr int ZQ = 0, ZK = 512, ZO = 1024, ZQA = 2048, ZKVA = 2560, ZU = 3072;
constexpr int NMISC = 80;
constexpr int MLCH = 128, MLNC = 34;
constexpr int S5NCH = 68, S5COLS = NB * S5NCH;
constexpr float EPS = 1e-6f;

constexpr size_t al256(size_t x) { return (x + 255) & ~(size_t)255; }
constexpr size_t O_WZ1 = 0;
constexpr size_t O_WKV = O_WZ1 + (size_t)NZ1 * DM * 2;
constexpr size_t O_WG = O_WKV + (size_t)1536 * DM * 2;
constexpr size_t O_WUQ = O_WG + (size_t)6144 * DM * 2;
constexpr size_t O_WUKVK = O_WUQ + (size_t)1536 * 512 * 2;
constexpr size_t O_WUKVV = O_WUKVK + (size_t)1024 * 512 * 2;
constexpr size_t O_WGLU = O_WUKVV + (size_t)1024 * 512 * 2;
constexpr size_t O_WBR = O_WGLU + (size_t)1024 * 1024 * 2;
constexpr size_t O_WOUT = O_WBR + (size_t)3 * 2048 * 1024 * 2;
constexpr size_t O_W1 = O_WOUT + (size_t)2048 * 2048 * 2;
constexpr size_t O_W2 = O_W1 + (size_t)8192 * 2048 * 2;
constexpr size_t O_BIAS = O_W2 + (size_t)8192 * 2048 * 2;
constexpr size_t O_T1 = al256(O_BIAS + (size_t)(4352 + 1536 + 6144) * 4);
constexpr size_t O_T2 = O_T1 + (size_t)64 * 256 * 1024 * 2;
constexpr size_t O_KC = O_T2 + (size_t)64 * 1024 * 256 * 2;
constexpr size_t O_LAMP = O_KC + (size_t)64 * 128 * 256 * 2;
constexpr size_t O_BBAR = O_LAMP + (size_t)2 * 64 * 2 * 65 * 64 * 8;
constexpr size_t O_MOD = O_BBAR + (size_t)2 * 64 * 2 * 64 * 16 * 8;
constexpr size_t O_CTXX = al256(O_MOD + (size_t)2 * 5 * 12288 * 4);
constexpr size_t O_MLG = O_CTXX + (size_t)NCTX * DM * 4;
constexpr size_t O_MLN = O_MLG + (size_t)3 * 8 * MROWS * 4;
constexpr size_t O_MLM = O_MLN + (size_t)32 * MLNC * 128 * 4;
constexpr size_t O_HX = al256(O_MLM + (size_t)32 * MLNC * 4);
constexpr size_t O_BR = O_HX + (size_t)MROWS * DM * 2;
constexpr size_t BRSZ = (size_t)MROWS * 1024 * 2;
constexpr size_t O_R1 = O_BR + 3 * BRSZ;
constexpr size_t O_Z1 = O_R1;
constexpr size_t O_MISC = O_Z1 + (size_t)MROWS * LDZ * 2;
constexpr size_t O_KVT = O_MISC + (size_t)MROWS * NMISC * 4;
constexpr size_t O_Q = O_KVT + (size_t)1536 * MROWS * 2;
constexpr size_t O_K = O_Q + (size_t)MROWS * 1536 * 2;
constexpr size_t O_VTA = O_K + (size_t)MROWS * 1536 * 2;
constexpr size_t O_E = O_VTA + (size_t)1024 * MROWS * 2;
constexpr size_t O_X = O_E + (size_t)64 * S5COLS * 256 * 4;
constexpr size_t O_GS = O_X + (size_t)64 * S5COLS * 256 * 2;
constexpr size_t O_END = O_GS + (size_t)MROWS * 1024 * 2;
constexpr size_t O_W2B = O_END;
constexpr size_t O_ROPE = O_W2B + (size_t)8192 * 2048 * 2;
constexpr size_t O_BARW = O_ROPE + 64 * 16 * 8;
constexpr size_t O_END2 = O_BARW + 2 * 16384;
constexpr size_t O_GATES = O_R1;
constexpr size_t O_HID = O_R1;
static_assert(O_GATES + (size_t)MROWS * 6144 * 2 <= O_GS, "gates alias");
static_assert(O_HID + (size_t)MROWS * 8192 * 2 <= O_END, "hidden alias");

__device__ __forceinline__ float bf2f(unsigned u) { return __uint_as_float(u << 16); }
__device__ __forceinline__ unsigned cvt_pk(float lo, float hi) { unsigned r; asm volatile("v_cvt_pk_bf16_f32 %0, %1, %2" : "=v"(r) : "v"(lo), "v"(hi)); return r; }
__device__ __forceinline__ float wave_sum(float v) {
#pragma unroll
    for (int o = 1; o < 64; o <<= 1) v += __shfl_xor(v, o);
    return v;
}
__device__ __forceinline__ float sigmoidf_(float x) { return 1.f / (1.f + __expf(-x)); }
__device__ __forceinline__ f32x4 mfma16(bf16x8 a, bf16x8 b, f32x4 c) { return __builtin_amdgcn_mfma_f32_16x16x32_bf16(a, b, c, 0, 0, 0); }
__device__ __forceinline__ bf16x8 ldg8(const bf16_t* p) { return *(const bf16x8*)p; }
__device__ __forceinline__ void unpack8(bf16x8 v, float* f) {
    const u32x4 w = __builtin_bit_cast(u32x4, v);
    f[0] = __uint_as_float(w.x << 16); f[1] = __uint_as_float(w.x & 0xffff0000u); f[2] = __uint_as_float(w.y << 16); f[3] = __uint_as_float(w.y & 0xffff0000u);
    f[4] = __uint_as_float(w.z << 16); f[5] = __uint_as_float(w.z & 0xffff0000u); f[6] = __uint_as_float(w.w << 16); f[7] = __uint_as_float(w.w & 0xffff0000u);
}
__device__ __forceinline__ bf16x8 pack8(const float* f) { u32x4 w; w.x = cvt_pk(f[0], f[1]); w.y = cvt_pk(f[2], f[3]); w.z = cvt_pk(f[4], f[5]); w.w = cvt_pk(f[6], f[7]); return __builtin_bit_cast(bf16x8, w); }

__device__ __forceinline__ int ltid() { int t = threadIdx.x; asm volatile("" : "+v"(t)); return t; }
__device__ __forceinline__ int lidx(int i) { asm volatile("" : "+s"(i)); return i; }
template <class T> __device__ __forceinline__ T* lptr(GAS T* p) { asm volatile("" : "+s"(p)); return (T*)p; }
__device__ __forceinline__ const float* gin(GAS const float* p) { return (const float*)p; }
__device__ __forceinline__ int vbid() { const int G = lidx((int)gridDim.x), b = lidx((int)blockIdx.x); return (G % 8 == 0) ? (b % 8) * (G / 8) + b / 8 : b; }
namespace pg8 {
constexpr int BM = 256, BK = 64, HALF = 128, HTB = HALF * BK * 2, STAGE_BYTES = 8 * HTB, NXCD = 8, WGM = 8;
__host__ __device__ __forceinline__ int lds_byte(int r, int c) { const int st = (r >> 4) * 2 + (c >> 5), rr = r & 15, cc = c & 31, ob = rr * 64 + cc * 2; return st * 1024 + (ob ^ (((ob >> 9) & 1) << 5)); }
__host__ __device__ __forceinline__ void stage_rc(int b, int& R, int& C) { const int st = b / 1024, sb = b % 1024, swz = sb ^ (((sb >> 9) & 1) << 5); R = (st >> 1) * 16 + swz / 64; C = (st & 1) * 32 + (swz % 64) / 2; }
__host__ __device__ __forceinline__ int perm32(int rho) { const int n = rho >> 4, i = rho & 15; return 8 * (i >> 2) + 4 * n + (i & 3); }
struct Unit { int pm, pn, r; };
struct Gemm { const bf16_t* A; const bf16_t* Bt; int lda, ldb, K; size_t rsA, rsB; };
template <int NR> struct Order {
    int nM, nN, nwg, G, c;
    __device__ void init(int M, int N, int G_, int c_) { nM = M / BM; nN = N / BM; nwg = nM * nN; G = G_; c = c_; }
    __device__ bool next(int i, Unit& u) const {
        const int ti = i / NR; u.r = i - ti * NR;
        const long L = (long)ti * G + c; if (L >= nwg) return false;
        int wgid = (int)L; { const int q = nwg / NXCD, r = nwg % NXCD, xcd = wgid % NXCD, off = wgid / NXCD; wgid = (xcd < r ? xcd * (q + 1) : r * (q + 1) + (xcd - r) * q) + off; }
        const int nig = WGM * nN, gid = wgid / nig, fm = gid * WGM, gsz = (nM - fm) < WGM ? (nM - fm) : WGM;
        u.pm = fm + ((wgid % nig) % gsz); u.pn = (wgid % nig) / gsz; return true;
    }
};
template <class F> struct Epi {
    F f;
    __device__ __forceinline__ void operator()(const f32x4 (&acc)[2][2][4][2], const Unit& u, int wr, int wc, int fr, int fq) const {
        typename F::Pre pre[2];
        const int row0 = u.pm * BM + wr * 64 + fr, col0 = u.pn * BM + wc * 32 + 8 * fq;
#pragma unroll
        for (int bj = 0; bj < 2; ++bj) f.pre(u.r, row0, col0 + bj * HALF, pre[bj]);
#pragma unroll
        for (int ai = 0; ai < 2; ++ai)
#pragma unroll
            for (int m2 = 0; m2 < 4; m2 += 2) {
                typename F::Aux ax[2][2];
#pragma unroll
                for (int mm = 0; mm < 2; ++mm)
#pragma unroll
                    for (int bj = 0; bj < 2; ++bj) f.ld(u.r, row0 + ai * HALF + (m2 + mm) * 16, col0 + bj * HALF, ax[mm][bj]);
                __builtin_amdgcn_sched_barrier(0);
#pragma unroll
                for (int mm = 0; mm < 2; ++mm)
#pragma unroll
                    for (int bj = 0; bj < 2; ++bj) f.st(u.r, row0 + ai * HALF + (m2 + mm) * 16, col0 + bj * HALF, acc[ai][bj][m2 + mm][0], acc[ai][bj][m2 + mm][1], pre[bj], ax[mm][bj]);
                __builtin_amdgcn_sched_barrier(0);
            }
    }
};

template <class EpiT, class Sched>
__device__ __forceinline__ void gemm_phase(LAS unsigned char* lds, const Gemm g, const Sched& S, const EpiT& E) {
    const int tid = ltid(), wid = __builtin_amdgcn_readfirstlane(tid >> 6), lane = tid & 63, wr = wid >> 2, wc = wid & 3, fr = lane & 15, fq = lane >> 4;
    const int K = g.K, nt = K / BK;
    unsigned voffA[2], voffB[2];
#pragma unroll
    for (int i = 0; i < 2; ++i) { int R, C; stage_rc(tid * 16 + i * 8192, R, C); const int Rb = (R & ~31) + perm32(R & 31);
        voffA[i] = (unsigned)(R * g.lda + C) * 2u; voffB[i] = (unsigned)(Rb * g.ldb + C) * 2u; }
    const size_t kstep = (size_t)(BK * 2);
    const size_t hstepA = (size_t)HALF * g.lda * 2, hstepB = (size_t)HALF * g.ldb * 2;
    const size_t tstepA = 2 * hstepA, tstepB = 2 * hstepB;
    const unsigned ldsw = (unsigned)wid * 1024u;
    const int aoff = lds_byte(wr * 64 + fr, fq * 8), boff = lds_byte(wc * 32 + fr, fq * 8);
#define PG8_SA(b, h) (((b) * 2 + (h)) * HTB)
#define PG8_SB(b, h) ((4 + (b) * 2 + (h)) * HTB)
#define PG8_STAGE(bufoff, gbase, voff) do { _Pragma("unroll") for (int _i = 0; _i < 2; ++_i) \
        __builtin_amdgcn_global_load_lds((const unsigned*)((const char*)(gbase) + (voff)[_i]), (LAS unsigned*)(lds + (bufoff) + ldsw + _i * 8192), 16, 0, 0); } while (0)
#define PG8_LDA(dst, b, h) do { _Pragma("unroll") for (int m = 0; m < 4; ++m) _Pragma("unroll") for (int k = 0; k < 2; ++k) dst[m][k] = *(const LAS bf16x8*)(lds + PG8_SA(b, h) + aoff + m * 2048 + k * 1024); } while (0)
#define PG8_LDB(dst, b, h) do { _Pragma("unroll") for (int n = 0; n < 2; ++n) _Pragma("unroll") for (int k = 0; k < 2; ++k) dst[n][k] = *(const LAS bf16x8*)(lds + PG8_SB(b, h) + boff + n * 2048 + k * 1024); } while (0)
#define PG8_MMA(ai, bj, At, Bt) do { __builtin_amdgcn_s_setprio(1); _Pragma("unroll") for (int m = 0; m < 4; ++m) _Pragma("unroll") for (int n = 0; n < 2; ++n) _Pragma("unroll") for (int k = 0; k < 2; ++k) \
        acc[ai][bj][m][n] = __builtin_amdgcn_mfma_f32_16x16x32_bf16(Bt[n][k], At[m][k], acc[ai][bj][m][n], 0, 0, 0); __builtin_amdgcn_s_setprio(0); } while (0)
#define PG8_WAIT_V(n) asm volatile("s_waitcnt vmcnt(" #n ")" ::: "memory")
#define PG8_WAIT_L(n) asm volatile("s_waitcnt lgkmcnt(" #n ")" ::: "memory")
#define PG8_BAR __builtin_amdgcn_s_barrier()
#define PG8_SCHED __builtin_amdgcn_sched_barrier(0)
    Unit cur, nxt; int ui = 0;
    if (!S.next(0, cur)) return;
    f32x4 acc[2][2][4][2];
#pragma unroll
    for (int a = 0; a < 2; ++a)
#pragma unroll
        for (int b = 0; b < 2; ++b)
#pragma unroll
            for (int m = 0; m < 4; ++m)
#pragma unroll
                for (int n = 0; n < 2; ++n) acc[a][b][m][n] = (f32x4){0.f, 0.f, 0.f, 0.f};
    bf16x8 At[4][2], B0[2][2], B1[2][2];
    const char* cA = (const char*)g.A + (size_t)cur.pm * tstepA + (size_t)cur.r * g.rsA * 2; const char* cB = (const char*)g.Bt + (size_t)cur.pn * tstepB + (size_t)cur.r * g.rsB * 2;
    PG8_STAGE(PG8_SB(0, 0), cB, voffB); PG8_STAGE(PG8_SB(0, 1), cB + hstepB, voffB); PG8_STAGE(PG8_SA(0, 0), cA, voffA); PG8_STAGE(PG8_SA(0, 1), cA + hstepA, voffA);
    if (wr == 1) PG8_BAR;
    PG8_WAIT_V(2); PG8_BAR;
    PG8_STAGE(PG8_SB(1, 0), cB + kstep, voffB); PG8_STAGE(PG8_SA(1, 0), cA + kstep, voffA); PG8_STAGE(PG8_SB(1, 1), cB + hstepB + kstep, voffB);
    PG8_WAIT_V(6); PG8_BAR;
    for (;;) {
        const bool has_next = S.next(ui + 1, nxt);
        const char* nA = has_next ? (const char*)g.A + (size_t)nxt.pm * tstepA + (size_t)nxt.r * g.rsA * 2 : cA; const char* nB = has_next ? (const char*)g.Bt + (size_t)nxt.pn * tstepB + (size_t)nxt.r * g.rsB * 2 : cB;
        for (int t = 0; t < nt; t += 2) {
            const bool last = (t == nt - 2);
            const char* a1 = cA + (size_t)(t + 1) * kstep;
            const char* a2 = last ? nA : cA + (size_t)(t + 2) * kstep; const char* b2 = last ? nB : cB + (size_t)(t + 2) * kstep;
            const char* a3 = a2 + kstep; const char* b3 = b2 + kstep;
            PG8_LDB(B0, 0, 0); PG8_LDB(B1, 0, 1); PG8_SCHED; PG8_LDA(At, 0, 0); PG8_STAGE(PG8_SA(1, 1), a1 + hstepA, voffA);
            PG8_WAIT_V(8); PG8_WAIT_L(0); PG8_BAR; PG8_MMA(0, 0, At, B0); PG8_MMA(0, 1, At, B1); PG8_BAR; PG8_SCHED;
            PG8_LDA(At, 0, 1); PG8_STAGE(PG8_SB(0, 0), b2, voffB); PG8_STAGE(PG8_SB(0, 1), b2 + hstepB, voffB); PG8_STAGE(PG8_SA(0, 0), a2, voffA);
            PG8_WAIT_V(8); PG8_WAIT_L(0); PG8_BAR; PG8_MMA(1, 0, At, B0); PG8_MMA(1, 1, At, B1); PG8_BAR; PG8_SCHED;
            PG8_LDB(B0, 1, 0); PG8_LDB(B1, 1, 1); PG8_SCHED; PG8_LDA(At, 1, 0); PG8_STAGE(PG8_SA(0, 1), a2 + hstepA, voffA);
            PG8_WAIT_V(8); PG8_WAIT_L(0); PG8_BAR; PG8_MMA(0, 0, At, B0); PG8_MMA(0, 1, At, B1); PG8_BAR; PG8_SCHED;
            PG8_LDA(At, 1, 1); PG8_STAGE(PG8_SB(1, 0), b3, voffB); PG8_STAGE(PG8_SB(1, 1), b3 + hstepB, voffB); PG8_STAGE(PG8_SA(1, 0), a3, voffA);
            PG8_WAIT_V(8); PG8_WAIT_L(0); PG8_BAR; PG8_MMA(1, 0, At, B0); PG8_MMA(1, 1, At, B1); PG8_BAR; PG8_SCHED;
        }
        if (wr == 0) PG8_BAR;
        E(acc, cur, wr, wc, fr, fq);
        if (!has_next) break;
#pragma unroll
        for (int a = 0; a < 2; ++a)
#pragma unroll
            for (int b = 0; b < 2; ++b)
#pragma unroll
                for (int m = 0; m < 4; ++m)
#pragma unroll
                    for (int n = 0; n < 2; ++n) acc[a][b][m][n] = (f32x4){0.f, 0.f, 0.f, 0.f};
        cur = nxt; cA = nA; cB = nB; ++ui;
        if (wr == 1) PG8_BAR;
    }
    PG8_WAIT_V(0);
    PG8_BAR;
#undef PG8_SA
#undef PG8_SB
#undef PG8_STAGE
#undef PG8_LDA
#undef PG8_LDB
#undef PG8_MMA
#undef PG8_WAIT_V
#undef PG8_WAIT_L
#undef PG8_BAR
#undef PG8_SCHED
}
}
__device__ __forceinline__ void st_bf16x8(bf16_t* p, f32x4 v0, f32x4 v1) { u32x4 w; w.x = cvt_pk(v0[0], v0[1]); w.y = cvt_pk(v0[2], v0[3]); w.z = cvt_pk(v1[0], v1[1]); w.w = cvt_pk(v1[2], v1[3]); *(u32x4*)p = w; }
struct NoAux {};
struct ColBias { f32x4 b0, b1; };
struct FZ1 { bf16_t* z1; float* misc; const float* b1; typedef ColBias Pre; typedef NoAux Aux;
    __device__ __forceinline__ void pre(int, int, int col, Pre& p) const { p.b0 = *(const f32x4*)(b1 + col); p.b1 = *(const f32x4*)(b1 + col + 4); }
    __device__ __forceinline__ void ld(int, int, int, Aux&) const {}
    __device__ __forceinline__ void st(int, int row, int col, f32x4 v0, f32x4 v1, const Pre& p, const Aux&) const {
        v0 += p.b0; v1 += p.b1;
        if (col < LDZ) st_bf16x8(z1 + (size_t)row * LDZ + col, v0, v1);
        else { const int c = col - LDZ; if (c < NMISC) { float* q = misc + (size_t)row * NMISC + c; *(f32x4*)q = v0; *(f32x4*)(q + 4) = v1; } }
    } };
struct RowB { float b; };
struct FRowBias { bf16_t* o; int ld_; const float* bias; typedef NoAux Pre; typedef RowB Aux;
    __device__ __forceinline__ void pre(int, int, int, Pre&) const {}
    __device__ __forceinline__ void ld(int, int row, int, Aux& x) const { x.b = bias ? bias[row] : 0.f; }
    __device__ __forceinline__ void st(int, int row, int col, f32x4 v0, f32x4 v1, const Pre&, const Aux& x) const { v0 += x.b; v1 += x.b; st_bf16x8(o + (size_t)row * ld_ + col, v0, v1); } };
struct FGate { bf16_t* o; const float* bg; typedef ColBias Pre; typedef NoAux Aux;
    __device__ __forceinline__ void pre(int, int, int col, Pre& p) const { p.b0 = *(const f32x4*)(bg + col); p.b1 = *(const f32x4*)(bg + col + 4); }
    __device__ __forceinline__ void ld(int, int, int, Aux&) const {}
    __device__ __forceinline__ void st(int, int row, int col, f32x4 v0, f32x4 v1, const Pre& p, const Aux&) const {
        v0 += p.b0; v1 += p.b1;
#pragma unroll
        for (int i = 0; i < 4; ++i) { v0[i] = sigmoidf_(v0[i]); v1[i] = sigmoidf_(v1[i]); }
        st_bf16x8(o + (size_t)row * 6144 + col, v0, v1);
    } };
struct FPlain { bf16_t* o; int ld_; typedef NoAux Pre; typedef NoAux Aux;
    __device__ __forceinline__ void pre(int, int, int, Pre&) const {}
    __device__ __forceinline__ void ld(int, int, int, Aux&) const {}
    __device__ __forceinline__ void st(int, int row, int col, f32x4 v0, f32x4 v1, const Pre&, const Aux&) const { st_bf16x8(o + (size_t)row * ld_ + col, v0, v1); } };
struct FKn { bf16_t* o; typedef NoAux Pre; typedef NoAux Aux;
    __device__ __forceinline__ void pre(int, int, int, Pre&) const {}
    __device__ __forceinline__ void ld(int, int, int, Aux&) const {}
    __device__ __forceinline__ void st(int, int row, int col, f32x4 v0, f32x4 v1, const Pre&, const Aux&) const { const int h = col >> 7, d = col & 127; st_bf16x8(o + (size_t)row * 1536 + h * 192 + d, v0, v1); } };
struct Vec8 { bf16x8 v; };
struct FGlu { bf16_t* o; const bf16_t* g; const float* bias; typedef ColBias Pre; typedef Vec8 Aux;
    __device__ __forceinline__ void pre(int, int, int col, Pre& p) const { p.b0 = *(const f32x4*)(bias + col); p.b1 = *(const f32x4*)(bias + col + 4); }
    __device__ __forceinline__ void ld(int, int row, int col, Aux& x) const { x.v = ldg8(g + (size_t)row * 1024 + col); }
    __device__ __forceinline__ void st(int, int row, int col, f32x4 v0, f32x4 v1, const Pre& p, const Aux& x) const {
        float gv[8]; unpack8(x.v, gv);
        v0 += p.b0; v1 += p.b1;
#pragma unroll
        for (int i = 0; i < 4; ++i) { v0[i] = gv[i] * sigmoidf_(v0[i]); v1[i] = gv[4 + i] * sigmoidf_(v1[i]); }
        st_bf16x8(o + (size_t)row * 1024 + col, v0, v1);
    } };
struct Vec8x2 { bf16x8 g, p; };
struct FMerge { bf16_t* o; const bf16_t* gates; typedef NoAux Pre; typedef Vec8x2 Aux;
    __device__ __forceinline__ void pre(int, int, int, Pre&) const {}
    __device__ __forceinline__ void ld(int r, int row, int col, Aux& x) const { x.g = ldg8(gates + (size_t)row * 6144 + r * 2048 + col); if (r > 0) x.p = ldg8(o + (size_t)row * DM + col); }
    __device__ __forceinline__ void st(int r, int row, int col, f32x4 v0, f32x4 v1, const Pre&, const Aux& x) const {
        float gv[8]; unpack8(x.g, gv);
#pragma unroll
        for (int i = 0; i < 4; ++i) { v0[i] *= gv[i]; v1[i] *= gv[4 + i]; }
        if (r > 0) { float pv[8]; unpack8(x.p, pv);
#pragma unroll
            for (int i = 0; i < 4; ++i) { v0[i] += pv[i]; v1[i] += pv[4 + i]; } }
        st_bf16x8(o + (size_t)row * DM + col, v0, v1);
    } };
struct X8 { f32x4 x0, x1; };
struct FResid { const float* xin_l; const float* xin_c; float* xout_l; float* xout_c; const float* modl; int gi; typedef ColBias Pre; typedef X8 Aux;
    __device__ __forceinline__ void pre(int, int row0, int col, Pre& p) const { const int mr = row0 < NLAT ? (row0 >> 12) : 4; const float* gp = modl + (size_t)mr * 12288 + gi * DM + col; p.b0 = *(const f32x4*)gp; p.b1 = *(const f32x4*)(gp + 4); }
    __device__ __forceinline__ void ld(int, int row, int col, Aux& x) const { const float* xi = row < NLAT ? xin_l + (size_t)row * DM : xin_c + (size_t)(row - NLAT) * DM; x.x0 = *(const f32x4*)(xi + col); x.x1 = *(const f32x4*)(xi + col + 4); }
    __device__ __forceinline__ void st(int, int row, int col, f32x4 v0, f32x4 v1, const Pre& p, const Aux& x) const {
        float* xo = row < NLAT ? xout_l + (size_t)row * DM : xout_c + (size_t)(row - NLAT) * DM;
        *(f32x4*)(xo + col) = x.x0 + p.b0 * v0; *(f32x4*)(xo + col + 4) = x.x1 + p.b1 * v1;
    } };
struct FFF1 { bf16_t* o; typedef NoAux Pre; typedef NoAux Aux;
    __device__ __forceinline__ void pre(int, int, int, Pre&) const {}
    __device__ __forceinline__ void ld(int, int, int, Aux&) const {}
    __device__ __forceinline__ void st(int, int row, int col, f32x4 v0, f32x4 v1, const Pre&, const Aux&) const {
#pragma unroll
        for (int i = 0; i < 4; ++i) { const float a = fmaxf(v0[i], 0.f), b = fmaxf(v1[i], 0.f); v0[i] = a * a; v1[i] = b * b; }
        st_bf16x8(o + (size_t)row * DFF + col, v0, v1);
    } };

struct Args { GAS const float* in[31]; GAS float* out; GAS unsigned char* ws; int ph_lo, ph_hi, sub, bar_region; };
enum { I_X = 0, I_C, I_CTX, I_CCTX, I_WMOD, I_BMOD, I_NORMG, I_WIN, I_BIN, I_MLGB, I_MLNG, I_QAG, I_KVAG, I_WUQ, I_WUKV, I_QNG, I_KNG,
       I_ARE, I_AIM, I_LOGDT, I_BRE, I_BIM, I_CRE, I_CIM, I_S5D, I_WGLU, I_BGLU, I_WBR, I_WOUT, I_FF1, I_FF2 };

__device__ __forceinline__ int seq_row(int b, int pos) { return pos < CTXL ? NLAT + b * CTXL + pos : b * SEQ + (pos - CTXL); }

__device__ __forceinline__ void tr_item(const float* W, int ld, int K, int nblk, bf16_t* WT, int mode, float* scr, int item, int lane) {
    const int kb = item / nblk, nb = item % nblk, k0 = 64 * kb, n0 = 32 * nb;
    float tv[32];
#pragma unroll
    for (int i = 0; i < 32; ++i) { const int kk = 2 * i + (lane >> 5); tv[i] = W[(size_t)(k0 + kk) * ld + n0 + (lane & 31)]; }
    __builtin_amdgcn_sched_barrier(0);
#pragma unroll
    for (int i = 0; i < 32; ++i) { const int kk = 2 * i + (lane >> 5); scr[kk * 33 + (lane & 31)] = tv[i]; }
    asm volatile("s_waitcnt lgkmcnt(0)" ::: "memory");
    const int c = lane & 7;
    int drow0 = n0;
    if (mode == 1) { const int h = n0 >> 8, w = n0 & 255; drow0 = (w < 128) ? (h * 128 + w) : (1024 + h * 128 + (w - 128)); }
#pragma unroll
    for (int j = 0; j < 4; ++j) { const int n = (lane >> 3) + 8 * j; const float* s = scr + (8 * c) * 33 + n;
        u32x4 o; o.x = cvt_pk(s[0 * 33], s[1 * 33]); o.y = cvt_pk(s[2 * 33], s[3 * 33]); o.z = cvt_pk(s[4 * 33], s[5 * 33]); o.w = cvt_pk(s[6 * 33], s[7 * 33]);
        *(u32x4*)(WT + (size_t)(drow0 + n) * K + k0 + 8 * c) = o; }
    asm volatile("s_waitcnt lgkmcnt(0)" ::: "memory");
}
#define TR_JOB(Wp, ld, K, ncols, WTp, mode) do { const int _nblk = (ncols) / 32, _nit = ((K) / 64) * _nblk; \
    for (int it = gw; it < _nit; it += NGW) tr_item((Wp), (ld), (K), _nblk, (WTp), (mode), scr, it, lane); } while (0)

__device__ __forceinline__ void norm_mod_rows(const float* xl, const float* xc, const float* ng, const float* modl, int si, bf16_t* out, int nrows, int gw, int NGW, int lane) {
    for (int row = gw; row < nrows; row += NGW) {
        const float* xr; int mr;
        if (row < NLAT) { xr = xl + (size_t)row * DM; mr = row >> 12; } else { xr = xc + (size_t)(row - NLAT) * DM; mr = 4; }
        f32x4 v[8]; float s = 0.f;
#pragma unroll
        for (int j = 0; j < 8; ++j) { v[j] = *(const f32x4*)(xr + 256 * j + 4 * lane); s += v[j][0] * v[j][0] + v[j][1] * v[j][1] + v[j][2] * v[j][2] + v[j][3] * v[j][3]; }
        const float rs = rsqrtf(wave_sum(s) * (1.f / DM) + EPS);
        const float* sh = modl + (size_t)mr * 12288 + si * DM; const float* sc = sh + DM;
#pragma unroll
        for (int jh = 0; jh < 8; jh += 4) {
            f32x4 g4[4], a4[4], b4[4];
#pragma unroll
            for (int j = 0; j < 4; ++j) { const int c = 256 * (jh + j) + 4 * lane; g4[j] = *(const f32x4*)(ng + c); a4[j] = *(const f32x4*)(sh + c); b4[j] = *(const f32x4*)(sc + c); }
            __builtin_amdgcn_sched_barrier(0);
#pragma unroll
            for (int j = 0; j < 4; ++j) { const int c = 256 * (jh + j) + 4 * lane; f32x4 y;
#pragma unroll
                for (int e = 0; e < 4; ++e) y[e] = v[jh + j][e] * rs * g4[j][e] * (1.f + b4[j][e]) + a4[j][e];
                u32x2 w; w.x = cvt_pk(y[0], y[1]); w.y = cvt_pk(y[2], y[3]); *(u32x2*)(out + (size_t)row * DM + c) = w; }
        }
    }
}
__device__ __forceinline__ void phase0(const Args& a, unsigned char* ws, float* sm, int tid) {
    const int w = tid >> 6, lane = tid & 63;
    float* sl = sm;
    float* red = sm + 5 * 2048;
    for (int i = tid; i < 5 * 2048; i += 512) { const float c = i < 4 * 2048 ? gin(a.in[lidx(I_C)])[i] : gin(a.in[lidx(I_CCTX)])[i - 4 * 2048]; sl[i] = c * sigmoidf_(c); }
    __syncthreads();
    float* mod = (float*)(ws + O_MOD);
    for (int u = vbid(); u < 384; u += lidx((int)gridDim.x)) {
        const int l = u / 192, j = (u % 192) * 64 + lane;
        const float* W = gin(a.in[lidx(I_WMOD)]) + (size_t)l * DM * 12288 + j;
        float acc[5] = {0.f, 0.f, 0.f, 0.f, 0.f};
#pragma unroll 1
        for (int k0 = w * 256; k0 < w * 256 + 256; k0 += 16) { float wv[16];
#pragma unroll
            for (int i = 0; i < 16; ++i) wv[i] = W[(size_t)(k0 + i) * 12288];
            __builtin_amdgcn_sched_barrier(0);
#pragma unroll
            for (int i = 0; i < 16; ++i)
#pragma unroll
                for (int r = 0; r < 5; ++r) acc[r] += sl[r * 2048 + k0 + i] * wv[i]; }
#pragma unroll
        for (int r = 0; r < 5; ++r) red[(w * 5 + r) * 64 + lane] = acc[r];
        __syncthreads();
        if (tid < 320) { const int r = tid >> 6; float s = 0.f;
#pragma unroll
            for (int ww = 0; ww < 8; ++ww) s += red[(ww * 5 + r) * 64 + lane];
            mod[(size_t)(l * 5 + r) * 12288 + j] = s + gin(a.in[lidx(I_BMOD)])[l * 12288 + j]; }
        __syncthreads();
    }
    { f32x2* rope = (f32x2*)(ws + O_ROPE); const int gt0 = lidx((int)blockIdx.x) * 512 + tid;
      if (gt0 < 1024) { const int f = gt0 & 15, pos = gt0 >> 4; float sn, cs; sincosf((float)pos * exp2f(-(float)f * (13.287712379549449f / 16.f)), &sn, &cs); rope[gt0] = (f32x2){cs, sn}; } }
    f32x2* lamp = (f32x2*)(ws + O_LAMP); f32x2* bbar = (f32x2*)(ws + O_BBAR);
    const int gt = lidx((int)blockIdx.x) * 512 + tid, gs = lidx((int)gridDim.x) * 512;
    for (int idx = gt; idx < 2 * 64 * 2 * 65 * 64; idx += gs) {
        const int n = idx & 63, p = (idx >> 6) % 65, rest = idx / (64 * 65), dir = rest & 1, g = (rest >> 1) & 63, l = rest >> 7;
        const int si = ((l * 2 + dir) * 64 + g) * 64 + n;
        const float re = fminf(gin(a.in[lidx(I_ARE)])[si], -1e-4f), im = gin(a.in[lidx(I_AIM)])[si], dt = expf(gin(a.in[lidx(I_LOGDT)])[(l * 2 + dir) * 64 + g]);
        const float mag = expf((float)p * (re * dt)); float s, c; sincosf((float)p * (im * dt), &s, &c);
        lamp[idx] = (f32x2){mag * c, mag * s};
    }
    for (int idx = gt; idx < 2 * 64 * 2 * 64 * 16; idx += gs) {
        const int ci = idx & 15, n = (idx >> 4) & 63, dir = (idx >> 10) & 1, g = (idx >> 11) & 63, l = idx >> 17;
        const int si = ((l * 2 + dir) * 64 + g) * 64 + n;
        const float re = fminf(gin(a.in[lidx(I_ARE)])[si], -1e-4f), im = gin(a.in[lidx(I_AIM)])[si], dt = expf(gin(a.in[lidx(I_LOGDT)])[(l * 2 + dir) * 64 + g]);
        const float mag = expf(re * dt); float s, c; sincosf(im * dt, &s, &c);
        const float nr = mag * c - 1.f, ni = mag * s, d = re * re + im * im;
        const float qr = (nr * re + ni * im) / d, qi = (ni * re - nr * im) / d;
        const float br = gin(a.in[lidx(I_BRE)])[(size_t)si * 16 + ci], bi = gin(a.in[lidx(I_BIM)])[(size_t)si * 16 + ci];
        bbar[idx] = (f32x2){qr * br - qi * bi, qr * bi + qi * br};
    }
}

__device__ __forceinline__ void phaseA(const Args& a, unsigned char* ws, unsigned char* smraw, int l, const float* xl, const float* xc, int tid, int mode, int boff, int nb) {
    const int wave = tid >> 6, lane = tid & 63;
    const int vb_ = lidx((int)blockIdx.x) - boff;
    const int gw = vb_ * 8 + wave, NGW = nb * 8;
    float* scr = (float*)(smraw + wave * 16384);
    const float* win = gin(a.in[lidx(I_WIN)]) + (size_t)l * DM * DIN;
    bf16_t* Wz1 = (bf16_t*)(ws + O_WZ1); bf16_t* Wkv = (bf16_t*)(ws + O_WKV);
    {
        constexpr int NJ = 17;
        constexpr int cum[NJ + 1] = {0, 512, 1024, 2048, 3072, 4096, 4160, 5696, 11840, 12224, 12736, 13248, 14272, 15296, 16320, 18368, 26560, 34752};
        const int it_lo = 0, it_hi = mode == 2 ? 0 : cum[NJ];
        for (int it = it_lo + gw; it < it_hi; it += NGW) {
            int j = 0;
#pragma unroll
            for (int k = 1; k < NJ; ++k) j += (it >= cum[k]) ? 1 : 0;
            int base = 0;
#pragma unroll
            for (int k = 1; k < NJ; ++k) base = (j == k) ? cum[k] : base;
            const float* W; int ld, K, ncols, mode = 0; bf16_t* WT;
            if (j < 8) { ld = DIN; K = DM;
                const int so[8] = {0, 512, 2048, 3088, 4176, 4112, 512, 5200}; const int nc[8] = {512, 512, 1024, 1024, 1024, 64, 1536, 6144}; const int dr[6] = {0, 512, 1024, 2048, 3072, 4096};
                int sof = 0, ncl = 0, dro = 0;
#pragma unroll
                for (int k = 0; k < 8; ++k) { sof = (j == k) ? so[k] : sof; ncl = (j == k) ? nc[k] : ncl; }
#pragma unroll
                for (int k = 0; k < 6; ++k) dro = (j == k) ? dr[k] : dro;
                W = win + sof; ncols = ncl; WT = j < 6 ? Wz1 + (size_t)dro * DM : (j == 6 ? Wkv : (bf16_t*)(ws + O_WG)); }
            else if (j == 8) { W = gin(a.in[lidx(I_WUQ)]) + (size_t)l * 512 * 1536; ld = 1536; K = 512; ncols = 1536; WT = (bf16_t*)(ws + O_WUQ); }
            else if (j == 9) { W = gin(a.in[lidx(I_WUKV)]) + (size_t)l * 512 * 2048; ld = 2048; K = 512; ncols = 2048; WT = (bf16_t*)(ws + O_WUKVK); mode = 1; }
            else if (j == 10) { W = gin(a.in[lidx(I_WGLU)]) + (size_t)l * 1024 * 1024; ld = 1024; K = 1024; ncols = 1024; WT = (bf16_t*)(ws + O_WGLU); }
            else if (j < 14) { const int r = j - 11; W = gin(a.in[lidx(I_WBR)]) + ((size_t)l * 3 + r) * 1024 * 2048; ld = 2048; K = 1024; ncols = 2048; WT = (bf16_t*)(ws + O_WBR) + (size_t)r * 2048 * 1024; }
            else if (j == 14) { W = gin(a.in[lidx(I_WOUT)]) + (size_t)l * DM * DM; ld = DM; K = DM; ncols = DM; WT = (bf16_t*)(ws + O_WOUT); }
            else if (j == 15) { W = gin(a.in[lidx(I_FF1)]) + (size_t)l * DM * DFF; ld = DFF; K = DM; ncols = DFF; WT = (bf16_t*)(ws + O_W1); }
            else { W = gin(a.in[lidx(I_FF2)]) + (size_t)l * DFF * DM; ld = DM; K = DFF; ncols = DM; WT = (bf16_t*)(ws + (l == 0 ? O_W2 : O_W2B)); }
            tr_item(W, ld, K, ncols / 32, WT, mode, scr, it - base, lane);
        }
    }
    const int gt = vb_ * 512 + tid, gs = nb * 512;
    if (mode != 2) {
    for (int idx = gt; idx < 192 * DM; idx += gs) { const int r = idx / DM, k = idx % DM;
        const float v = r < 16 ? win[(size_t)k * DIN + 3072 + r] : 0.f; Wz1[(size_t)(4160 + r) * DM + k] = (bf16_t)(cvt_pk(v, 0.f) & 0xffffu); }
    { float* b1 = (float*)(ws + O_BIAS); float* bkv = b1 + 4352; float* bg = bkv + 1536; const float* bin = gin(a.in[lidx(I_BIN)]) + (size_t)l * DIN;
      for (int i = gt; i < 4352; i += gs) { int src = -1;
          if (i < 1024) src = i; else if (i < 2048) src = 2048 + (i - 1024); else if (i < 3072) src = 3088 + (i - 2048); else if (i < 4096) src = 4176 + (i - 3072);
          else if (i < 4160) src = 4112 + (i - 4096); else if (i < 4176) src = 3072 + (i - 4160);
          b1[i] = src >= 0 ? bin[src] : 0.f; }
      for (int i = gt; i < 1536; i += gs) bkv[i] = bin[512 + i];
      for (int i = gt; i < 6144; i += gs) bg[i] = bin[5200 + i]; }
    const f32x2* lamp = (const f32x2*)(ws + O_LAMP) + (size_t)l * 64 * 2 * 65 * 64; const f32x2* bbar = (const f32x2*)(ws + O_BBAR) + (size_t)l * 64 * 2 * 64 * 16;
    bf16_t* T1 = (bf16_t*)(ws + O_T1); bf16_t* T2 = (bf16_t*)(ws + O_T2); bf16_t* KC = (bf16_t*)(ws + O_KC);
    for (int idx = gt; idx < 64 * 16 * 32 * 64; idx += gs) {
        const int ln = idx & 63, ks = (idx >> 6) & 31, rbk = (idx >> 11) & 15, g = idx >> 15;
        const int row = rbk * 16 + (ln & 15), k0 = 32 * ks + 8 * (ln >> 4);
        const int dir = row >> 7, n = (row >> 1) & 63, reim = row & 1, j = k0 >> 4, ci0 = k0 & 15;
        const int p = dir ? j : 63 - j;
        const f32x2 lp = lamp[((g * 2 + dir) * 65 + p) * 64 + n];
        const f32x2* bb = bbar + ((size_t)(g * 2 + dir) * 64 + n) * 16 + ci0;
        float v[8];
#pragma unroll
        for (int e = 0; e < 8; ++e) { const f32x2 b = bb[e]; v[e] = reim ? (lp.x * b.y + lp.y * b.x) : (lp.x * b.x - lp.y * b.y); }
        *(bf16x8*)(T1 + (size_t)g * 256 * 1024 + (size_t)idx % (16 * 32 * 64) * 8) = pack8(v);
    }
    for (int idx = gt; idx < 64 * 64 * 16 * 2 * 16; idx += gs) {
        const int co = idx & 15, q_ = (idx >> 4) & 3, ksl = (idx >> 6) & 3, dir = (idx >> 8) & 1, t = (idx >> 9) & 63, g = idx >> 15, nq = ksl * 4 + q_;
        const int p = dir ? 64 - t : t + 1, n0 = 4 * nq;
        const f32x4 cr = *(const f32x4*)(gin(a.in[lidx(I_CRE)]) + ((size_t)((l * 2 + dir) * 64 + g) * 16 + co) * 64 + n0), ci4 = *(const f32x4*)(gin(a.in[lidx(I_CIM)]) + ((size_t)((l * 2 + dir) * 64 + g) * 16 + co) * 64 + n0);
        const f32x2* lpp = lamp + ((g * 2 + dir) * 65 + p) * 64 + n0;
        float v[8];
#pragma unroll
        for (int e = 0; e < 4; ++e) { const f32x2 lp = lpp[e]; v[2 * e] = cr[e] * lp.x - ci4[e] * lp.y; v[2 * e + 1] = -(cr[e] * lp.y + ci4[e] * lp.x); }
        *(bf16x8*)(T2 + (size_t)g * 1024 * 256 + (size_t)((t * 8 + dir * 4 + (nq >> 2)) * 64 + (nq & 3) * 16 + co) * 8) = pack8(v);
    }
    { f32x2* lps = (f32x2*)smraw; float* ex = (float*)(smraw + 2 * 32 * 64 * 8);
      for (int u = vb_; u < 128; u += nb) {
        const int g = u >> 1, ph = u & 1;
        __syncthreads();
        for (int i = tid; i < 2 * 32 * 64; i += 512) { const int n = i & 63, pp = (i >> 6) & 31, dir = i >> 11; lps[i] = lamp[((g * 2 + dir) * 65 + 32 * ph + pp) * 64 + n]; }
        __syncthreads();
        const int pair = tid & 255, co = pair >> 4, ci = pair & 15, dir = tid >> 8;
        const float* cre = gin(a.in[lidx(I_CRE)]) + ((size_t)((l * 2 + dir) * 64 + g) * 16 + co) * 64; const float* cim = gin(a.in[lidx(I_CIM)]) + ((size_t)((l * 2 + dir) * 64 + g) * 16 + co) * 64;
        const f32x2* bb = bbar + ((size_t)(g * 2 + dir) * 64) * 16 + ci;
        float acc[32];
#pragma unroll
        for (int pp = 0; pp < 32; ++pp) acc[pp] = 0.f;
        for (int n = 0; n < 64; ++n) {
            const f32x2 b = bb[n * 16]; const float cr = cre[n], cm = cim[n];
            const float xr = cr * b.x - cm * b.y, xi = cr * b.y + cm * b.x;
            const f32x2* lq = lps + dir * 2048 + n;
#pragma unroll
            for (int pp = 0; pp < 32; ++pp) { const f32x2 lp = lq[pp * 64]; acc[pp] += xr * lp.x - xi * lp.y; }
        }
        if (ph == 0 && dir == 1) ex[pair] = acc[0];
        __syncthreads();
        bf16_t* kc = KC + (size_t)g * 128 * 256 + pair;
#pragma unroll
        for (int pp = 0; pp < 32; ++pp) {
            const int p = 32 * ph + pp;
            if (p == 0) { if (dir == 0) { const float v = acc[0] + ex[pair] + (co == ci ? gin(a.in[lidx(I_S5D)])[l * 1024 + g * 16 + co] : 0.f); kc[63 * 256] = (bf16_t)(cvt_pk(v, 0.f) & 0xffffu); kc[127 * 256] = 0; } }
            else kc[(dir == 0 ? 63 + p : 63 - p) * 256] = (bf16_t)(cvt_pk(acc[pp], 0.f) & 0xffffu);
        }
      }
      __syncthreads(); }
    }
    if (mode != 1) {
    norm_mod_rows(xl, xc, gin(a.in[lidx(I_NORMG)]) + (size_t)(l * 2 + 0) * DM, (const float*)(ws + O_MOD) + (size_t)l * 5 * 12288, 0, (bf16_t*)(ws + O_HX), MROWS, gw, NGW, lane);
    }
}

__device__ __forceinline__ void mla_norm(const Args& a, unsigned char* ws, int l, int gw, int NGW, int lane) {
    bf16_t* z1 = (bf16_t*)(ws + O_Z1);
    for (int it = gw; it < MROWS * 2; it += NGW) {
        const int row = it >> 1, which = it & 1;
        bf16_t* p = z1 + (size_t)row * LDZ + (which ? ZKVA : ZQA) + lane * 8;
        float v[8]; unpack8(*(const bf16x8*)p, v);
        float s = 0.f;
#pragma unroll
        for (int e = 0; e < 8; ++e) s += v[e] * v[e];
        const float rs = rsqrtf(wave_sum(s) * (1.f / 512.f) + EPS);
        const float* g = (which ? gin(a.in[lidx(I_KVAG)]) : gin(a.in[lidx(I_QAG)])) + l * 512 + lane * 8;
#pragma unroll
        for (int e = 0; e < 8; ++e) v[e] = v[e] * rs * g[e];
        *(bf16x8*)p = pack8(v);
    }
}
__device__ __forceinline__ float logsigmoidf_(float x) { return fminf(x, 0.f) - log1pf(__expf(-fabsf(x))); }
__device__ __forceinline__ float scan_add_incl(float v, int lane) {
#pragma unroll
    for (int o = 1; o < 64; o <<= 1) { const float t = __shfl_up(v, o); if (lane >= o) v += t; }
    return v;
}
__device__ __forceinline__ float scan_max_incl(float v, int lane) {
#pragma unroll
    for (int o = 1; o < 64; o <<= 1) { const float t = __shfl_up(v, o); if (lane >= o) v = fmaxf(v, t); }
    return v;
}
__device__ __forceinline__ void ml_state_pass(const Args& a, unsigned char* ws, float* sm, int l, int tid) {
    const int w = tid >> 6, lane = tid & 63, cidx = lane & 15, q = lane >> 4;
    const float* misc = (const float*)(ws + O_MISC); const bf16_t* KVt = (const bf16_t*)(ws + O_KVT);
    bf16_t* Cst = (bf16_t*)(ws + O_BR + BRSZ); float* MLG = (float*)(ws + O_MLG); float* MLN = (float*)(ws + O_MLN); float* MLM = (float*)(ws + O_MLM);
    float* wsh = sm + w * 128;
    constexpr int SP = 136, BUFB = (128 + 32) * SP * 2 + 1024;
    unsigned char* sbase = (unsigned char*)sm + 4096;
#define MLS_ROW0(ci_) ({ const int _oc = dir == 0 ? (ci_) : ((ci_) < 2 ? 1 - (ci_) : 35 - (ci_)); _oc < 2 ? NLAT + b * CTXL + _oc * MLCH : b * SEQ + (_oc - 2) * MLCH; })
#define MLS_LOAD(ci_) do { const int _r0 = MLS_ROW0(ci_); \
        _Pragma("unroll") for (int k = 0; k < 4; ++k) { const int c = tid + 512 * k, r = c >> 4, cc = c & 15; kreg[k] = *(const u32x4*)(KVt + (size_t)(h * 128 + r) * MROWS + _r0 + cc * 8); } \
        { const int r = tid >> 4, cc = tid & 15; vreg = *(const u32x4*)(KVt + (size_t)(512 + h * 256 + slice * 32 + r) * MROWS + _r0 + cc * 8); } \
        greg = 0.f; if (tid < 256) greg = misc[(size_t)(_r0 + (tid & 127)) * NMISC + 64 + (dir * 2 + (tid >> 7)) * 4 + h]; } while (0)
#define MLS_STORE(buf_) do { unsigned char* _b = sbase + (buf_) * BUFB; \
        _Pragma("unroll") for (int k = 0; k < 4; ++k) { const int c = tid + 512 * k, r = c >> 4, cc = c & 15; *(u32x4*)(_b + (r * SP + cc * 8) * 2) = kreg[k]; } \
        { const int r = tid >> 4, cc = tid & 15; *(u32x4*)(_b + ((128 + r) * SP + cc * 8) * 2) = vreg; } \
        if (tid < 256) ((float*)(_b + 160 * SP * 2))[tid] = greg; } while (0)
    for (int u = vbid(); u < 256; u += lidx((int)gridDim.x)) {
        const int chain = u >> 3, slice = u & 7, dir = chain & 1, h = (chain >> 1) & 3, b = chain >> 3;
        const float bi = gin(a.in[lidx(I_MLGB)])[l * 16 + (dir * 2 + 0) * 4 + h], bf = gin(a.in[lidx(I_MLGB)])[l * 16 + (dir * 2 + 1) * 4 + h];
        const int i0 = 2 * lane, j0 = dir ? 127 - i0 : i0, j1 = dir ? 126 - i0 : i0 + 1;
        f32x4 acc[2] = {(f32x4){0.f, 0.f, 0.f, 0.f}, (f32x4){0.f, 0.f, 0.f, 0.f}};
        float nv = 0.f, m = 0.f;
        u32x4 kreg[4], vreg; float greg;
        __syncthreads();
        MLS_LOAD(0); __builtin_amdgcn_sched_barrier(0); MLS_STORE(0); __syncthreads();
#pragma unroll 1
        for (int ci = 0; ci < MLNC; ++ci) {
            const int row0 = MLS_ROW0(ci);
            if (ci + 1 < MLNC) MLS_LOAD(ci + 1);
            __builtin_amdgcn_sched_barrier(0);
            const unsigned char* cb_ = sbase + (ci & 1) * BUFB;
            const bf16_t* Ksh = (const bf16_t*)cb_; const bf16_t* Vsh = Ksh + 128 * SP; const float* gs = (const float*)(cb_ + 160 * SP * 2);
            const float li0 = gs[j0] + bi, li1 = gs[j1] + bi;
            const float lf0 = logsigmoidf_(gs[128 + j0] + bf), lf1 = logsigmoidf_(gs[128 + j1] + bf);
            const float S = scan_add_incl(lf0 + lf1, lane);
            const float G1 = S, G0 = S - lf1, a0 = li0 - G0, a1 = li1 - G1;
            const float pmx = scan_max_incl(fmaxf(a0, a1), lane);
            float prev = __shfl_up(pmx, 1); if (lane == 0) prev = -1e30f;
            const float pm0 = fmaxf(prev, a0), pm1 = pmx;
            const float Ftot = __shfl(S, 63), Ac = __shfl(pmx, 63);
            const float Mx = fmaxf(m, Ac), decay = __expf(m - Mx);
            asm volatile("s_waitcnt lgkmcnt(0)" ::: "memory");
            wsh[j0] = __expf(a0 - Mx); wsh[j1] = __expf(a1 - Mx);
            if (slice == 0 && w == 0) { const size_t o = (size_t)(dir * 4 + h) * MROWS + row0;
                MLG[o + j0] = G0; MLG[o + j1] = G1; MLG[(size_t)8 * MROWS + o + j0] = a0; MLG[(size_t)8 * MROWS + o + j1] = a1; MLG[(size_t)16 * MROWS + o + j0] = pm0; MLG[(size_t)16 * MROWS + o + j1] = pm1;
                if (lane == 0) MLM[chain * MLNC + ci] = m; }
            if (slice == 0 && q == 0) MLN[((size_t)chain * MLNC + ci) * 128 + 16 * w + cidx] = nv;
#pragma unroll
            for (int i = 0; i < 2; ++i)
#pragma unroll
                for (int r = 0; r < 4; ++r) Cst[(((size_t)chain * MLNC + ci) * 256 + slice * 32 + 16 * i + 4 * q + r) * 128 + 16 * w + cidx] = (bf16_t)(cvt_pk(acc[i][r], 0.f) & 0xffffu);
            asm volatile("s_waitcnt lgkmcnt(0)" ::: "memory");
            acc[0] *= decay; acc[1] *= decay;
            float nsum = 0.f;
#pragma unroll
            for (int ks = 0; ks < 4; ++ks) {
                const f32x4 w0 = *(const f32x4*)(wsh + 32 * ks + 8 * q), w1 = *(const f32x4*)(wsh + 32 * ks + 8 * q + 4);
                float kf[8]; unpack8(*(const bf16x8*)(Ksh + (16 * w + cidx) * SP + 32 * ks + 8 * q), kf);
#pragma unroll
                for (int e = 0; e < 4; ++e) { kf[e] *= w0[e]; kf[4 + e] *= w1[e]; nsum += kf[e] + kf[4 + e]; }
                const bf16x8 kb = pack8(kf);
#pragma unroll
                for (int i = 0; i < 2; ++i) acc[i] = mfma16(*(const bf16x8*)(Vsh + (16 * i + cidx) * SP + 32 * ks + 8 * q), kb, acc[i]);
            }
            nsum += __shfl_xor(nsum, 16); nsum += __shfl_xor(nsum, 32);
            nv = decay * nv + nsum;
            m = Ftot + Mx;
            __builtin_amdgcn_sched_barrier(0);
            if (ci + 1 < MLNC) MLS_STORE((ci + 1) & 1);
            __syncthreads();
        }
    }
#undef MLS_LOAD
#undef MLS_STORE
#undef MLS_ROW0
    __syncthreads();
}
__device__ __forceinline__ int s5_rowbase(int cc) { const int b = cc / S5NCH, ch = cc - b * S5NCH; const int r1 = NLAT + b * CTXL + ch * 64, r2 = b * SEQ + (ch - 4) * 64; return __builtin_amdgcn_readfirstlane(0) + ((ch < 4) ? r1 : r2); }
constexpr int UPITCH = 1032, XPITCH = 264;
__device__ __forceinline__ void s5_stage_u(const bf16_t* z1, bf16_t* Us, int g, int cb, int tid) {
    u32x4 tmp[4];
#pragma unroll
    for (int i = 0; i < 4; ++i) { const int c = tid + 512 * i, cc = c >> 7, j = (c >> 1) & 63, hf = c & 1;
        const int rowb = s5_rowbase(cb * 16 + cc);
        tmp[i] = *(const u32x4*)(z1 + (size_t)(rowb + j) * LDZ + ZU + g * 16 + 8 * hf); }
    __builtin_amdgcn_sched_barrier(0);
#pragma unroll
    for (int i = 0; i < 4; ++i) { const int c = tid + 512 * i, cc = c >> 7, j = (c >> 1) & 63, hf = c & 1;
        *(u32x4*)(Us + cc * UPITCH + j * 16 + 8 * hf) = tmp[i]; }
}
__device__ __forceinline__ void s5_pass1(unsigned char* ws, unsigned char* sm, int tid) {
    const int w = tid >> 6, lane = tid & 63, cidx = lane & 15, q = lane >> 4;
    const bf16_t* z1 = (const bf16_t*)(ws + O_Z1); const bf16_t* T1 = (const bf16_t*)(ws + O_T1); float* E = (float*)(ws + O_E);
    bf16_t* Us = (bf16_t*)sm;
    for (int u = vbid(); u < 64 * 17; u += lidx((int)gridDim.x)) {
        const int cb = u % 17, g = u / 17;
        __syncthreads();
        s5_stage_u(z1, Us, g, cb, tid);
        __syncthreads();
        f32x4 acc[2] = {(f32x4){0.f, 0.f, 0.f, 0.f}, (f32x4){0.f, 0.f, 0.f, 0.f}};
        const bf16_t* tp = T1 + (size_t)g * 256 * 1024 + (size_t)(2 * w) * 32 * 512 + lane * 8;
        const bf16_t* up = Us + cidx * UPITCH + 8 * q;
#pragma unroll 1
        for (int ks0 = 0; ks0 < 32; ks0 += 8) {
            bf16x8 af[8][2];
#pragma unroll
            for (int i = 0; i < 8; ++i) { af[i][0] = ldg8(tp + 512 * (ks0 + i)); af[i][1] = ldg8(tp + 32 * 512 + 512 * (ks0 + i)); }
            __builtin_amdgcn_sched_barrier(0);
#pragma unroll
            for (int i = 0; i < 8; ++i) { const bf16x8 bfr = *(const bf16x8*)(up + 32 * (ks0 + i)); acc[0] = mfma16(af[i][0], bfr, acc[0]); acc[1] = mfma16(af[i][1], bfr, acc[1]); }
            __builtin_amdgcn_sched_barrier(0);
        }
        const int cc = cb * 16 + cidx;
        *(f32x4*)(E + ((size_t)g * S5COLS + cc) * 256 + (w * 2) * 16 + 4 * q) = acc[0];
        *(f32x4*)(E + ((size_t)g * S5COLS + cc) * 256 + (w * 2 + 1) * 16 + 4 * q) = acc[1];
    }
    __syncthreads();
}
__device__ __forceinline__ void s5_scan(unsigned char* ws, int l, int tid) {
    const f32x2* lamp = (const f32x2*)(ws + O_LAMP) + (size_t)l * 64 * 2 * 65 * 64; const float* E = (const float*)(ws + O_E); bf16_t* X = (bf16_t*)(ws + O_X);
    for (int idx = lidx((int)blockIdx.x) * 512 + tid; idx < 64 * 4 * 2 * 64; idx += lidx((int)gridDim.x) * 512) {
        const int n = idx & 63, dir = (idx >> 6) & 1, b = (idx >> 7) & 3, g = idx >> 9;
        const f32x2 l64 = lamp[((g * 2 + dir) * 65 + 64) * 64 + n];
        float xr = 0.f, xi = 0.f;
#pragma unroll 1
        for (int s0 = 0; s0 < S5NCH; s0 += 17) {
            f32x2 ev[17];
#pragma unroll
            for (int k = 0; k < 17; ++k) { const int step = s0 + k, ch = dir == 0 ? step : (step < 4 ? 3 - step : 71 - step);
                ev[k] = *(const f32x2*)(E + ((size_t)g * S5COLS + b * S5NCH + ch) * 256 + dir * 128 + 2 * n); }
            __builtin_amdgcn_sched_barrier(0);
#pragma unroll
            for (int k = 0; k < 17; ++k) { const int step = s0 + k, ch = dir == 0 ? step : (step < 4 ? 3 - step : 71 - step);
                const size_t o = ((size_t)g * S5COLS + b * S5NCH + ch) * 256 + dir * 128 + 2 * n;
                *(unsigned*)(X + o) = cvt_pk(xr, xi);
                const float nr = l64.x * xr - l64.y * xi + ev[k].x, ni = l64.x * xi + l64.y * xr + ev[k].y; xr = nr; xi = ni; }
        }
    }
}
__device__ __forceinline__ float gelu_tanh(float x) { const float u = 0.7978845608028654f * (x + 0.044715f * x * x * x); return 0.5f * x * (1.f + tanhf(u)); }
__device__ __forceinline__ void s5_pass2(unsigned char* ws, unsigned char* sm, int tid) {
    const int w = tid >> 6, lane = tid & 63, cidx = lane & 15, q = lane >> 4;
    const bf16_t* z1 = (const bf16_t*)(ws + O_Z1); const bf16_t* T2 = (const bf16_t*)(ws + O_T2); const bf16_t* KC = (const bf16_t*)(ws + O_KC); const bf16_t* X = (const bf16_t*)(ws + O_X);
    bf16_t* Gs = (bf16_t*)(ws + O_GS);
    bf16_t* Us = (bf16_t*)sm; bf16_t* Xs = Us + 16 * UPITCH; bf16_t* KCs = Xs + 16 * XPITCH;
    for (int u = vbid(); u < 64 * 17; u += lidx((int)gridDim.x)) {
        const int cb = u % 17, g = u / 17;
        __syncthreads();
        s5_stage_u(z1, Us, g, cb, tid);
        { u32x4 kt[8]; const int cc = tid >> 5, part = tid & 31; const u32x4 xt = *(const u32x4*)(X + ((size_t)g * S5COLS + cb * 16 + cc) * 256 + part * 8);
#pragma unroll
          for (int i = 0; i < 8; ++i) { const int c = tid + 512 * i; kt[i] = *(const u32x4*)(KC + (size_t)g * 128 * 256 + c * 8); }
          __builtin_amdgcn_sched_barrier(0);
          *(u32x4*)(Xs + cc * XPITCH + part * 8) = xt;
#pragma unroll
          for (int i = 0; i < 8; ++i) { const int c = tid + 512 * i; *(u32x4*)(KCs + c * 8) = kt[i]; } }
        __syncthreads();
        f32x4 acc[8];
#pragma unroll
        for (int i = 0; i < 8; ++i) acc[i] = (f32x4){0.f, 0.f, 0.f, 0.f};
        const bf16_t* kp = KCs + (63 - (q >> 1) + 8 * w) * 256 + cidx * 16 + 8 * (q & 1);
        const bf16_t* up = Us + cidx * UPITCH + 8 * q;
#pragma unroll 4
        for (int ks = 0; ks < 32; ++ks) {
            const bf16x8 bfr = *(const bf16x8*)(up + 32 * ks);
#pragma unroll
            for (int tb = 0; tb < 8; ++tb) acc[tb] = mfma16(*(const bf16x8*)(kp + (tb - 2 * ks) * 256), bfr, acc[tb]);
        }
        const bf16_t* xp = Xs + cidx * XPITCH + 8 * q;
        const bf16_t* tp = T2 + (size_t)g * 1024 * 256 + (size_t)(8 * w) * 8 * 512 + lane * 8;
#pragma unroll 1
        for (int ks0 = 0; ks0 < 8; ks0 += 2) {
            bf16x8 af[2][8];
#pragma unroll
            for (int i = 0; i < 2; ++i)
#pragma unroll
                for (int tb = 0; tb < 8; ++tb) af[i][tb] = ldg8(tp + (size_t)tb * 8 * 512 + 512 * (ks0 + i));
            __builtin_amdgcn_sched_barrier(0);
#pragma unroll
            for (int i = 0; i < 2; ++i) { const bf16x8 bfr = *(const bf16x8*)(xp + 32 * (ks0 + i));
#pragma unroll
                for (int tb = 0; tb < 8; ++tb) acc[tb] = mfma16(af[i][tb], bfr, acc[tb]); }
            __builtin_amdgcn_sched_barrier(0);
        }
        const int rowb = s5_rowbase(cb * 16 + cidx);
#pragma unroll
        for (int tb = 0; tb < 8; ++tb) { u32x2 o; o.x = cvt_pk(gelu_tanh(acc[tb][0]), gelu_tanh(acc[tb][1])); o.y = cvt_pk(gelu_tanh(acc[tb][2]), gelu_tanh(acc[tb][3]));
            *(u32x2*)(Gs + (size_t)(rowb + 8 * w + tb) * 1024 + g * 16 + 4 * q) = o; }
    }
    __syncthreads();
}
__device__ __forceinline__ void qk_prep(const Args& a, unsigned char* ws, int l, int gw, int NGW, int lane) {
    const int h = lane >> 3, sub = lane & 7;
    const float* misc = (const float*)(ws + O_MISC);
    for (int it = gw; it < MROWS * 2; it += NGW) {
        const int row = it >> 1, which = it & 1;
        bf16_t* p = (bf16_t*)(ws + (which ? O_K : O_Q)) + (size_t)row * 1536 + h * 192 + 8 * sub;
        const float* gn = (which ? gin(a.in[lidx(I_KNG)]) : gin(a.in[lidx(I_QNG)])) + l * 192 + 8 * sub;
        float v[3][8];
        unpack8(*(const bf16x8*)p, v[0]); unpack8(*(const bf16x8*)(p + 64), v[1]);
        if (which) { const f32x4 k0 = *(const f32x4*)(misc + (size_t)row * NMISC + 8 * sub), k1 = *(const f32x4*)(misc + (size_t)row * NMISC + 8 * sub + 4);
#pragma unroll
            for (int e = 0; e < 4; ++e) { v[2][e] = k0[e]; v[2][4 + e] = k1[e]; } }
        else unpack8(*(const bf16x8*)(p + 128), v[2]);
        float s = 0.f;
#pragma unroll
        for (int j = 0; j < 3; ++j)
#pragma unroll
            for (int e = 0; e < 8; ++e) s += v[j][e] * v[j][e];
        s += __shfl_xor(s, 1); s += __shfl_xor(s, 2); s += __shfl_xor(s, 4);
        const float rs = rsqrtf(s * (1.f / 192.f) + EPS);
#pragma unroll
        for (int j = 0; j < 3; ++j)
#pragma unroll
            for (int e = 0; e < 8; ++e) v[j][e] = v[j][e] * rs * gn[64 * j + e];
        if (row < NLAT) {
            const int t = row & (SEQ - 1);
            const int pos = (sub >> 2) ? (t & 63) : (t >> 6);
            const f32x2* rp = (const f32x2*)(ws + O_ROPE) + pos * 16 + 8 * (sub & 1);
            f32x2 cs8[8];
#pragma unroll
            for (int e = 0; e < 8; ++e) cs8[e] = rp[e];
#pragma unroll
            for (int e = 0; e < 8; ++e) {
                const float partner = __shfl_xor(v[2][e], 2);
                v[2][e] = (sub & 2) ? (v[2][e] * cs8[e].x + partner * cs8[e].y) : (v[2][e] * cs8[e].x - partner * cs8[e].y);
            }
        }
        *(bf16x8*)p = pack8(v[0]); *(bf16x8*)(p + 64) = pack8(v[1]); *(bf16x8*)(p + 128) = pack8(v[2]);
    }
}

__device__ __forceinline__ void ml_out_pass(const Args& a, unsigned char* ws, unsigned char* sm, int l, bool with_ctx, int tid) {
    const int w = tid >> 6, lane = tid & 63, cidx = lane & 15, q = lane >> 4;
    const bf16_t* z1 = (const bf16_t*)(ws + O_Z1); const bf16_t* KVt = (const bf16_t*)(ws + O_KVT); const bf16_t* Cst = (const bf16_t*)(ws + O_BR + BRSZ);
    const float* MLG = (const float*)(ws + O_MLG); const float* MLN = (const float*)(ws + O_MLN); const float* MLM = (const float*)(ws + O_MLM);
    bf16_t* BRa = (bf16_t*)(ws + O_BR);
    constexpr int KP = 136;
    bf16_t* Ks = (bf16_t*)sm; float* As = (float*)(sm + 128 * KP * 2);
    const float scale = 0.08838834764831845f;
    for (int u = vbid(); u < 4 * 4 * MLNC; u += lidx((int)gridDim.x)) {
        const int oc = u % MLNC, h = (u / MLNC) & 3, b = u / (4 * MLNC);
        if (!with_ctx && oc < 2) continue;
        const int row0 = oc < 2 ? NLAT + b * CTXL + oc * MLCH : b * SEQ + (oc - 2) * MLCH;
        const int rb = w, t = 16 * rb + cidx;
        __syncthreads();
        { u32x4 kt[4];
#pragma unroll
          for (int i = 0; i < 4; ++i) { const int c = tid + 512 * i, r = c >> 4, cc = c & 15; kt[i] = *(const u32x4*)(z1 + (size_t)(row0 + r) * LDZ + ZK + h * 128 + cc * 8); }
          float av = 0.f; if (tid < 256) av = MLG[(size_t)(8 + (tid >> 7) * 4 + h) * MROWS + row0 + (tid & 127)];
          __builtin_amdgcn_sched_barrier(0);
#pragma unroll
          for (int i = 0; i < 4; ++i) { const int c = tid + 512 * i, r = c >> 4, cc = c & 15; *(u32x4*)(Ks + r * KP + cc * 8) = kt[i]; }
          if (tid < 256) As[tid] = av; }
        bf16x8 qf[4];
#pragma unroll
        for (int ks = 0; ks < 4; ++ks) qf[ks] = ldg8(z1 + (size_t)(row0 + t) * LDZ + ZQ + h * 128 + 32 * ks + 8 * q);
        __syncthreads();
        bf16x8 pf[2][4]; float inv2[2], wsc2[2];
#pragma unroll
        for (int dir = 0; dir < 2; ++dir) {
            const int chain = (b * 4 + h) * 2 + dir, ci = dir == 0 ? oc : (oc < 2 ? 1 - oc : 35 - oc);
            const float mc = MLM[chain * MLNC + ci];
            const float* Gp = MLG + (size_t)(dir * 4 + h) * MROWS + row0; const float* pp = Gp + (size_t)16 * MROWS;
            const float Gt = Gp[t], Mt = fmaxf(mc, pp[t]);
            f32x4 nq[4][2];
            { const float* np = MLN + ((size_t)chain * MLNC + ci) * 128 + 8 * q;
#pragma unroll
              for (int ks = 0; ks < 4; ++ks) { nq[ks][0] = *(const f32x4*)(np + 32 * ks); nq[ks][1] = *(const f32x4*)(np + 32 * ks + 4); } }
            __builtin_amdgcn_sched_barrier(0);
            const float winter = __expf(mc - Mt);
            float qn = 0.f;
#pragma unroll
            for (int ks = 0; ks < 4; ++ks) { float qv[8]; unpack8(qf[ks], qv);
#pragma unroll
                for (int e = 0; e < 4; ++e) qn += qv[e] * nq[ks][0][e] + qv[4 + e] * nq[ks][1][e]; }
            qn += __shfl_xor(qn, 16); qn += __shfl_xor(qn, 32);
            float rsum = 0.f;
#pragma unroll
            for (int i = 0; i < 4; ++i) {
                float pv[8];
#pragma unroll
                for (int hb = 0; hb < 2; ++hb) {
                    const int kb = 2 * i + hb;
                    const bool skip = dir == 0 ? (kb > rb) : (kb < rb);
                    f32x4 sacc = (f32x4){0.f, 0.f, 0.f, 0.f};
                    if (!(a.sub & 16))
#pragma unroll
                    for (int ks = 0; ks < 4; ++ks) sacc = mfma16(*(const bf16x8*)(Ks + (16 * kb + cidx) * KP + 32 * ks + 8 * q), qf[ks], sacc);
                    const f32x4 a4 = *(const f32x4*)(As + dir * 128 + 16 * kb + 4 * q);
#pragma unroll
                    for (int r = 0; r < 4; ++r) {
                        const int sidx = 16 * kb + 4 * q + r;
                        const bool valid = !skip && (dir == 0 ? (sidx <= t) : (sidx >= t));
                        const float e = __expf(fminf(a4[r] - Mt, 0.f));
                        const float val = valid ? sacc[r] * scale * e : 0.f;
                        pv[hb * 4 + r] = val; rsum += val;
                    }
                }
                pf[dir][i] = pack8(pv);
            }
            rsum += __shfl_xor(rsum, 16); rsum += __shfl_xor(rsum, 32);
            const float den = winter * qn * scale + rsum;
            inv2[dir] = 1.f / fmaxf(fabsf(den), __expf(-(Gt + Mt)));
            wsc2[dir] = winter * scale;
        }
        float ss = 0.f;
        bf16_t* dp = BRa + (size_t)(row0 + t) * 1024 + h * 256 + 4 * q;
        const int ci0 = oc, ci1 = oc < 2 ? 1 - oc : 35 - oc;
        constexpr int SP = 136, SBUF = 64 * SP;
        bf16_t* stg = (bf16_t*)(sm + 36864);
        const bf16_t* cg0 = Cst + ((size_t)((b * 4 + h) * 2 + 0) * MLNC + ci0) * 256 * 128;
        const bf16_t* cg1 = Cst + ((size_t)((b * 4 + h) * 2 + 1) * MLNC + ci1) * 256 * 128;
        const bf16_t* vg = KVt + (size_t)(512 + h * 256) * MROWS + row0;
        u32x4 sreg[6];
#define MLO_SLOAD(s_) do { _Pragma("unroll") for (int k = 0; k < 6; ++k) { const int c = tid + 512 * k, which = c >> 10, idx = c & 1023, r = idx >> 4, cc = idx & 15; \
            const bf16_t* src = which == 0 ? cg0 + (size_t)(64 * (s_) + r) * 128 + cc * 8 : (which == 1 ? cg1 + (size_t)(64 * (s_) + r) * 128 + cc * 8 : vg + (size_t)(64 * (s_) + r) * MROWS + cc * 8); \
            sreg[k] = *(const u32x4*)src; } } while (0)
#define MLO_SSTORE(buf_) do { _Pragma("unroll") for (int k = 0; k < 6; ++k) { const int c = tid + 512 * k, which = c >> 10, idx = c & 1023, r = idx >> 4, cc = idx & 15; \
            *(u32x4*)(stg + (buf_) * 3 * SBUF + which * SBUF + r * SP + cc * 8) = sreg[k]; } } while (0)
        MLO_SLOAD(0); __builtin_amdgcn_sched_barrier(0); MLO_SSTORE(0); __syncthreads();
#pragma unroll 1
        for (int st = 0; st < ((a.sub & 8) ? 0 : 4); ++st) {
            if (st + 1 < 4) MLO_SLOAD(st + 1);
            __builtin_amdgcn_sched_barrier(0);
            const bf16_t* sb = stg + (st & 1) * 3 * SBUF;
#pragma unroll
            for (int d4 = 0; d4 < 4; ++d4) {
                f32x4 hsum = (f32x4){0.f, 0.f, 0.f, 0.f};
                const bf16_t* vrow = sb + 2 * SBUF + (16 * d4 + cidx) * SP + 4 * q;
#pragma unroll
                for (int dir = 0; dir < 2; ++dir) {
                    const bf16_t* crow = sb + dir * SBUF + (16 * d4 + cidx) * SP + 8 * q;
                    f32x4 acc = (f32x4){0.f, 0.f, 0.f, 0.f};
#pragma unroll
                    for (int ks = 0; ks < 4; ++ks) acc = mfma16(*(const bf16x8*)(crow + 32 * ks), qf[ks], acc);
                    acc *= wsc2[dir];
#pragma unroll
                    for (int i = 0; i < 4; ++i) { const u32x2 lo = *(const u32x2*)(vrow + 32 * i), hi = *(const u32x2*)(vrow + 32 * i + 16);
                        const u32x4 av = (u32x4){lo.x, lo.y, hi.x, hi.y}; acc = mfma16(__builtin_bit_cast(bf16x8, av), pf[dir][i], acc); }
                    hsum += acc * inv2[dir];
                }
                ss += hsum[0] * hsum[0] + hsum[1] * hsum[1] + hsum[2] * hsum[2] + hsum[3] * hsum[3];
                u32x2 r_; r_.x = cvt_pk(hsum[0], hsum[1]); r_.y = cvt_pk(hsum[2], hsum[3]); *(u32x2*)(dp + 16 * (4 * st + d4)) = r_;
            }
            __builtin_amdgcn_sched_barrier(0);
            if (st + 1 < 4) MLO_SSTORE((st + 1) & 1);
            __syncthreads();
        }
#undef MLO_SLOAD
#undef MLO_SSTORE
        ss += __shfl_xor(ss, 16); ss += __shfl_xor(ss, 32);
        const float rs = rsqrtf(ss * (1.f / 256.f) + EPS);
        const float* ng = gin(a.in[lidx(I_MLNG)]) + (size_t)l * 1024 + h * 256 + 4 * q;
        const bf16_t* op = z1 + (size_t)(row0 + t) * LDZ + ZO + h * 256 + 4 * q;
#pragma unroll 1
        for (int i0 = 0; i0 < 16; i0 += 4) {
            u32x2 ov[4], hv[4]; f32x4 g4[4];
#pragma unroll
            for (int k = 0; k < 4; ++k) { ov[k] = *(const u32x2*)(op + 16 * (i0 + k)); g4[k] = *(const f32x4*)(ng + 16 * (i0 + k)); hv[k] = *(const u32x2*)(dp + 16 * (i0 + k)); }
            __builtin_amdgcn_sched_barrier(0);
#pragma unroll
            for (int k = 0; k < 4; ++k) {
                const float o0 = __uint_as_float(ov[k].x << 16), o1 = __uint_as_float(ov[k].x & 0xffff0000u), o2 = __uint_as_float(ov[k].y << 16), o3 = __uint_as_float(ov[k].y & 0xffff0000u);
                const float h0 = __uint_as_float(hv[k].x << 16), h1 = __uint_as_float(hv[k].x & 0xffff0000u), h2 = __uint_as_float(hv[k].y << 16), h3 = __uint_as_float(hv[k].y & 0xffff0000u);
                u32x2 r; r.x = cvt_pk(h0 * rs * g4[k][0] * sigmoidf_(o0), h1 * rs * g4[k][1] * sigmoidf_(o1)); r.y = cvt_pk(h2 * rs * g4[k][2] * sigmoidf_(o2), h3 * rs * g4[k][3] * sigmoidf_(o3));
                *(u32x2*)(dp + 16 * (i0 + k)) = r;
            }
        }
    }
    __syncthreads();
}

constexpr int VPITCH = 72, KTILE_B = 64 * 24 * 16, VTILE_B = 128 * VPITCH * 2;
__device__ __forceinline__ void attn_phase(unsigned char* ws, unsigned char* sm, bool with_ctx, int tid) {
    const int w = tid >> 6, lane = tid & 63, cidx = lane & 15, q = lane >> 4;
    const bf16_t* Q = (const bf16_t*)(ws + O_Q); const bf16_t* K = (const bf16_t*)(ws + O_K); const bf16_t* Vt = (const bf16_t*)(ws + O_VTA);
    bf16_t* out = (bf16_t*)(ws + O_BR + BRSZ);
    const float C = 0.07216878364870322f * 1.4426950408889634f;
    const int nunits = 512 + (with_ctx ? 32 : 0);
    for (int u = vbid(); u < nunits; u += lidx((int)gridDim.x)) {
        int b, h, qrow0, ntiles;
        if (u < 512) { b = u >> 7; h = (u >> 4) & 7; qrow0 = b * SEQ + (u & 15) * 256; ntiles = 68; }
        else { const int uu = u - 512; b = uu >> 3; h = uu & 7; qrow0 = NLAT + b * CTXL; ntiles = 4; }
        bf16x8 qf[2][6];
#pragma unroll
        for (int qq = 0; qq < 2; ++qq)
#pragma unroll
            for (int ks = 0; ks < 6; ++ks) qf[qq][ks] = ldg8(Q + (size_t)(qrow0 + 32 * w + 16 * qq + cidx) * 1536 + h * 192 + 32 * ks + 8 * q);
        f32x4 o[8][2];
#pragma unroll
        for (int i = 0; i < 8; ++i) { o[i][0] = (f32x4){0.f, 0.f, 0.f, 0.f}; o[i][1] = (f32x4){0.f, 0.f, 0.f, 0.f}; }
        float mrun[2] = {-1e30f, -1e30f}, lsum[2] = {0.f, 0.f};
        unsigned koff[4], voff[3];
#pragma unroll
        for (int i = 0; i < 3; ++i) { const int L = (w + 8 * i) * 64 + lane, r = L / 24, cl = L - r * 24, cc = cl ^ (r & 7); koff[i] = (unsigned)((r * 1536 + h * 192 + cc * 8) * 2); }
        koff[3] = 0u;
#pragma unroll
        for (int i = 0; i < 3; ++i) { const int c = (w + 8 * i) * 64 + lane, r = c / 9; int cc = c - r * 9; if (cc == 8) cc = 0; voff[i] = (unsigned)(((h * 128 + r) * MROWS + cc * 8) * 2); }
#define ATT_LOAD(j, buf) do { const int _kr = (j) < 4 ? NLAT + b * CTXL + 64 * (j) : b * SEQ + 64 * ((j) - 4); \
        const char* _kg = (const char*)(K + (size_t)_kr * 1536); const char* _vg = (const char*)(Vt + _kr); \
        LAS unsigned char* _kb = (LAS unsigned char*)sm + (buf) * (KTILE_B + VTILE_B); LAS unsigned char* _vb = _kb + KTILE_B; \
        _Pragma("unroll") for (int _i = 0; _i < 3; ++_i) __builtin_amdgcn_global_load_lds((const unsigned*)(_kg + koff[_i]), (LAS unsigned*)(_kb + (w + 8 * _i) * 1024), 16, 0, 0); \
        _Pragma("unroll") for (int _i = 0; _i < 3; ++_i) if (w + 8 * _i < 18) __builtin_amdgcn_global_load_lds((const unsigned*)(_vg + voff[_i]), (LAS unsigned*)(_vb + (w + 8 * _i) * 1024), 16, 0, 0); } while (0)
#define ATT_STORE(buf) do { } while (0)
        ATT_LOAD(0, 0); asm volatile("s_waitcnt vmcnt(0)" ::: "memory"); __syncthreads();
        for (int j = 0; j < ntiles; ++j) {
            if (j + 1 < ntiles) ATT_LOAD(j + 1, (j + 1) & 1);
            const unsigned char* kb_ = sm + (j & 1) * (KTILE_B + VTILE_B); const unsigned char* vb_ = kb_ + KTILE_B;
            f32x4 s[4][2];
#pragma unroll
            for (int kb = 0; kb < 4; ++kb) { s[kb][0] = (f32x4){0.f, 0.f, 0.f, 0.f}; s[kb][1] = (f32x4){0.f, 0.f, 0.f, 0.f};
#pragma unroll
                for (int ks = 0; ks < 6; ++ks) { const bf16x8 af = *(const bf16x8*)(kb_ + ((16 * kb + cidx) * 24 + ((4 * ks + q) ^ (cidx & 7))) * 16);
                    s[kb][0] = mfma16(af, qf[0][ks], s[kb][0]); s[kb][1] = mfma16(af, qf[1][ks], s[kb][1]); } }
            bf16x8 pf[2][2];
#pragma unroll
            for (int qq = 0; qq < 2; ++qq) {
                float mx = fmaxf(fmaxf(s[0][qq][0], s[0][qq][1]), fmaxf(s[0][qq][2], s[0][qq][3]));
#pragma unroll
                for (int kb = 1; kb < 4; ++kb) mx = fmaxf(mx, fmaxf(fmaxf(s[kb][qq][0], s[kb][qq][1]), fmaxf(s[kb][qq][2], s[kb][qq][3])));
                if (!__all(mx - mrun[qq] <= 110.851251684f)) {
                    mx = fmaxf(mx, __shfl_xor(mx, 16)); mx = fmaxf(mx, __shfl_xor(mx, 32));
                    const float mnew = fmaxf(mrun[qq], mx), alpha = __builtin_amdgcn_exp2f((mrun[qq] - mnew) * C);
                    mrun[qq] = mnew; lsum[qq] *= alpha;
#pragma unroll
                    for (int i = 0; i < 8; ++i) o[i][qq] *= alpha;
                }
                const float mc = mrun[qq] * C;
                float ps = 0.f; float pv[4][4];
#pragma unroll
                for (int kb = 0; kb < 4; ++kb)
#pragma unroll
                    for (int r = 0; r < 4; ++r) { pv[kb][r] = __builtin_amdgcn_exp2f(fmaf(s[kb][qq][r], C, -mc)); ps += pv[kb][r]; }
                lsum[qq] += ps;
#pragma unroll
                for (int i = 0; i < 2; ++i) { u32x4 pw; pw.x = cvt_pk(pv[2 * i][0], pv[2 * i][1]); pw.y = cvt_pk(pv[2 * i][2], pv[2 * i][3]); pw.z = cvt_pk(pv[2 * i + 1][0], pv[2 * i + 1][1]); pw.w = cvt_pk(pv[2 * i + 1][2], pv[2 * i + 1][3]);
                    pf[qq][i] = __builtin_bit_cast(bf16x8, pw); }
            }
#pragma unroll
            for (int dvb = 0; dvb < 8; ++dvb)
#pragma unroll
                for (int i = 0; i < 2; ++i) {
                    const unsigned char* vq = vb_ + ((16 * dvb + cidx) * VPITCH + 32 * i + 4 * q) * 2;
                    const u32x2 lo = *(const u32x2*)vq; asm volatile("" ::: "memory"); const u32x2 hi = *(const u32x2*)(vq + 32); asm volatile("" ::: "memory");
                    const bf16x8 af = __builtin_bit_cast(bf16x8, ((u32x4){lo.x, lo.y, hi.x, hi.y}));
                    o[dvb][0] = mfma16(af, pf[0][i], o[dvb][0]); o[dvb][1] = mfma16(af, pf[1][i], o[dvb][1]);
                }
            asm volatile("s_waitcnt vmcnt(0)" ::: "memory");
            __syncthreads();
        }
#pragma unroll
        for (int qq = 0; qq < 2; ++qq) {
            float lt = lsum[qq]; lt += __shfl_xor(lt, 16); lt += __shfl_xor(lt, 32);
            const float inv = 1.f / lt;
            bf16_t* dp = out + (size_t)(qrow0 + 32 * w + 16 * qq + cidx) * 1024 + h * 128 + 4 * q;
#pragma unroll
            for (int dvb = 0; dvb < 8; ++dvb) { u32x2 r; r.x = cvt_pk(o[dvb][qq][0] * inv, o[dvb][qq][1] * inv); r.y = cvt_pk(o[dvb][qq][2] * inv, o[dvb][qq][3] * inv); *(u32x2*)(dp + 16 * dvb) = r; }
        }
    }
#undef ATT_LOAD
#undef ATT_STORE
}


#define XB_TMO      128
#define XB_XCNT(j)  (256  + 64 * (j))
#define XB_XSUB(j)  (1280 + 64 * (j))
#define XB_XGEN(j)  (2304 + 64 * (j))
#define XB_TOP      3328
#define XB_TOPGEN   3392
#define XCD_BAR_WORDS 3456
#define XB_SPIN_CAP (1u << 18)
__device__ __forceinline__ unsigned xb_ld(unsigned* p)              { return __hip_atomic_load(p, __ATOMIC_RELAXED, __HIP_MEMORY_SCOPE_AGENT); }
__device__ __forceinline__ unsigned xb_add(unsigned* p, unsigned v) { return __hip_atomic_fetch_add(p, v, __ATOMIC_RELAXED, __HIP_MEMORY_SCOPE_AGENT); }
__device__ __forceinline__ unsigned xb_xcc_id() { return (unsigned)__builtin_amdgcn_s_getreg((3 << 11) | 20) & 0xFu; }
#define XB_SPIN(cond, bar) do { unsigned _sp = 0; while (cond) { __builtin_amdgcn_s_sleep(1); \
    if ((++_sp & 255u) == 0u) { if (xb_ld(&(bar)[XB_TMO])) break; if (_sp > XB_SPIN_CAP) { atomicAdd(&(bar)[XB_TMO], 1u); break; } } } } while (0)
struct XcdBarrier { unsigned* bar; unsigned x; volatile LAS unsigned* st; };
__device__ __forceinline__ XcdBarrier xcd_barrier_post(unsigned* bar, volatile LAS unsigned* st) {
    XcdBarrier b; b.bar = bar; b.x = xb_xcc_id(); b.st = st;
    if (threadIdx.x == 0) (void)xb_add(&bar[XB_XCNT(b.x)], 1u);
    return b;
}
__device__ __forceinline__ void xcd_barrier_complete(unsigned* bar, unsigned x, unsigned& nloc, unsigned& nx) {
    const unsigned G = gridDim.x * gridDim.y * gridDim.z;
    unsigned sum, cnt, mine, sp = 0u;
    for (;;) {
        sum = 0u; cnt = 0u; mine = 0u;
#pragma unroll
        for (unsigned j = 0; j < 16; ++j) { const unsigned c = xb_ld(&bar[XB_XCNT(j)]); sum += c; cnt += (c > 0u) ? 1u : 0u; mine = (j == x) ? c : mine; }
        if (sum == G) break;
        __builtin_amdgcn_s_sleep(1);
        if ((++sp & 255u) == 0u) { if (xb_ld(&bar[XB_TMO])) break; if (sp > XB_SPIN_CAP) { atomicAdd(&bar[XB_TMO], 1u); break; } }
    }
    nloc = mine > 0u ? mine : 1u; nx = cnt > 0u ? cnt : 1u;
}
__device__ __forceinline__ void xcd_barrier(const XcdBarrier& b) {
    asm volatile("s_waitcnt vmcnt(0)" ::: "memory");
    __syncthreads();
    if (threadIdx.x == 0) {
        unsigned* bar = b.bar;
        __builtin_amdgcn_s_waitcnt(0);
        unsigned nloc = b.st[0], nx = b.st[1];
        if (nloc == 0u) { xcd_barrier_complete(bar, b.x, nloc, nx); b.st[0] = nloc; b.st[1] = nx; }
        const unsigned old = xb_add(&bar[XB_XSUB(b.x)], 1u);
        const unsigned gen = old / nloc;
        if (old + 1u == (gen + 1u) * nloc) {
            __builtin_amdgcn_fence(__ATOMIC_RELEASE, "agent");
            asm volatile("s_waitcnt vmcnt(0)" ::: "memory");
            const unsigned og = xb_add(&bar[XB_TOP], 1u);
            const unsigned tg = og / nx;
            if (og + 1u == (tg + 1u) * nx) xb_add(&bar[XB_TOPGEN], 1u);
            else XB_SPIN(xb_ld(&bar[XB_TOPGEN]) == tg, bar);
            __builtin_amdgcn_fence(__ATOMIC_ACQUIRE, "agent");
            xb_add(&bar[XB_XGEN(b.x)], 1u);
            asm volatile("s_waitcnt vmcnt(0)" ::: "memory");
        } else {
            XB_SPIN(xb_ld(&bar[XB_XGEN(b.x)]) == gen, bar);
            __builtin_amdgcn_fence(__ATOMIC_ACQUIRE, "agent");
            asm volatile("s_waitcnt vmcnt(0)" ::: "memory");
        }
    }
    __syncthreads();
}

constexpr int LDS_BYTES = 147456;
constexpr int NPHASE = 25;
constexpr int PROBE_LO = -1, PROBE_HI = -1, PROBE_SUB = 7;
__global__ void __launch_bounds__(512, 2) mega(Args a) {
    extern __shared__ __attribute__((aligned(16))) unsigned char lds[];
    cg::grid_group grid = cg::this_grid();
    const int NGW = lidx((int)gridDim.x) * 8;
#define tid (ltid())
#define lane (ltid() & 63)
#define gw ((int)(lidx((int)blockIdx.x) * 8 + (ltid() >> 6)))
unsigned char* const wsraw_ = (unsigned char*)a.ws;
#define ws (lptr(a.ws))
    LAS unsigned char* ldsl = (LAS unsigned char*)lds;
    const int lo = a.ph_lo, hi = a.ph_hi;
#define IN(p) ((p) >= lo && (p) < hi)
    volatile LAS unsigned* xst = (volatile LAS unsigned*)(ldsl + LDS_BYTES - 64);
    if (threadIdx.x < 2) xst[threadIdx.x] = 0u;
    __syncthreads();
    const XcdBarrier xbar = xcd_barrier_post((unsigned*)(wsraw_ + O_BARW) + a.bar_region * 4096, xst);
#define SEAM(p) do { if ((p) + 1 < hi) { (void)xbar; grid.sync(); } } while (0)
    if (IN(0)) { phase0(a, ws, (float*)lds, tid); SEAM(0); }
    const int G = lidx((int)gridDim.x), cb = lidx((int)blockIdx.x);
    float* outl = (float*)a.out; float* outc = (float*)(ws + O_CTXX);
#pragma unroll 1
    for (int l = 0; l < 2; ++l) {
        const int P = 1 + 12 * l;
        const bool wctx = (l == 0);
        const int Mlate = wctx ? MROWS : NLAT;
        const float* xl = l == 0 ? gin(a.in[lidx(I_X)]) : outl; const float* xc = l == 0 ? gin(a.in[lidx(I_CTX)]) : outc;
        const float* modl = (const float*)(ws + O_MOD) + (size_t)l * 5 * 12288;
        const bf16_t* HX = (const bf16_t*)(ws + O_HX); const bf16_t* Z1 = (const bf16_t*)(ws + O_Z1);
        if (IN(P + 0)) { phaseA(a, ws, lds, l, xl, xc, tid, (l == 0 || G <= 64) ? 0 : 2, 0, G); SEAM(P + 0); }
        if (IN(P + 1)) {
            { pg8::Gemm g{HX, (const bf16_t*)(ws + O_WZ1), DM, DM, DM, 0, 0}; pg8::Order<1> S; S.init(MROWS, NZ1, G, cb);
              pg8::Epi<FZ1> E{{(bf16_t*)(ws + O_Z1), (float*)(ws + O_MISC), (const float*)(ws + O_BIAS)}};
#ifndef NO_G0
            pg8::gemm_phase(ldsl, g, S, E);
#endif
 }
            { pg8::Gemm g{(const bf16_t*)(ws + O_WKV), HX, DM, DM, DM, 0, 0}; pg8::Order<1> S; S.init(1536, MROWS, G, cb);
              pg8::Epi<FRowBias> E{{(bf16_t*)(ws + O_KVT), MROWS, (const float*)(ws + O_BIAS) + 4352}};
#ifndef NO_G1
            pg8::gemm_phase(ldsl, g, S, E);
#endif
 }
            SEAM(P + 1);
        }
        if (IN(P + 2)) { if (a.sub & 1) mla_norm(a, ws, l, gw, NGW, lane); if (a.sub & 2) s5_pass1(ws, lds, tid); if (a.sub & 4) ml_state_pass(a, ws, (float*)lds, l, tid); SEAM(P + 2); }
        if (IN(P + 3)) {
            { pg8::Gemm g{Z1 + ZQA, (const bf16_t*)(ws + O_WUQ), LDZ, 512, 512, 0, 0}; pg8::Order<1> S; S.init(MROWS, 1536, G, cb);
              pg8::Epi<FPlain> E{{(bf16_t*)(ws + O_Q), 1536}};
#ifndef NO_G2
            pg8::gemm_phase(ldsl, g, S, E);
#endif
 }
            { pg8::Gemm g{Z1 + ZKVA, (const bf16_t*)(ws + O_WUKVK), LDZ, 512, 512, 0, 0}; pg8::Order<1> S; S.init(MROWS, 1024, G, cb);
              pg8::Epi<FKn> E{{(bf16_t*)(ws + O_K)}};
#ifndef NO_G3
            pg8::gemm_phase(ldsl, g, S, E);
#endif
 }
            { pg8::Gemm g{(const bf16_t*)(ws + O_WUKVV), Z1 + ZKVA, 512, LDZ, 512, 0, 0}; pg8::Order<1> S; S.init(1024, MROWS, G, cb);
              pg8::Epi<FRowBias> E{{(bf16_t*)(ws + O_VTA), MROWS, nullptr}};
#ifndef NO_G4
            pg8::gemm_phase(ldsl, g, S, E);
#endif
 }
            s5_scan(ws, l, tid);
            SEAM(P + 3);
        }
        if (IN(P + 4)) { if (a.sub & 1) qk_prep(a, ws, l, gw, NGW, lane); if (a.sub & 2) s5_pass2(ws, lds, tid); if (a.sub & 4) ml_out_pass(a, ws, lds, l, wctx, tid); SEAM(P + 4); }
        if (IN(P + 5)) {
            attn_phase(ws, lds, wctx, tid);
            { pg8::Gemm g{(const bf16_t*)(ws + O_GS), (const bf16_t*)(ws + O_WGLU), 1024, 1024, 1024, 0, 0}; pg8::Order<1> S; S.init(Mlate, 1024, G, cb);
              pg8::Epi<FGlu> E{{(bf16_t*)(ws + O_BR + 2 * BRSZ), (const bf16_t*)(ws + O_GS), gin(a.in[lidx(I_BGLU)]) + l * 1024}};
#ifndef NO_G5
            pg8::gemm_phase(ldsl, g, S, E);
#endif
 }
            SEAM(P + 5);
        }
        if (IN(P + 6)) {
            pg8::Gemm g{HX, (const bf16_t*)(ws + O_WG), DM, DM, DM, 0, 0}; pg8::Order<1> S; S.init(Mlate, 6144, G, cb);
            pg8::Epi<FGate> E{{(bf16_t*)(ws + O_GATES), (const float*)(ws + O_BIAS) + 4352 + 1536}};
#ifndef NO_G6
            pg8::gemm_phase(ldsl, g, S, E);
#endif

            SEAM(P + 6);
        }
        if (IN(P + 7)) {
            pg8::Gemm g{(const bf16_t*)(ws + O_BR), (const bf16_t*)(ws + O_WBR), 1024, 1024, 1024, (size_t)MROWS * 1024, (size_t)2048 * 1024}; pg8::Order<3> S; S.init(Mlate, DM, G, cb);
            pg8::Epi<FMerge> E{{(bf16_t*)(ws + O_HX), (const bf16_t*)(ws + O_GATES)}};
#ifndef NO_G7
            pg8::gemm_phase(ldsl, g, S, E);
#endif

            SEAM(P + 7);
        }
        if (IN(P + 8)) {
            pg8::Gemm g{HX, (const bf16_t*)(ws + O_WOUT), DM, DM, DM, 0, 0}; pg8::Order<1> S; S.init(Mlate, DM, G, cb);
            pg8::Epi<FResid> E{{xl, xc, outl, outc, modl, 2}};
#ifndef NO_G8
            pg8::gemm_phase(ldsl, g, S, E);
#endif

            SEAM(P + 8);
        }
        if (IN(P + 9)) { norm_mod_rows(outl, outc, gin(a.in[lidx(I_NORMG)]) + (size_t)(l * 2 + 1) * DM, modl, 3, (bf16_t*)(ws + O_HX), Mlate, gw, NGW, lane); SEAM(P + 9); }
        if (IN(P + 10)) {
            pg8::Gemm g{HX, (const bf16_t*)(ws + O_W1), DM, DM, DM, 0, 0}; pg8::Order<1> S; S.init(Mlate, DFF, G, cb);
            pg8::Epi<FFF1> E{{(bf16_t*)(ws + O_HID)}};
#ifndef NO_G9
            pg8::gemm_phase(ldsl, g, S, E);
#endif

            SEAM(P + 10);
        }
        if (IN(P + 11)) {
            pg8::Gemm g{(const bf16_t*)(ws + O_HID), (const bf16_t*)(ws + (l == 0 ? O_W2 : O_W2B)), DFF, DFF, DFF, 0, 0}; pg8::Order<1> S; S.init(Mlate, DM, G, cb);
            pg8::Epi<FResid> E{{outl, outc, outl, outc, modl, 5}};
#ifndef NO_G10
            pg8::gemm_phase(ldsl, g, S, E);
#endif
            if (wctx && cb >= 32 && G > 64) phaseA(a, ws, lds, 1, nullptr, nullptr, tid, 1, 32, G - 32);

            SEAM(P + 11);
        }
    }
#undef IN
#undef SEAM
#undef tid
#undef lane
#undef gw
#undef ws
}

extern "C" void kernel_launch(void* const* d_in, const int* in_sizes, int n_in, void* d_out, int out_size, void* d_ws, size_t ws_size, hipStream_t stream) {
    static int grid = 0;
    if (grid == 0) {
        int dev = 0, cus = 0, per_cu = 0;
        (void)hipGetDevice(&dev);
        (void)hipDeviceGetAttribute(&cus, hipDeviceAttributeMultiprocessorCount, dev);
        (void)hipFuncSetAttribute((const void*)mega, hipFuncAttributeMaxDynamicSharedMemorySize, LDS_BYTES);
        (void)hipOccupancyMaxActiveBlocksPerMultiprocessor(&per_cu, (const void*)mega, 512, LDS_BYTES);
        if (per_cu < 1) per_cu = 1;
        grid = cus * per_cu;
        if (ws_size < O_END2) fprintf(stderr, "kernel_launch: workspace too small: %zu < %zu\n", ws_size, (size_t)O_END2);
    }
    (void)hipMemsetAsync((unsigned char*)d_ws + O_BARW, 0, 2 * 16384, stream);
    Args a{};
    for (int i = 0; i < 31 && i < n_in; ++i) a.in[i] = (GAS const float*)d_in[i];
    a.out = (GAS float*)d_out; a.ws = (GAS unsigned char*)d_ws; a.ph_lo = 0; a.ph_hi = NPHASE; a.sub = 7;
    void* args[] = {&a};
    hipError_t e = hipLaunchCooperativeKernel((const void*)mega, dim3(grid), dim3(512), args, LDS_BYTES, stream);
    if (e != hipSuccess) fprintf(stderr, "cooperative launch failed: %s (grid %d)\n", hipGetErrorString(e), grid);
    if (PROBE_LO >= 0) { Args b2 = a; b2.ph_lo = PROBE_LO; b2.ph_hi = PROBE_HI; b2.sub = PROBE_SUB; b2.bar_region = 1; void* args2[] = {&b2};
        (void)hipLaunchCooperativeKernel((const void*)mega, dim3(grid), dim3(512), args2, LDS_BYTES, stream); }
}
```

```cpp
#include <hip/hip_runtime.h>
#include <hip/hip_cooperative_groups.h>
#include <cstdio>
#include <cstdint>
namespace cg = cooperative_groups;

typedef unsigned short bf16_t;
typedef short bf16x8 __attribute__((ext_vector_type(8)));
typedef float f32x4 __attribute__((ext_vector_type(4)));
typedef float f32x2 __attribute__((ext_vector_type(2)));
typedef unsigned u32x4 __attribute__((ext_vector_type(4)));
typedef unsigned u32x2 __attribute__((ext_vector_type(2)));
#define LAS __attribute__((address_space(3)))
#define GAS __attribute__((address_space(1)))

constexpr int DM = 2048, NB = 4, SEQ = 4096, CTXL = 256, NLAT = NB * SEQ, NCTX = NB * CTXL, MROWS = NLAT + NCTX;
constexpr int DIN = 11344, DFF = 8192;
constexpr int NZ1 = 4352;
constexpr int LDZ = 4096;
constexpr int ZQ = 0, ZK = 512, ZO = 1024, ZQA = 2048, ZKVA = 2560, ZU = 3072;
constexpr int NMISC = 80;
constexpr int MLCH = 128, MLNC = 34;
constexpr int S5NCH = 68, S5COLS = NB * S5NCH;
constexpr float EPS = 1e-6f;

constexpr size_t al256(size_t x) { return (x + 255) & ~(size_t)255; }
constexpr size_t O_WZ1 = 0;
constexpr size_t O_WKV = O_WZ1 + (size_t)NZ1 * DM * 2;
constexpr size_t O_WG = O_WKV + (size_t)1536 * DM * 2;
constexpr size_t O_WUQ = O_WG + (size_t)6144 * DM * 2;
constexpr size_t O_WUKVK = O_WUQ + (size_t)1536 * 512 * 2;
constexpr size_t O_WUKVV = O_WUKVK + (size_t)1024 * 512 * 2;
constexpr size_t O_WGLU = O_WUKVV + (size_t)1024 * 512 * 2;
constexpr size_t O_WBR = O_WGLU + (size_t)1024 * 1024 * 2;
constexpr size_t O_WOUT = O_WBR + (size_t)3 * 2048 * 1024 * 2;
constexpr size_t O_W1 = O_WOUT + (size_t)2048 * 2048 * 2;
constexpr size_t O_W2 = O_W1 + (size_t)8192 * 2048 * 2;
constexpr size_t O_BIAS = O_W2 + (size_t)8192 * 2048 * 2;
constexpr size_t O_T1 = al256(O_BIAS + (size_t)(4352 + 1536 + 6144) * 4);
constexpr size_t O_T2 = O_T1 + (size_t)64 * 256 * 1024 * 2;
constexpr size_t O_KC = O_T2 + (size_t)64 * 1024 * 256 * 2;
constexpr size_t O_LAMP = O_KC + (size_t)64 * 128 * 256 * 2;
constexpr size_t O_BBAR = O_LAMP + (size_t)2 * 64 * 2 * 65 * 64 * 8;
constexpr size_t O_MOD = O_BBAR + (size_t)2 * 64 * 2 * 64 * 16 * 8;
constexpr size_t O_CTXX = al256(O_MOD + (size_t)2 * 5 * 12288 * 4);
constexpr size_t O_MLG = O_CTXX + (size_t)NCTX * DM * 4;
constexpr size_t O_MLN = O_MLG + (size_t)3 * 8 * MROWS * 4;
constexpr size_t O_MLM = O_MLN + (size_t)32 * MLNC * 128 * 4;
constexpr size_t O_HX = al256(O_MLM + (size_t)32 * MLNC * 4);
constexpr size_t O_BR = O_HX + (size_t)MROWS * DM * 2;
constexpr size_t BRSZ = (size_t)MROWS * 1024 * 2;
constexpr size_t O_R1 = O_BR + 3 * BRSZ;
constexpr size_t O_Z1 = O_R1;
constexpr size_t O_MISC = O_Z1 + (size_t)MROWS * LDZ * 2;
constexpr size_t O_KVT = O_MISC + (size_t)MROWS * NMISC * 4;
constexpr size_t O_Q = O_KVT + (size_t)1536 * MROWS * 2;
constexpr size_t O_K = O_Q + (size_t)MROWS * 1536 * 2;
constexpr size_t O_VTA = O_K + (size_t)MROWS * 1536 * 2;
constexpr size_t O_E = O_VTA + (size_t)1024 * MROWS * 2;
constexpr size_t O_X = O_E + (size_t)64 * S5COLS * 256 * 4;
constexpr size_t O_GS = O_X + (size_t)64 * S5COLS * 256 * 2;
constexpr size_t O_END = O_GS + (size_t)MROWS * 1024 * 2;
constexpr size_t O_W2B = O_END;
constexpr size_t O_ROPE = O_W2B + (size_t)8192 * 2048 * 2;
constexpr size_t O_BARW = O_ROPE + 64 * 16 * 8;
constexpr size_t O_END2 = O_BARW + 2 * 16384;
constexpr size_t O_GATES = O_R1;
constexpr size_t O_HID = O_R1;
static_assert(O_GATES + (size_t)MROWS * 6144 * 2 <= O_GS, "gates alias");
static_assert(O_HID + (size_t)MROWS * 8192 * 2 <= O_END, "hidden alias");

__device__ __forceinline__ float bf2f(unsigned u) { return __uint_as_float(u << 16); }
__device__ __forceinline__ unsigned cvt_pk(float lo, float hi) { unsigned r; asm volatile("v_cvt_pk_bf16_f32 %0, %1, %2" : "=v"(r) : "v"(lo), "v"(hi)); return r; }
__device__ __forceinline__ float wave_sum(float v) {
#pragma unroll
    for (int o = 1; o < 64; o <<= 1) v += __shfl_xor(v, o);
    return v;
}
__device__ __forceinline__ float sigmoidf_(float x) { return 1.f / (1.f + __expf(-x)); }
__device__ __forceinline__ f32x4 mfma16(bf16x8 a, bf16x8 b, f32x4 c) { return __builtin_amdgcn_mfma_f32_16x16x32_bf16(a, b, c, 0, 0, 0); }
__device__ __forceinline__ bf16x8 ldg8(const bf16_t* p) { return *(const bf16x8*)p; }
__device__ __forceinline__ void unpack8(bf16x8 v, float* f) {
    const u32x4 w = __builtin_bit_cast(u32x4, v);
    f[0] = __uint_as_float(w.x << 16); f[1] = __uint_as_float(w.x & 0xffff0000u); f[2] = __uint_as_float(w.y << 16); f[3] = __uint_as_float(w.y & 0xffff0000u);
    f[4] = __uint_as_float(w.z << 16); f[5] = __uint_as_float(w.z & 0xffff0000u); f[6] = __uint_as_float(w.w << 16); f[7] = __uint_as_float(w.w & 0xffff0000u);
}
__device__ __forceinline__ bf16x8 pack8(const float* f) { u32x4 w; w.x = cvt_pk(f[0], f[1]); w.y = cvt_pk(f[2], f[3]); w.z = cvt_pk(f[4], f[5]); w.w = cvt_pk(f[6], f[7]); return __builtin_bit_cast(bf16x8, w); }

__device__ __forceinline__ int ltid() { int t = threadIdx.x; asm volatile("" : "+v"(t)); return t; }
__device__ __forceinline__ int lidx(int i) { asm volatile("" : "+s"(i)); return i; }
template <class T> __device__ __forceinline__ T* lptr(GAS T* p) { asm volatile("" : "+s"(p)); return (T*)p; }
__device__ __forceinline__ const float* gin(GAS const float* p) { return (const float*)p; }
__device__ __forceinline__ int vbid() { const int G = lidx((int)gridDim.x), b = lidx((int)blockIdx.x); return (G % 8 == 0) ? (b % 8) * (G / 8) + b / 8 : b; }
namespace pg8 {
constexpr int BM = 256, BK = 64, HALF = 128, HTB = HALF * BK * 2, STAGE_BYTES = 8 * HTB, NXCD = 8, WGM = 8;
__host__ __device__ __forceinline__ int lds_byte(int r, int c) { const int st = (r >> 4) * 2 + (c >> 5), rr = r & 15, cc = c & 31, ob = rr * 64 + cc * 2; return st * 1024 + (ob ^ (((ob >> 9) & 1) << 5)); }
__host__ __device__ __forceinline__ void stage_rc(int b, int& R, int& C) { const int st = b / 1024, sb = b % 1024, swz = sb ^ (((sb >> 9) & 1) << 5); R = (st >> 1) * 16 + swz / 64; C = (st & 1) * 32 + (swz % 64) / 2; }
__host__ __device__ __forceinline__ int perm32(int rho) { const int n = rho >> 4, i = rho & 15; return 8 * (i >> 2) + 4 * n + (i & 3); }
struct Unit { int pm, pn, r; };
struct Gemm { const bf16_t* A; const bf16_t* Bt; int lda, ldb, K; size_t rsA, rsB; };
template <int NR> struct Order {
    int nM, nN, nwg, G, c;
    __device__ void init(int M, int N, int G_, int c_) { nM = M / BM; nN = N / BM; nwg = nM * nN; G = G_; c = c_; }
    __device__ bool next(int i, Unit& u) const {
        const int ti = i / NR; u.r = i - ti * NR;
        const long L = (long)ti * G + c; if (L >= nwg) return false;
        int wgid = (int)L; { const int q = nwg / NXCD, r = nwg % NXCD, xcd = wgid % NXCD, off = wgid / NXCD; wgid = (xcd < r ? xcd * (q + 1) : r * (q + 1) + (xcd - r) * q) + off; }
        const int nig = WGM * nN, gid = wgid / nig, fm = gid * WGM, gsz = (nM - fm) < WGM ? (nM - fm) : WGM;
        u.pm = fm + ((wgid % nig) % gsz); u.pn = (wgid % nig) / gsz; return true;
    }
};
template <class F> struct Epi {
    F f;
    __device__ __forceinline__ void operator()(const f32x4 (&acc)[2][2][4][2], const Unit& u, int wr, int wc, int fr, int fq) const {
        typename F::Pre pre[2];
        const int row0 = u.pm * BM + wr * 64 + fr, col0 = u.pn * BM + wc * 32 + 8 * fq;
#pragma unroll
        for (int bj = 0; bj < 2; ++bj) f.pre(u.r, row0, col0 + bj * HALF, pre[bj]);
#pragma unroll
        for (int ai = 0; ai < 2; ++ai)
#pragma unroll
            for (int m2 = 0; m2 < 4; m2 += 2) {
                typename F::Aux ax[2][2];
#pragma unroll
                for (int mm = 0; mm < 2; ++mm)
#pragma unroll
                    for (int bj = 0; bj < 2; ++bj) f.ld(u.r, row0 + ai * HALF + (m2 + mm) * 16, col0 + bj * HALF, ax[mm][bj]);
                __builtin_amdgcn_sched_barrier(0);
#pragma unroll
                for (int mm = 0; mm < 2; ++mm)
#pragma unroll
                    for (int bj = 0; bj < 2; ++bj) f.st(u.r, row0 + ai * HALF + (m2 + mm) * 16, col0 + bj * HALF, acc[ai][bj][m2 + mm][0], acc[ai][bj][m2 + mm][1], pre[bj], ax[mm][bj]);
                __builtin_amdgcn_sched_barrier(0);
            }
    }
};

template <class EpiT, class Sched>
__device__ __forceinline__ void gemm_phase(LAS unsigned char* lds, const Gemm g, const Sched& S, const EpiT& E) {
    const int tid = ltid(), wid = __builtin_amdgcn_readfirstlane(tid >> 6), lane = tid & 63, wr = wid >> 2, wc = wid & 3, fr = lane & 15, fq = lane >> 4;
    const int K = g.K, nt = K / BK;
    unsigned voffA[2], voffB[2];
#pragma unroll
    for (int i = 0; i < 2; ++i) { int R, C; stage_rc(tid * 16 + i * 8192, R, C); const int Rb = (R & ~31) + perm32(R & 31);
        voffA[i] = (unsigned)(R * g.lda + C) * 2u; voffB[i] = (unsigned)(Rb * g.ldb + C) * 2u; }
    const size_t kstep = (size_t)(BK * 2);
    const size_t hstepA = (size_t)HALF * g.lda * 2, hstepB = (size_t)HALF * g.ldb * 2;
    const size_t tstepA = 2 * hstepA, tstepB = 2 * hstepB;
    const unsigned ldsw = (unsigned)wid * 1024u;
    const int aoff = lds_byte(wr * 64 + fr, fq * 8), boff = lds_byte(wc * 32 + fr, fq * 8);
#define PG8_SA(b, h) (((b) * 2 + (h)) * HTB)
#define PG8_SB(b, h) ((4 + (b) * 2 + (h)) * HTB)
#define PG8_STAGE(bufoff, gbase, voff) do { _Pragma("unroll") for (int _i = 0; _i < 2; ++_i) \
        __builtin_amdgcn_global_load_lds((const unsigned*)((const char*)(gbase) + (voff)[_i]), (LAS unsigned*)(lds + (bufoff) + ldsw + _i * 8192), 16, 0, 0); } while (0)
#define PG8_LDA(dst, b, h) do { _Pragma("unroll") for (int m = 0; m < 4; ++m) _Pragma("unroll") for (int k = 0; k < 2; ++k) dst[m][k] = *(const LAS bf16x8*)(lds + PG8_SA(b, h) + aoff + m * 2048 + k * 1024); } while (0)
#define PG8_LDB(dst, b, h) do { _Pragma("unroll") for (int n = 0; n < 2; ++n) _Pragma("unroll") for (int k = 0; k < 2; ++k) dst[n][k] = *(const LAS bf16x8*)(lds + PG8_SB(b, h) + boff + n * 2048 + k * 1024); } while (0)
#define PG8_MMA(ai, bj, At, Bt) do { __builtin_amdgcn_s_setprio(1); _Pragma("unroll") for (int m = 0; m < 4; ++m) _Pragma("unroll") for (int n = 0; n < 2; ++n) _Pragma("unroll") for (int k = 0; k < 2; ++k) \
        acc[ai][bj][m][n] = __builtin_amdgcn_mfma_f32_16x16x32_bf16(Bt[n][k], At[m][k], acc[ai][bj][m][n], 0, 0, 0); __builtin_amdgcn_s_setprio(0); } while (0)
#define PG8_WAIT_V(n) asm volatile("s_waitcnt vmcnt(" #n ")" ::: "memory")
#define PG8_WAIT_L(n) asm volatile("s_waitcnt lgkmcnt(" #n ")" ::: "memory")
#define PG8_BAR __builtin_amdgcn_s_barrier()
#define PG8_SCHED __builtin_amdgcn_sched_barrier(0)
    Unit cur, nxt; int ui = 0;
    if (!S.next(0, cur)) return;
    f32x4 acc[2][2][4][2];
#pragma unroll
    for (int a = 0; a < 2; ++a)
#pragma unroll
        for (int b = 0; b < 2; ++b)
#pragma unroll
            for (int m = 0; m < 4; ++m)
#pragma unroll
                for (int n = 0; n < 2; ++n) acc[a][b][m][n] = (f32x4){0.f, 0.f, 0.f, 0.f};
    bf16x8 At[4][2], B0[2][2], B1[2][2];
    const char* cA = (const char*)g.A + (size_t)cur.pm * tstepA + (size_t)cur.r * g.rsA * 2; const char* cB = (const char*)g.Bt + (size_t)cur.pn * tstepB + (size_t)cur.r * g.rsB * 2;
    PG8_STAGE(PG8_SB(0, 0), cB, voffB); PG8_STAGE(PG8_SB(0, 1), cB + hstepB, voffB); PG8_STAGE(PG8_SA(0, 0), cA, voffA); PG8_STAGE(PG8_SA(0, 1), cA + hstepA, voffA);
    if (wr == 1) PG8_BAR;
    PG8_WAIT_V(2); PG8_BAR;
    PG8_STAGE(PG8_SB(1, 0), cB + kstep, voffB); PG8_STAGE(PG8_SA(1, 0), cA + kstep, voffA); PG8_STAGE(PG8_SB(1, 1), cB + hstepB + kstep, voffB);
    PG8_WAIT_V(6); PG8_BAR;
    for (;;) {
        const bool has_next = S.next(ui + 1, nxt);
        const char* nA = has_next ? (const char*)g.A + (size_t)nxt.pm * tstepA + (size_t)nxt.r * g.rsA * 2 : cA; const char* nB = has_next ? (const char*)g.Bt + (size_t)nxt.pn * tstepB + (size_t)nxt.r * g.rsB * 2 : cB;
        for (int t = 0; t < nt; t += 2) {
            const bool last = (t == nt - 2);
            const char* a1 = cA + (size_t)(t + 1) * kstep;
            const char* a2 = last ? nA : cA + (size_t)(t + 2) * kstep; const char* b2 = last ? nB : cB + (size_t)(t + 2) * kstep;
            const char* a3 = a2 + kstep; const char* b3 = b2 + kstep;
            PG8_LDB(B0, 0, 0); PG8_LDB(B1, 0, 1); PG8_SCHED; PG8_LDA(At, 0, 0); PG8_STAGE(PG8_SA(1, 1), a1 + hstepA, voffA);
            PG8_WAIT_V(8); PG8_WAIT_L(0); PG8_BAR; PG8_MMA(0, 0, At, B0); PG8_MMA(0, 1, At, B1); PG8_BAR; PG8_SCHED;
            PG8_LDA(At, 0, 1); PG8_STAGE(PG8_SB(0, 0), b2, voffB); PG8_STAGE(PG8_SB(0, 1), b2 + hstepB, voffB); PG8_STAGE(PG8_SA(0, 0), a2, voffA);
            PG8_WAIT_V(8); PG8_WAIT_L(0); PG8_BAR; PG8_MMA(1, 0, At, B0); PG8_MMA(1, 1, At, B1); PG8_BAR; PG8_SCHED;
            PG8_LDB(B0, 1, 0); PG8_LDB(B1, 1, 1); PG8_SCHED; PG8_LDA(At, 1, 0); PG8_STAGE(PG8_SA(0, 1), a2 + hstepA, voffA);
            PG8_WAIT_V(8); PG8_WAIT_L(0); PG8_BAR; PG8_MMA(0, 0, At, B0); PG8_MMA(0, 1, At, B1); PG8_BAR; PG8_SCHED;
            PG8_LDA(At, 1, 1); PG8_STAGE(PG8_SB(1, 0), b3, voffB); PG8_STAGE(PG8_SB(1, 1), b3 + hstepB, voffB); PG8_STAGE(PG8_SA(1, 0), a3, voffA);
            PG8_WAIT_V(8); PG8_WAIT_L(0); PG8_BAR; PG8_MMA(1, 0, At, B0); PG8_MMA(1, 1, At, B1); PG8_BAR; PG8_SCHED;
        }
        if (wr == 0) PG8_BAR;
        E(acc, cur, wr, wc, fr, fq);
        if (!has_next) break;
#pragma unroll
        for (int a = 0; a < 2; ++a)
#pragma unroll
            for (int b = 0; b < 2; ++b)
#pragma unroll
                for (int m = 0; m < 4; ++m)
#pragma unroll
                    for (int n = 0; n < 2; ++n) acc[a][b][m][n] = (f32x4){0.f, 0.f, 0.f, 0.f};
        cur = nxt; cA = nA; cB = nB; ++ui;
        if (wr == 1) PG8_BAR;
    }
    PG8_WAIT_V(0);
    PG8_BAR;
#undef PG8_SA
#undef PG8_SB
#undef PG8_STAGE
#undef PG8_LDA
#undef PG8_LDB
#undef PG8_MMA
#undef PG8_WAIT_V
#undef PG8_WAIT_L
#undef PG8_BAR
#undef PG8_SCHED
}
}
__device__ __forceinline__ void st_bf16x8(bf16_t* p, f32x4 v0, f32x4 v1) { u32x4 w; w.x = cvt_pk(v0[0], v0[1]); w.y = cvt_pk(v0[2], v0[3]); w.z = cvt_pk(v1[0], v1[1]); w.w = cvt_pk(v1[2], v1[3]); *(u32x4*)p = w; }
struct NoAux {};
struct ColBias { f32x4 b0, b1; };
struct FZ1 { bf16_t* z1; float* misc; const float* b1; typedef ColBias Pre; typedef NoAux Aux;
    __device__ __forceinline__ void pre(int, int, int col, Pre& p) const { p.b0 = *(const f32x4*)(b1 + col); p.b1 = *(const f32x4*)(b1 + col + 4); }
    __device__ __forceinline__ void ld(int, int, int, Aux&) const {}
    __device__ __forceinline__ void st(int, int row, int col, f32x4 v0, f32x4 v1, const Pre& p, const Aux&) const {
        v0 += p.b0; v1 += p.b1;
        if (col < LDZ) st_bf16x8(z1 + (size_t)row * LDZ + col, v0, v1);
        else { const int c = col - LDZ; if (c < NMISC) { float* q = misc + (size_t)row * NMISC + c; *(f32x4*)q = v0; *(f32x4*)(q + 4) = v1; } }
    } };
struct RowB { float b; };
struct FRowBias { bf16_t* o; int ld_; const float* bias; typedef NoAux Pre; typedef RowB Aux;
    __device__ __forceinline__ void pre(int, int, int, Pre&) const {}
    __device__ __forceinline__ void ld(int, int row, int, Aux& x) const { x.b = bias ? bias[row] : 0.f; }
    __device__ __forceinline__ void st(int, int row, int col, f32x4 v0, f32x4 v1, const Pre&, const Aux& x) const { v0 += x.b; v1 += x.b; st_bf16x8(o + (size_t)row * ld_ + col, v0, v1); } };
struct FGate { bf16_t* o; const float* bg; typedef ColBias Pre; typedef NoAux Aux;
    __device__ __forceinline__ void pre(int, int, int col, Pre& p) const { p.b0 = *(const f32x4*)(bg + col); p.b1 = *(const f32x4*)(bg + col + 4); }
    __device__ __forceinline__ void ld(int, int, int, Aux&) const {}
    __device__ __forceinline__ void st(int, int row, int col, f32x4 v0, f32x4 v1, const Pre& p, const Aux&) const {
        v0 += p.b0; v1 += p.b1;
#pragma unroll
        for (int i = 0; i < 4; ++i) { v0[i] = sigmoidf_(v0[i]); v1[i] = sigmoidf_(v1[i]); }
        st_bf16x8(o + (size_t)row * 6144 + col, v0, v1);
    } };
struct FPlain { bf16_t* o; int ld_; typedef NoAux Pre; typedef NoAux Aux;
    __device__ __forceinline__ void pre(int, int, int, Pre&) const {}
    __device__ __forceinline__ void ld(int, int, int, Aux&) const {}
    __device__ __forceinline__ void st(int, int row, int col, f32x4 v0, f32x4 v1, const Pre&, const Aux&) const { st_bf16x8(o + (size_t)row * ld_ + col, v0, v1); } };
struct FKn { bf16_t* o; typedef NoAux Pre; typedef NoAux Aux;
    __device__ __forceinline__ void pre(int, int, int, Pre&) const {}
    __device__ __forceinline__ void ld(int, int, int, Aux&) const {}
    __device__ __forceinline__ void st(int, int row, int col, f32x4 v0, f32x4 v1, const Pre&, const Aux&) const { const int h = col >> 7, d = col & 127; st_bf16x8(o + (size_t)row * 1536 + h * 192 + d, v0, v1); } };
struct Vec8 { bf16x8 v; };
struct FGlu { bf16_t* o; const bf16_t* g; const float* bias; typedef ColBias Pre; typedef Vec8 Aux;
    __device__ __forceinline__ void pre(int, int, int col, Pre& p) const { p.b0 = *(const f32x4*)(bias + col); p.b1 = *(const f32x4*)(bias + col + 4); }
    __device__ __forceinline__ void ld(int, int row, int col, Aux& x) const { x.v = ldg8(g + (size_t)row * 1024 + col); }
    __device__ __forceinline__ void st(int, int row, int col, f32x4 v0, f32x4 v1, const Pre& p, const Aux& x) const {
        float gv[8]; unpack8(x.v, gv);
        v0 += p.b0; v1 += p.b1;
#pragma unroll
        for (int i = 0; i < 4; ++i) { v0[i] = gv[i] * sigmoidf_(v0[i]); v1[i] = gv[4 + i] * sigmoidf_(v1[i]); }
        st_bf16x8(o + (size_t)row * 1024 + col, v0, v1);
    } };
struct Vec8x2 { bf16x8 g, p; };
struct FMerge { bf16_t* o; const bf16_t* gates; typedef NoAux Pre; typedef Vec8x2 Aux;
    __device__ __forceinline__ void pre(int, int, int, Pre&) const {}
    __device__ __forceinline__ void ld(int r, int row, int col, Aux& x) const { x.g = ldg8(gates + (size_t)row * 6144 + r * 2048 + col); if (r > 0) x.p = ldg8(o + (size_t)row * DM + col); }
    __device__ __forceinline__ void st(int r, int row, int col, f32x4 v0, f32x4 v1, const Pre&, const Aux& x) const {
        float gv[8]; unpack8(x.g, gv);
#pragma unroll
        for (int i = 0; i < 4; ++i) { v0[i] *= gv[i]; v1[i] *= gv[4 + i]; }
        if (r > 0) { float pv[8]; unpack8(x.p, pv);
#pragma unroll
            for (int i = 0; i < 4; ++i) { v0[i] += pv[i]; v1[i] += pv[4 + i]; } }
        st_bf16x8(o + (size_t)row * DM + col, v0, v1);
    } };
struct X8 { f32x4 x0, x1; };
struct FResid { const float* xin_l; const float* xin_c; float* xout_l; float* xout_c; const float* modl; int gi; typedef ColBias Pre; typedef X8 Aux;
    __device__ __forceinline__ void pre(int, int row0, int col, Pre& p) const { const int mr = row0 < NLAT ? (row0 >> 12) : 4; const float* gp = modl + (size_t)mr * 12288 + gi * DM + col; p.b0 = *(const f32x4*)gp; p.b1 = *(const f32x4*)(gp + 4); }
    __device__ __forceinline__ void ld(int, int row, int col, Aux& x) const { const float* xi = row < NLAT ? xin_l + (size_t)row * DM : xin_c + (size_t)(row - NLAT) * DM; x.x0 = *(const f32x4*)(xi + col); x.x1 = *(const f32x4*)(xi + col + 4); }
    __device__ __forceinline__ void st(int, int row, int col, f32x4 v0, f32x4 v1, const Pre& p, const Aux& x) const {
        float* xo = row < NLAT ? xout_l + (size_t)row * DM : xout_c + (size_t)(row - NLAT) * DM;
        *(f32x4*)(xo + col) = x.x0 + p.b0 * v0; *(f32x4*)(xo + col + 4) = x.x1 + p.b1 * v1;
    } };
struct FFF1 { bf16_t* o; typedef NoAux Pre; typedef NoAux Aux;
    __device__ __forceinline__ void pre(int, int, int, Pre&) const {}
    __device__ __forceinline__ void ld(int, int, int, Aux&) const {}
    __device__ __forceinline__ void st(int, int row, int col, f32x4 v0, f32x4 v1, const Pre&, const Aux&) const {
#pragma unroll
        for (int i = 0; i < 4; ++i) { const float a = fmaxf(v0[i], 0.f), b = fmaxf(v1[i], 0.f); v0[i] = a * a; v1[i] = b * b; }
        st_bf16x8(o + (size_t)row * DFF + col, v0, v1);
    } };

struct Args { GAS const float* in[31]; GAS float* out; GAS unsigned char* ws; int ph_lo, ph_hi, sub, bar_region; };
enum { I_X = 0, I_C, I_CTX, I_CCTX, I_WMOD, I_BMOD, I_NORMG, I_WIN, I_BIN, I_MLGB, I_MLNG, I_QAG, I_KVAG, I_WUQ, I_WUKV, I_QNG, I_KNG,
       I_ARE, I_AIM, I_LOGDT, I_BRE, I_BIM, I_CRE, I_CIM, I_S5D, I_WGLU, I_BGLU, I_WBR, I_WOUT, I_FF1, I_FF2 };

__device__ __forceinline__ int seq_row(int b, int pos) { return pos < CTXL ? NLAT + b * CTXL + pos : b * SEQ + (pos - CTXL); }

__device__ __forceinline__ void tr_item(const float* W, int ld, int K, int nblk, bf16_t* WT, int mode, float* scr, int item, int lane) {
    const int kb = item / nblk, nb = item % nblk, k0 = 64 * kb, n0 = 32 * nb;
    float tv[32];
#pragma unroll
    for (int i = 0; i < 32; ++i) { const int kk = 2 * i + (lane >> 5); tv[i] = W[(size_t)(k0 + kk) * ld + n0 + (lane & 31)]; }
    __builtin_amdgcn_sched_barrier(0);
#pragma unroll
    for (int i = 0; i < 32; ++i) { const int kk = 2 * i + (lane >> 5); scr[kk * 33 + (lane & 31)] = tv[i]; }
    asm volatile("s_waitcnt lgkmcnt(0)" ::: "memory");
    const int c = lane & 7;
    int drow0 = n0;
    if (mode == 1) { const int h = n0 >> 8, w = n0 & 255; drow0 = (w < 128) ? (h * 128 + w) : (1024 + h * 128 + (w - 128)); }
#pragma unroll
    for (int j = 0; j < 4; ++j) { const int n = (lane >> 3) + 8 * j; const float* s = scr + (8 * c) * 33 + n;
        u32x4 o; o.x = cvt_pk(s[0 * 33], s[1 * 33]); o.y = cvt_pk(s[2 * 33], s[3 * 33]); o.z = cvt_pk(s[4 * 33], s[5 * 33]); o.w = cvt_pk(s[6 * 33], s[7 * 33]);
        *(u32x4*)(WT + (size_t)(drow0 + n) * K + k0 + 8 * c) = o; }
    asm volatile("s_waitcnt lgkmcnt(0)" ::: "memory");
}
#define TR_JOB(Wp, ld, K, ncols, WTp, mode) do { const int _nblk = (ncols) / 32, _nit = ((K) / 64) * _nblk; \
    for (int it = gw; it < _nit; it += NGW) tr_item((Wp), (ld), (K), _nblk, (WTp), (mode), scr, it, lane); } while (0)

__device__ __forceinline__ void norm_mod_rows(const float* xl, const float* xc, const float* ng, const float* modl, int si, bf16_t* out, int nrows, int gw, int NGW, int lane) {
    for (int row = gw; row < nrows; row += NGW) {
        const float* xr; int mr;
        if (row < NLAT) { xr = xl + (size_t)row * DM; mr = row >> 12; } else { xr = xc + (size_t)(row - NLAT) * DM; mr = 4; }
        f32x4 v[8]; float s = 0.f;
#pragma unroll
        for (int j = 0; j < 8; ++j) { v[j] = *(const f32x4*)(xr + 256 * j + 4 * lane); s += v[j][0] * v[j][0] + v[j][1] * v[j][1] + v[j][2] * v[j][2] + v[j][3] * v[j][3]; }
        const float rs = rsqrtf(wave_sum(s) * (1.f / DM) + EPS);
        const float* sh = modl + (size_t)mr * 12288 + si * DM; const float* sc = sh + DM;
#pragma unroll
        for (int jh = 0; jh < 8; jh += 4) {
            f32x4 g4[4], a4[4], b4[4];
#pragma unroll
            for (int j = 0; j < 4; ++j) { const int c = 256 * (jh + j) + 4 * lane; g4[j] = *(const f32x4*)(ng + c); a4[j] = *(const f32x4*)(sh + c); b4[j] = *(const f32x4*)(sc + c); }
            __builtin_amdgcn_sched_barrier(0);
#pragma unroll
            for (int j = 0; j < 4; ++j) { const int c = 256 * (jh + j) + 4 * lane; f32x4 y;
#pragma unroll
                for (int e = 0; e < 4; ++e) y[e] = v[jh + j][e] * rs * g4[j][e] * (1.f + b4[j][e]) + a4[j][e];
                u32x2 w; w.x = cvt_pk(y[0], y[1]); w.y = cvt_pk(y[2], y[3]); *(u32x2*)(out + (size_t)row * DM + c) = w; }
        }
    }
}
__device__ __forceinline__ void phase0(const Args& a, unsigned char* ws, float* sm, int tid) {
    const int w = tid >> 6, lane = tid & 63;
    float* sl = sm;
    float* red = sm + 5 * 2048;
    for (int i = tid; i < 5 * 2048; i += 512) { const float c = i < 4 * 2048 ? gin(a.in[lidx(I_C)])[i] : gin(a.in[lidx(I_CCTX)])[i - 4 * 2048]; sl[i] = c * sigmoidf_(c); }
    __syncthreads();
    float* mod = (float*)(ws + O_MOD);
    for (int u = vbid(); u < 384; u += lidx((int)gridDim.x)) {
        const int l = u / 192, j = (u % 192) * 64 + lane;
        const float* W = gin(a.in[lidx(I_WMOD)]) + (size_t)l * DM * 12288 + j;
        float acc[5] = {0.f, 0.f, 0.f, 0.f, 0.f};
#pragma unroll 1
        for (int k0 = w * 256; k0 < w * 256 + 256; k0 += 16) { float wv[16];
#pragma unroll
            for (int i = 0; i < 16; ++i) wv[i] = W[(size_t)(k0 + i) * 12288];
            __builtin_amdgcn_sched_barrier(0);
#pragma unroll
            for (int i = 0; i < 16; ++i)
#pragma unroll
                for (int r = 0; r < 5; ++r) acc[r] += sl[r * 2048 + k0 + i] * wv[i]; }
#pragma unroll
        for (int r = 0; r < 5; ++r) red[(w * 5 + r) * 64 + lane] = acc[r];
        __syncthreads();
        if (tid < 320) { const int r = tid >> 6; float s = 0.f;
#pragma unroll
            for (int ww = 0; ww < 8; ++ww) s += red[(ww * 5 + r) * 64 + lane];
            mod[(size_t)(l * 5 + r) * 12288 + j] = s + gin(a.in[lidx(I_BMOD)])[l * 12288 + j]; }
        __syncthreads();
    }
    { f32x2* rope = (f32x2*)(ws + O_ROPE); const int gt0 = lidx((int)blockIdx.x) * 512 + tid;
      if (gt0 < 1024) { const int f = gt0 & 15, pos = gt0 >> 4; float sn, cs; sincosf((float)pos * exp2f(-(float)f * (13.287712379549449f / 16.f)), &sn, &cs); rope[gt0] = (f32x2){cs, sn}; } }
    f32x2* lamp = (f32x2*)(ws + O_LAMP); f32x2* bbar = (f32x2*)(ws + O_BBAR);
    const int gt = lidx((int)blockIdx.x) * 512 + tid, gs = lidx((int)gridDim.x) * 512;
    for (int idx = gt; idx < 2 * 64 * 2 * 65 * 64; idx += gs) {
        const int n = idx & 63, p = (idx >> 6) % 65, rest = idx / (64 * 65), dir = rest & 1, g = (rest >> 1) & 63, l = rest >> 7;
        const int si = ((l * 2 + dir) * 64 + g) * 64 + n;
        const float re = fminf(gin(a.in[lidx(I_ARE)])[si], -1e-4f), im = gin(a.in[lidx(I_AIM)])[si], dt = expf(gin(a.in[lidx(I_LOGDT)])[(l * 2 + dir) * 64 + g]);
        const float mag = expf((float)p * (re * dt)); float s, c; sincosf((float)p * (im * dt), &s, &c);
        lamp[idx] = (f32x2){mag * c, mag * s};
    }
    for (int idx = gt; idx < 2 * 64 * 2 * 64 * 16; idx += gs) {
        const int ci = idx & 15, n = (idx >> 4) & 63, dir = (idx >> 10) & 1, g = (idx >> 11) & 63, l = idx >> 17;
        const int si = ((l * 2 + dir) * 64 + g) * 64 + n;
        const float re = fminf(gin(a.in[lidx(I_ARE)])[si], -1e-4f), im = gin(a.in[lidx(I_AIM)])[si], dt = expf(gin(a.in[lidx(I_LOGDT)])[(l * 2 + dir) * 64 + g]);
        const float mag = expf(re * dt); float s, c; sincosf(im * dt, &s, &c);
        const float nr = mag * c - 1.f, ni = mag * s, d = re * re + im * im;
        const float qr = (nr * re + ni * im) / d, qi = (ni * re - nr * im) / d;
        const float br = gin(a.in[lidx(I_BRE)])[(size_t)si * 16 + ci], bi = gin(a.in[lidx(I_BIM)])[(size_t)si * 16 + ci];
        bbar[idx] = (f32x2){qr * br - qi * bi, qr * bi + qi * br};
    }
}

__device__ __forceinline__ void phaseA(const Args& a, unsigned char* ws, unsigned char* smraw, int l, const float* xl, const float* xc, int tid, int mode, int boff, int nb) {
    const int wave = tid >> 6, lane = tid & 63;
    const int vb_ = lidx((int)blockIdx.x) - boff;
    const int gw = vb_ * 8 + wave, NGW = nb * 8;
    float* scr = (float*)(smraw + wave * 16384);
    const float* win = gin(a.in[lidx(I_WIN)]) + (size_t)l * DM * DIN;
    bf16_t* Wz1 = (bf16_t*)(ws + O_WZ1); bf16_t* Wkv = (bf16_t*)(ws + O_WKV);
    {
        constexpr int NJ = 17;
        constexpr int cum[NJ + 1] = {0, 512, 1024, 2048, 3072, 4096, 4160, 5696, 11840, 12224, 12736, 13248, 14272, 15296, 16320, 18368, 26560, 34752};
        const int it_lo = 0, it_hi = mode == 2 ? 0 : cum[NJ];
        for (int it = it_lo + gw; it < it_hi; it += NGW) {
            int j = 0;
#pragma unroll
            for (int k = 1; k < NJ; ++k) j += (it >= cum[k]) ? 1 : 0;
            int base = 0;
#pragma unroll
            for (int k = 1; k < NJ; ++k) base = (j == k) ? cum[k] : base;
            const float* W; int ld, K, ncols, mode = 0; bf16_t* WT;
            if (j < 8) { ld = DIN; K = DM;
                const int so[8] = {0, 512, 2048, 3088, 4176, 4112, 512, 5200}; const int nc[8] = {512, 512, 1024, 1024, 1024, 64, 1536, 6144}; const int dr[6] = {0, 512, 1024, 2048, 3072, 4096};
                int sof = 0, ncl = 0, dro = 0;
#pragma unroll
                for (int k = 0; k < 8; ++k) { sof = (j == k) ? so[k] : sof; ncl = (j == k) ? nc[k] : ncl; }
#pragma unroll
                for (int k = 0; k < 6; ++k) dro = (j == k) ? dr[k] : dro;
                W = win + sof; ncols = ncl; WT = j < 6 ? Wz1 + (size_t)dro * DM : (j == 6 ? Wkv : (bf16_t*)(ws + O_WG)); }
            else if (j == 8) { W = gin(a.in[lidx(I_WUQ)]) + (size_t)l * 512 * 1536; ld = 1536; K = 512; ncols = 1536; WT = (bf16_t*)(ws + O_WUQ); }
            else if (j == 9) { W = gin(a.in[lidx(I_WUKV)]) + (size_t)l * 512 * 2048; ld = 2048; K = 512; ncols = 2048; WT = (bf16_t*)(ws + O_WUKVK); mode = 1; }
            else if (j == 10) { W = gin(a.in[lidx(I_WGLU)]) + (size_t)l * 1024 * 1024; ld = 1024; K = 1024; ncols = 1024; WT = (bf16_t*)(ws + O_WGLU); }
            else if (j < 14) { const int r = j - 11; W = gin(a.in[lidx(I_WBR)]) + ((size_t)l * 3 + r) * 1024 * 2048; ld = 2048; K = 1024; ncols = 2048; WT = (bf16_t*)(ws + O_WBR) + (size_t)r * 2048 * 1024; }
            else if (j == 14) { W = gin(a.in[lidx(I_WOUT)]) + (size_t)l * DM * DM; ld = DM; K = DM; ncols = DM; WT = (bf16_t*)(ws + O_WOUT); }
            else if (j == 15) { W = gin(a.in[lidx(I_FF1)]) + (size_t)l * DM * DFF; ld = DFF; K = DM; ncols = DFF; WT = (bf16_t*)(ws + O_W1); }
            else { W = gin(a.in[lidx(I_FF2)]) + (size_t)l * DFF * DM; ld = DM; K = DFF; ncols = DM; WT = (bf16_t*)(ws + (l == 0 ? O_W2 : O_W2B)); }
            tr_item(W, ld, K, ncols / 32, WT, mode, scr, it - base, lane);
        }
    }
    const int gt = vb_ * 512 + tid, gs = nb * 512;
    if (mode != 2) {
    for (int idx = gt; idx < 192 * DM; idx += gs) { const int r = idx / DM, k = idx % DM;
        const float v = r < 16 ? win[(size_t)k * DIN + 3072 + r] : 0.f; Wz1[(size_t)(4160 + r) * DM + k] = (bf16_t)(cvt_pk(v, 0.f) & 0xffffu); }
    { float* b1 = (float*)(ws + O_BIAS); float* bkv = b1 + 4352; float* bg = bkv + 1536; const float* bin = gin(a.in[lidx(I_BIN)]) + (size_t)l * DIN;
      for (int i = gt; i < 4352; i += gs) { int src = -1;
          if (i < 1024) src = i; else if (i < 2048) src = 2048 + (i - 1024); else if (i < 3072) src = 3088 + (i - 2048); else if (i < 4096) src = 4176 + (i - 3072);
          else if (i < 4160) src = 4112 + (i - 4096); else if (i < 4176) src = 3072 + (i - 4160);
          b1[i] = src >= 0 ? bin[src] : 0.f; }
      for (int i = gt; i < 1536; i += gs) bkv[i] = bin[512 + i];
      for (int i = gt; i < 6144; i += gs) bg[i] = bin[5200 + i]; }
    const f32x2* lamp = (const f32x2*)(ws + O_LAMP) + (size_t)l * 64 * 2 * 65 * 64; const f32x2* bbar = (const f32x2*)(ws + O_BBAR) + (size_t)l * 64 * 2 * 64 * 16;
    bf16_t* T1 = (bf16_t*)(ws + O_T1); bf16_t* T2 = (bf16_t*)(ws + O_T2); bf16_t* KC = (bf16_t*)(ws + O_KC);
    for (int idx = gt; idx < 64 * 16 * 32 * 64; idx += gs) {
        const int ln = idx & 63, ks = (idx >> 6) & 31, rbk = (idx >> 11) & 15, g = idx >> 15;
        const int row = rbk * 16 + (ln & 15), k0 = 32 * ks + 8 * (ln >> 4);
        const int dir = row >> 7, n = (row >> 1) & 63, reim = row & 1, j = k0 >> 4, ci0 = k0 & 15;
        const int p = dir ? j : 63 - j;
        const f32x2 lp = lamp[((g * 2 + dir) * 65 + p) * 64 + n];
        const f32x2* bb = bbar + ((size_t)(g * 2 + dir) * 64 + n) * 16 + ci0;
        float v[8];
#pragma unroll
        for (int e = 0; e < 8; ++e) { const f32x2 b = bb[e]; v[e] = reim ? (lp.x * b.y + lp.y * b.x) : (lp.x * b.x - lp.y * b.y); }
        *(bf16x8*)(T1 + (size_t)g * 256 * 1024 + (size_t)idx % (16 * 32 * 64) * 8) = pack8(v);
    }
    for (int idx = gt; idx < 64 * 64 * 16 * 2 * 16; idx += gs) {
        const int co = idx & 15, q_ = (idx >> 4) & 3, ksl = (idx >> 6) & 3, dir = (idx >> 8) & 1, t = (idx >> 9) & 63, g = idx >> 15, nq = ksl * 4 + q_;
        const int p = dir ? 64 - t : t + 1, n0 = 4 * nq;
        const f32x4 cr = *(const f32x4*)(gin(a.in[lidx(I_CRE)]) + ((size_t)((l * 2 + dir) * 64 + g) * 16 + co) * 64 + n0), ci4 = *(const f32x4*)(gin(a.in[lidx(I_CIM)]) + ((size_t)((l * 2 + dir) * 64 + g) * 16 + co) * 64 + n0);
        const f32x2* lpp = lamp + ((g * 2 + dir) * 65 + p) * 64 + n0;
        float v[8];
#pragma unroll
        for (int e = 0; e < 4; ++e) { const f32x2 lp = lpp[e]; v[2 * e] = cr[e] * lp.x - ci4[e] * lp.y; v[2 * e + 1] = -(cr[e] * lp.y + ci4[e] * lp.x); }
        *(bf16x8*)(T2 + (size_t)g * 1024 * 256 + (size_t)((t * 8 + dir * 4 + (nq >> 2)) * 64 + (nq & 3) * 16 + co) * 8) = pack8(v);
    }
    { f32x2* lps = (f32x2*)smraw; float* ex = (float*)(smraw + 2 * 32 * 64 * 8);
      for (int u = vb_; u < 128; u += nb) {
        const int g = u >> 1, ph = u & 1;
        __syncthreads();
        for (int i = tid; i < 2 * 32 * 64; i += 512) { const int n = i & 63, pp = (i >> 6) & 31, dir = i >> 11; lps[i] = lamp[((g * 2 + dir) * 65 + 32 * ph + pp) * 64 + n]; }
        __syncthreads();
        const int pair = tid & 255, co = pair >> 4, ci = pair & 15, dir = tid >> 8;
        const float* cre = gin(a.in[lidx(I_CRE)]) + ((size_t)((l * 2 + dir) * 64 + g) * 16 + co) * 64; const float* cim = gin(a.in[lidx(I_CIM)]) + ((size_t)((l * 2 + dir) * 64 + g) * 16 + co) * 64;
        const f32x2* bb = bbar + ((size_t)(g * 2 + dir) * 64) * 16 + ci;
        float acc[32];
#pragma unroll
        for (int pp = 0; pp < 32; ++pp) acc[pp] = 0.f;
        for (int n = 0; n < 64; ++n) {
            const f32x2 b = bb[n * 16]; const float cr = cre[n], cm = cim[n];
            const float xr = cr * b.x - cm * b.y, xi = cr * b.y + cm * b.x;
            const f32x2* lq = lps + dir * 2048 + n;
#pragma unroll
            for (int pp = 0; pp < 32; ++pp) { const f32x2 lp = lq[pp * 64]; acc[pp] += xr * lp.x - xi * lp.y; }
        }
        if (ph == 0 && dir == 1) ex[pair] = acc[0];
        __syncthreads();
        bf16_t* kc = KC + (size_t)g * 128 * 256 + pair;
#pragma unroll
        for (int pp = 0; pp < 32; ++pp) {
            const int p = 32 * ph + pp;
            if (p == 0) { if (dir == 0) { const float v = acc[0] + ex[pair] + (co == ci ? gin(a.in[lidx(I_S5D)])[l * 1024 + g * 16 + co] : 0.f); kc[63 * 256] = (bf16_t)(cvt_pk(v, 0.f) & 0xffffu); kc[127 * 256] = 0; } }
            else kc[(dir == 0 ? 63 + p : 63 - p) * 256] = (bf16_t)(cvt_pk(acc[pp], 0.f) & 0xffffu);
        }
      }
      __syncthreads(); }
    }
    if (mode != 1) {
    norm_mod_rows(xl, xc, gin(a.in[lidx(I_NORMG)]) + (size_t)(l * 2 + 0) * DM, (const float*)(ws + O_MOD) + (size_t)l * 5 * 12288, 0, (bf16_t*)(ws + O_HX), MROWS, gw, NGW, lane);
    }
}

__device__ __forceinline__ void mla_norm(const Args& a, unsigned char* ws, int l, int gw, int NGW, int lane) {
    bf16_t* z1 = (bf16_t*)(ws + O_Z1);
    for (int it = gw; it < MROWS * 2; it += NGW) {
        const int row = it >> 1, which = it & 1;
        bf16_t* p = z1 + (size_t)row * LDZ + (which ? ZKVA : ZQA) + lane * 8;
        float v[8]; unpack8(*(const bf16x8*)p, v);
        float s = 0.f;
#pragma unroll
        for (int e = 0; e < 8; ++e) s += v[e] * v[e];
        const float rs = rsqrtf(wave_sum(s) * (1.f / 512.f) + EPS);
        const float* g = (which ? gin(a.in[lidx(I_KVAG)]) : gin(a.in[lidx(I_QAG)])) + l * 512 + lane * 8;
#pragma unroll
        for (int e = 0; e < 8; ++e) v[e] = v[e] * rs * g[e];
        *(bf16x8*)p = pack8(v);
    }
}
__device__ __forceinline__ float logsigmoidf_(float x) { return fminf(x, 0.f) - log1pf(__expf(-fabsf(x))); }
__device__ __forceinline__ float scan_add_incl(float v, int lane) {
#pragma unroll
    for (int o = 1; o < 64; o <<= 1) { const float t = __shfl_up(v, o); if (lane >= o) v += t; }
    return v;
}
__device__ __forceinline__ float scan_max_incl(float v, int lane) {
#pragma unroll
    for (int o = 1; o < 64; o <<= 1) { const float t = __shfl_up(v, o); if (lane >= o) v = fmaxf(v, t); }
    return v;
}
__device__ __forceinline__ void ml_state_pass(const Args& a, unsigned char* ws, float* sm, int l, int tid) {
    const int w = tid >> 6, lane = tid & 63, cidx = lane & 15, q = lane >> 4;
    const float* misc = (const float*)(ws + O_MISC); const bf16_t* KVt = (const bf16_t*)(ws + O_KVT);
    bf16_t* Cst = (bf16_t*)(ws + O_BR + BRSZ); float* MLG = (float*)(ws + O_MLG); float* MLN = (float*)(ws + O_MLN); float* MLM = (float*)(ws + O_MLM);
    float* wsh = sm + w * 128;
    constexpr int SP = 136, BUFB = (128 + 32) * SP * 2 + 1024;
    unsigned char* sbase = (unsigned char*)sm + 4096;
#define MLS_ROW0(ci_) ({ const int _oc = dir == 0 ? (ci_) : ((ci_) < 2 ? 1 - (ci_) : 35 - (ci_)); _oc < 2 ? NLAT + b * CTXL + _oc * MLCH : b * SEQ + (_oc - 2) * MLCH; })
#define MLS_LOAD(ci_) do { const int _r0 = MLS_ROW0(ci_); \
        _Pragma("unroll") for (int k = 0; k < 4; ++k) { const int c = tid + 512 * k, r = c >> 4, cc = c & 15; kreg[k] = *(const u32x4*)(KVt + (size_t)(h * 128 + r) * MROWS + _r0 + cc * 8); } \
        { const int r = tid >> 4, cc = tid & 15; vreg = *(const u32x4*)(KVt + (size_t)(512 + h * 256 + slice * 32 + r) * MROWS + _r0 + cc * 8); } \
        greg = 0.f; if (tid < 256) greg = misc[(size_t)(_r0 + (tid & 127)) * NMISC + 64 + (dir * 2 + (tid >> 7)) * 4 + h]; } while (0)
#define MLS_STORE(buf_) do { unsigned char* _b = sbase + (buf_) * BUFB; \
        _Pragma("unroll") for (int k = 0; k < 4; ++k) { const int c = tid + 512 * k, r = c >> 4, cc = c & 15; *(u32x4*)(_b + (r * SP + cc * 8) * 2) = kreg[k]; } \
        { const int r = tid >> 4, cc = tid & 15; *(u32x4*)(_b + ((128 + r) * SP + cc * 8) * 2) = vreg; } \
        if (tid < 256) ((float*)(_b + 160 * SP * 2))[tid] = greg; } while (0)
    for (int u = vbid(); u < 256; u += lidx((int)gridDim.x)) {
        const int chain = u >> 3, slice = u & 7, dir = chain & 1, h = (chain >> 1) & 3, b = chain >> 3;
        const float bi = gin(a.in[lidx(I_MLGB)])[l * 16 + (dir * 2 + 0) * 4 + h], bf = gin(a.in[lidx(I_MLGB)])[l * 16 + (dir * 2 + 1) * 4 + h];
        const int i0 = 2 * lane, j0 = dir ? 127 - i0 : i0, j1 = dir ? 126 - i0 : i0 + 1;
        f32x4 acc[2] = {(f32x4){0.f, 0.f, 0.f, 0.f}, (f32x4){0.f, 0.f, 0.f, 0.f}};
        float nv = 0.f, m = 0.f;
        u32x4 kreg[4], vreg; float greg;
        __syncthreads();
        MLS_LOAD(0); __builtin_amdgcn_sched_barrier(0); MLS_STORE(0); __syncthreads();
#pragma unroll 1
        for (int ci = 0; ci < MLNC; ++ci) {
            const int row0 = MLS_ROW0(ci);
            if (ci + 1 < MLNC) MLS_LOAD(ci + 1);
            __builtin_amdgcn_sched_barrier(0);
            const unsigned char* cb_ = sbase + (ci & 1) * BUFB;
            const bf16_t* Ksh = (const bf16_t*)cb_; const bf16_t* Vsh = Ksh + 128 * SP; const float* gs = (const float*)(cb_ + 160 * SP * 2);
            const float li0 = gs[j0] + bi, li1 = gs[j1] + bi;
            const float lf0 = logsigmoidf_(gs[128 + j0] + bf), lf1 = logsigmoidf_(gs[128 + j1] + bf);
            const float S = scan_add_incl(lf0 + lf1, lane);
            const float G1 = S, G0 = S - lf1, a0 = li0 - G0, a1 = li1 - G1;
            const float pmx = scan_max_incl(fmaxf(a0, a1), lane);
            float prev = __shfl_up(pmx, 1); if (lane == 0) prev = -1e30f;
            const float pm0 = fmaxf(prev, a0), pm1 = pmx;
            const float Ftot = __shfl(S, 63), Ac = __shfl(pmx, 63);
            const float Mx = fmaxf(m, Ac), decay = __expf(m - Mx);
            asm volatile("s_waitcnt lgkmcnt(0)" ::: "memory");
            wsh[j0] = __expf(a0 - Mx); wsh[j1] = __expf(a1 - Mx);
            if (slice == 0 && w == 0) { const size_t o = (size_t)(dir * 4 + h) * MROWS + row0;
                MLG[o + j0] = G0; MLG[o + j1] = G1; MLG[(size_t)8 * MROWS + o + j0] = a0; MLG[(size_t)8 * MROWS + o + j1] = a1; MLG[(size_t)16 * MROWS + o + j0] = pm0; MLG[(size_t)16 * MROWS + o + j1] = pm1;
                if (lane == 0) MLM[chain * MLNC + ci] = m; }
            if (slice == 0 && q == 0) MLN[((size_t)chain * MLNC + ci) * 128 + 16 * w + cidx] = nv;
#pragma unroll
            for (int i = 0; i < 2; ++i)
#pragma unroll
                for (int r = 0; r < 4; ++r) Cst[(((size_t)chain * MLNC + ci) * 256 + slice * 32 + 16 * i + 4 * q + r) * 128 + 16 * w + cidx] = (bf16_t)(cvt_pk(acc[i][r], 0.f) & 0xffffu);
            asm volatile("s_waitcnt lgkmcnt(0)" ::: "memory");
            acc[0] *= decay; acc[1] *= decay;
            float nsum = 0.f;
#pragma unroll
            for (int ks = 0; ks < 4; ++ks) {
                const f32x4 w0 = *(const f32x4*)(wsh + 32 * ks + 8 * q), w1 = *(const f32x4*)(wsh + 32 * ks + 8 * q + 4);
                float kf[8]; unpack8(*(const bf16x8*)(Ksh + (16 * w + cidx) * SP + 32 * ks + 8 * q), kf);
#pragma unroll
                for (int e = 0; e < 4; ++e) { kf[e] *= w0[e]; kf[4 + e] *= w1[e]; nsum += kf[e] + kf[4 + e]; }
                const bf16x8 kb = pack8(kf);
#pragma unroll
                for (int i = 0; i < 2; ++i) acc[i] = mfma16(*(const bf16x8*)(Vsh + (16 * i + cidx) * SP + 32 * ks + 8 * q), kb, acc[i]);
            }
            nsum += __shfl_xor(nsum, 16); nsum += __shfl_xor(nsum, 32);
            nv = decay * nv + nsum;
            m = Ftot + Mx;
            __builtin_amdgcn_sched_barrier(0);
            if (ci + 1 < MLNC) MLS_STORE((ci + 1) & 1);
            __syncthreads();
        }
    }
#undef MLS_LOAD
#undef MLS_STORE
#undef MLS_ROW0
    __syncthreads();
}
__device__ __forceinline__ int s5_rowbase(int cc) { const int b = cc / S5NCH, ch = cc - b * S5NCH; const int r1 = NLAT + b * CTXL + ch * 64, r2 = b * SEQ + (ch - 4) * 64; return __builtin_amdgcn_readfirstlane(0) + ((ch < 4) ? r1 : r2); }
constexpr int UPITCH = 1032, XPITCH = 264;
__device__ __forceinline__ void s5_stage_u(const bf16_t* z1, bf16_t* Us, int g, int cb, int tid) {
    u32x4 tmp[4];
#pragma unroll
    for (int i = 0; i < 4; ++i) { const int c = tid + 512 * i, cc = c >> 7, j = (c >> 1) & 63, hf = c & 1;
        const int rowb = s5_rowbase(cb * 16 + cc);
        tmp[i] = *(const u32x4*)(z1 + (size_t)(rowb + j) * LDZ + ZU + g * 16 + 8 * hf); }
    __builtin_amdgcn_sched_barrier(0);
#pragma unroll
    for (int i = 0; i < 4; ++i) { const int c = tid + 512 * i, cc = c >> 7, j = (c >> 1) & 63, hf = c & 1;
        *(u32x4*)(Us + cc * UPITCH + j * 16 + 8 * hf) = tmp[i]; }
}
__device__ __forceinline__ void s5_pass1(unsigned char* ws, unsigned char* sm, int tid) {
    const int w = tid >> 6, lane = tid & 63, cidx = lane & 15, q = lane >> 4;
    const bf16_t* z1 = (const bf16_t*)(ws + O_Z1); const bf16_t* T1 = (const bf16_t*)(ws + O_T1); float* E = (float*)(ws + O_E);
    bf16_t* Us = (bf16_t*)sm;
    for (int u = vbid(); u < 64 * 17; u += lidx((int)gridDim.x)) {
        const int cb = u % 17, g = u / 17;
        const bf16_t* tp = T1 + (size_t)g * 256 * 1024 + (size_t)(2 * w) * 32 * 512 + lane * 8;
        const bf16_t* up = Us + cidx * UPITCH + 8 * q;
        bf16x8 fa[8][2], fb[8][2];
#define P1_LOAD(dst, ks0_) do { _Pragma("unroll") for (int i = 0; i < 8; ++i) { dst[i][0] = ldg8(tp + 512 * ((ks0_) + i)); dst[i][1] = ldg8(tp + 32 * 512 + 512 * ((ks0_) + i)); } } while (0)
#define P1_COMP(src, ks0_) do { _Pragma("unroll") for (int i = 0; i < 8; ++i) { const bf16x8 bfr = *(const bf16x8*)(up + 32 * ((ks0_) + i)); acc[0] = mfma16(src[i][0], bfr, acc[0]); acc[1] = mfma16(src[i][1], bfr, acc[1]); } } while (0)
        __syncthreads();
        P1_LOAD(fa, 0);
        s5_stage_u(z1, Us, g, cb, tid);
        __syncthreads();
        f32x4 acc[2] = {(f32x4){0.f, 0.f, 0.f, 0.f}, (f32x4){0.f, 0.f, 0.f, 0.f}};
        P1_LOAD(fb, 8); __builtin_amdgcn_sched_barrier(0);
        P1_COMP(fa, 0); __builtin_amdgcn_sched_barrier(0);
        P1_LOAD(fa, 16); __builtin_amdgcn_sched_barrier(0);
        P1_COMP(fb, 8); __builtin_amdgcn_sched_barrier(0);
        P1_LOAD(fb, 24); __builtin_amdgcn_sched_barrier(0);
        P1_COMP(fa, 16); __builtin_amdgcn_sched_barrier(0);
        P1_COMP(fb, 24); __builtin_amdgcn_sched_barrier(0);
#undef P1_LOAD
#undef P1_COMP
        const int cc = cb * 16 + cidx;
        *(f32x4*)(E + ((size_t)g * S5COLS + cc) * 256 + (w * 2) * 16 + 4 * q) = acc[0];
        *(f32x4*)(E + ((size_t)g * S5COLS + cc) * 256 + (w * 2 + 1) * 16 + 4 * q) = acc[1];
    }
    __syncthreads();
}
__device__ __forceinline__ void s5_scan(unsigned char* ws, int l, int tid) {
    const f32x2* lamp = (const f32x2*)(ws + O_LAMP) + (size_t)l * 64 * 2 * 65 * 64; const float* E = (const float*)(ws + O_E); bf16_t* X = (bf16_t*)(ws + O_X);
    for (int idx = lidx((int)blockIdx.x) * 512 + tid; idx < 64 * 4 * 2 * 64; idx += lidx((int)gridDim.x) * 512) {
        const int n = idx & 63, dir = (idx >> 6) & 1, b = (idx >> 7) & 3, g = idx >> 9;
        const f32x2 l64 = lamp[((g * 2 + dir) * 65 + 64) * 64 + n];
        float xr = 0.f, xi = 0.f;
#pragma unroll 1
        for (int s0 = 0; s0 < S5NCH; s0 += 17) {
            f32x2 ev[17];
#pragma unroll
            for (int k = 0; k < 17; ++k) { const int step = s0 + k, ch = dir == 0 ? step : (step < 4 ? 3 - step : 71 - step);
                ev[k] = *(const f32x2*)(E + ((size_t)g * S5COLS + b * S5NCH + ch) * 256 + dir * 128 + 2 * n); }
            __builtin_amdgcn_sched_barrier(0);
#pragma unroll
            for (int k = 0; k < 17; ++k) { const int step = s0 + k, ch = dir == 0 ? step : (step < 4 ? 3 - step : 71 - step);
                const size_t o = ((size_t)g * S5COLS + b * S5NCH + ch) * 256 + dir * 128 + 2 * n;
                *(unsigned*)(X + o) = cvt_pk(xr, xi);
                const float nr = l64.x * xr - l64.y * xi + ev[k].x, ni = l64.x * xi + l64.y * xr + ev[k].y; xr = nr; xi = ni; }
        }
    }
}
__device__ __forceinline__ float gelu_tanh(float x) { const float u = 0.7978845608028654f * (x + 0.044715f * x * x * x); return 0.5f * x * (1.f + tanhf(u)); }
__device__ __forceinline__ void s5_pass2(unsigned char* ws, unsigned char* sm, int tid) {
    const int w = tid >> 6, lane = tid & 63, cidx = lane & 15, q = lane >> 4;
    const bf16_t* z1 = (const bf16_t*)(ws + O_Z1); const bf16_t* T2 = (const bf16_t*)(ws + O_T2); const bf16_t* KC = (const bf16_t*)(ws + O_KC); const bf16_t* X = (const bf16_t*)(ws + O_X);
    bf16_t* Gs = (bf16_t*)(ws + O_GS);
    bf16_t* Us = (bf16_t*)sm; bf16_t* Xs = Us + 16 * UPITCH; bf16_t* KCs = Xs + 16 * XPITCH;
    for (int u = vbid(); u < 64 * 17; u += lidx((int)gridDim.x)) {
        const int cb = u % 17, g = u / 17;
        const bf16_t* xp = Xs + cidx * XPITCH + 8 * q;
        const bf16_t* tp = T2 + (size_t)g * 1024 * 256 + (size_t)(8 * w) * 8 * 512 + lane * 8;
        bf16x8 fa[2][8], fb[2][8];
#define P2_LOAD(dst, ks0_) do { _Pragma("unroll") for (int i = 0; i < 2; ++i) _Pragma("unroll") for (int tb = 0; tb < 8; ++tb) dst[i][tb] = ldg8(tp + (size_t)tb * 8 * 512 + 512 * ((ks0_) + i)); } while (0)
#define P2_COMP(src, ks0_) do { _Pragma("unroll") for (int i = 0; i < 2; ++i) { const bf16x8 bfr = *(const bf16x8*)(xp + 32 * ((ks0_) + i)); \
            _Pragma("unroll") for (int tb = 0; tb < 8; ++tb) acc[tb] = mfma16(src[i][tb], bfr, acc[tb]); } } while (0)
        __syncthreads();
        P2_LOAD(fa, 0);
        s5_stage_u(z1, Us, g, cb, tid);
        { u32x4 kt[8]; const int cc = tid >> 5, part = tid & 31; const u32x4 xt = *(const u32x4*)(X + ((size_t)g * S5COLS + cb * 16 + cc) * 256 + part * 8);
#pragma unroll
          for (int i = 0; i < 8; ++i) { const int c = tid + 512 * i; kt[i] = *(const u32x4*)(KC + (size_t)g * 128 * 256 + c * 8); }
          __builtin_amdgcn_sched_barrier(0);
          *(u32x4*)(Xs + cc * XPITCH + part * 8) = xt;
#pragma unroll
          for (int i = 0; i < 8; ++i) { const int c = tid + 512 * i; *(u32x4*)(KCs + c * 8) = kt[i]; } }
        __syncthreads();
        f32x4 acc[8];
#pragma unroll
        for (int i = 0; i < 8; ++i) acc[i] = (f32x4){0.f, 0.f, 0.f, 0.f};
        const bf16_t* kp = KCs + (63 - (q >> 1) + 8 * w) * 256 + cidx * 16 + 8 * (q & 1);
        const bf16_t* up = Us + cidx * UPITCH + 8 * q;
#pragma unroll 4
        for (int ks = 0; ks < 32; ++ks) {
            const bf16x8 bfr = *(const bf16x8*)(up + 32 * ks);
#pragma unroll
            for (int tb = 0; tb < 8; ++tb) acc[tb] = mfma16(*(const bf16x8*)(kp + (tb - 2 * ks) * 256), bfr, acc[tb]);
        }
        __builtin_amdgcn_sched_barrier(0);
        P2_LOAD(fb, 2); __builtin_amdgcn_sched_barrier(0);
        P2_COMP(fa, 0); __builtin_amdgcn_sched_barrier(0);
        P2_LOAD(fa, 4); __builtin_amdgcn_sched_barrier(0);
        P2_COMP(fb, 2); __builtin_amdgcn_sched_barrier(0);
        P2_LOAD(fb, 6); __builtin_amdgcn_sched_barrier(0);
        P2_COMP(fa, 4); __builtin_amdgcn_sched_barrier(0);
        P2_COMP(fb, 6); __builtin_amdgcn_sched_barrier(0);
#undef P2_LOAD
#undef P2_COMP
        const int rowb = s5_rowbase(cb * 16 + cidx);
#pragma unroll
        for (int tb = 0; tb < 8; ++tb) { u32x2 o; o.x = cvt_pk(gelu_tanh(acc[tb][0]), gelu_tanh(acc[tb][1])); o.y = cvt_pk(gelu_tanh(acc[tb][2]), gelu_tanh(acc[tb][3]));
            *(u32x2*)(Gs + (size_t)(rowb + 8 * w + tb) * 1024 + g * 16 + 4 * q) = o; }
    }
    __syncthreads();
}
__device__ __forceinline__ void qk_prep(const Args& a, unsigned char* ws, int l, int gw, int NGW, int lane) {
    const int h = lane >> 3, sub = lane & 7;
    const float* misc = (const float*)(ws + O_MISC);
    for (int it = gw; it < MROWS * 2; it += NGW) {
        const int row = it >> 1, which = it & 1;
        bf16_t* p = (bf16_t*)(ws + (which ? O_K : O_Q)) + (size_t)row * 1536 + h * 192 + 8 * sub;
        const float* gn = (which ? gin(a.in[lidx(I_KNG)]) : gin(a.in[lidx(I_QNG)])) + l * 192 + 8 * sub;
        float v[3][8];
        unpack8(*(const bf16x8*)p, v[0]); unpack8(*(const bf16x8*)(p + 64), v[1]);
        if (which) { const f32x4 k0 = *(const f32x4*)(misc + (size_t)row * NMISC + 8 * sub), k1 = *(const f32x4*)(misc + (size_t)row * NMISC + 8 * sub + 4);
#pragma unroll
            for (int e = 0; e < 4; ++e) { v[2][e] = k0[e]; v[2][4 + e] = k1[e]; } }
        else unpack8(*(const bf16x8*)(p + 128), v[2]);
        float s = 0.f;
#pragma unroll
        for (int j = 0; j < 3; ++j)
#pragma unroll
            for (int e = 0; e < 8; ++e) s += v[j][e] * v[j][e];
        s += __shfl_xor(s, 1); s += __shfl_xor(s, 2); s += __shfl_xor(s, 4);
        const float rs = rsqrtf(s * (1.f / 192.f) + EPS);
#pragma unroll
        for (int j = 0; j < 3; ++j)
#pragma unroll
            for (int e = 0; e < 8; ++e) v[j][e] = v[j][e] * rs * gn[64 * j + e];
        if (row < NLAT) {
            const int t = row & (SEQ - 1);
            const int pos = (sub >> 2) ? (t & 63) : (t >> 6);
            const f32x2* rp = (const f32x2*)(ws + O_ROPE) + pos * 16 + 8 * (sub & 1);
            f32x2 cs8[8];
#pragma unroll
            for (int e = 0; e < 8; ++e) cs8[e] = rp[e];
#pragma unroll
            for (int e = 0; e < 8; ++e) {
                const float partner = __shfl_xor(v[2][e], 2);
                v[2][e] = (sub & 2) ? (v[2][e] * cs8[e].x + partner * cs8[e].y) : (v[2][e] * cs8[e].x - partner * cs8[e].y);
            }
        }
        *(bf16x8*)p = pack8(v[0]); *(bf16x8*)(p + 64) = pack8(v[1]); *(bf16x8*)(p + 128) = pack8(v[2]);
    }
}

__device__ __forceinline__ void ml_out_pass(const Args& a, unsigned char* ws, unsigned char* sm, int l, bool with_ctx, int tid) {
    const int w = tid >> 6, lane = tid & 63, cidx = lane & 15, q = lane >> 4;
    const bf16_t* z1 = (const bf16_t*)(ws + O_Z1); const bf16_t* KVt = (const bf16_t*)(ws + O_KVT); const bf16_t* Cst = (const bf16_t*)(ws + O_BR + BRSZ);
    const float* MLG = (const float*)(ws + O_MLG); const float* MLN = (const float*)(ws + O_MLN); const float* MLM = (const float*)(ws + O_MLM);
    bf16_t* BRa = (bf16_t*)(ws + O_BR);
    constexpr int KP = 136;
    bf16_t* Ks = (bf16_t*)sm; float* As = (float*)(sm + 128 * KP * 2);
    const float scale = 0.08838834764831845f;
    for (int u = vbid(); u < 4 * 4 * MLNC; u += lidx((int)gridDim.x)) {
        const int oc = u % MLNC, h = (u / MLNC) & 3, b = u / (4 * MLNC);
        if (!with_ctx && oc < 2) continue;
        const int row0 = oc < 2 ? NLAT + b * CTXL + oc * MLCH : b * SEQ + (oc - 2) * MLCH;
        const int rb = w, t = 16 * rb + cidx;
        __syncthreads();
        { u32x4 kt[4];
#pragma unroll
          for (int i = 0; i < 4; ++i) { const int c = tid + 512 * i, r = c >> 4, cc = c & 15; kt[i] = *(const u32x4*)(z1 + (size_t)(row0 + r) * LDZ + ZK + h * 128 + cc * 8); }
          float av = 0.f; if (tid < 256) av = MLG[(size_t)(8 + (tid >> 7) * 4 + h) * MROWS + row0 + (tid & 127)];
          __builtin_amdgcn_sched_barrier(0);
#pragma unroll
          for (int i = 0; i < 4; ++i) { const int c = tid + 512 * i, r = c >> 4, cc = c & 15; *(u32x4*)(Ks + r * KP + cc * 8) = kt[i]; }
          if (tid < 256) As[tid] = av; }
        bf16x8 qf[4];
#pragma unroll
        for (int ks = 0; ks < 4; ++ks) qf[ks] = ldg8(z1 + (size_t)(row0 + t) * LDZ + ZQ + h * 128 + 32 * ks + 8 * q);
        __syncthreads();
        bf16x8 pf[2][4]; float inv2[2], wsc2[2];
#pragma unroll
        for (int dir = 0; dir < 2; ++dir) {
            const int chain = (b * 4 + h) * 2 + dir, ci = dir == 0 ? oc : (oc < 2 ? 1 - oc : 35 - oc);
            const float mc = MLM[chain * MLNC + ci];
            const float* Gp = MLG + (size_t)(dir * 4 + h) * MROWS + row0; const float* pp = Gp + (size_t)16 * MROWS;
            const float Gt = Gp[t], Mt = fmaxf(mc, pp[t]);
            f32x4 nq[4][2];
            { const float* np = MLN + ((size_t)chain * MLNC + ci) * 128 + 8 * q;
#pragma unroll
              for (int ks = 0; ks < 4; ++ks) { nq[ks][0] = *(const f32x4*)(np + 32 * ks); nq[ks][1] = *(const f32x4*)(np + 32 * ks + 4); } }
            __builtin_amdgcn_sched_barrier(0);
            const float winter = __expf(mc - Mt);
            float qn = 0.f;
#pragma unroll
            for (int ks = 0; ks < 4; ++ks) { float qv[8]; unpack8(qf[ks], qv);
#pragma unroll
                for (int e = 0; e < 4; ++e) qn += qv[e] * nq[ks][0][e] + qv[4 + e] * nq[ks][1][e]; }
            qn += __shfl_xor(qn, 16); qn += __shfl_xor(qn, 32);
            float rsum = 0.f;
#pragma unroll
            for (int i = 0; i < 4; ++i) {
                float pv[8];
#pragma unroll
                for (int hb = 0; hb < 2; ++hb) {
                    const int kb = 2 * i + hb;
                    const bool skip = dir == 0 ? (kb > rb) : (kb < rb);
                    f32x4 sacc = (f32x4){0.f, 0.f, 0.f, 0.f};
                    if (!(a.sub & 16))
#pragma unroll
                    for (int ks = 0; ks < 4; ++ks) sacc = mfma16(*(const bf16x8*)(Ks + (16 * kb + cidx) * KP + 32 * ks + 8 * q), qf[ks], sacc);
                    const f32x4 a4 = *(const f32x4*)(As + dir * 128 + 16 * kb + 4 * q);
#pragma unroll
                    for (int r = 0; r < 4; ++r) {
                        const int sidx = 16 * kb + 4 * q + r;
                        const bool valid = !skip && (dir == 0 ? (sidx <= t) : (sidx >= t));
                        const float e = __expf(fminf(a4[r] - Mt, 0.f));
                        const float val = valid ? sacc[r] * scale * e : 0.f;
                        pv[hb * 4 + r] = val; rsum += val;
                    }
                }
                pf[dir][i] = pack8(pv);
            }
            rsum += __shfl_xor(rsum, 16); rsum += __shfl_xor(rsum, 32);
            const float den = winter * qn * scale + rsum;
            inv2[dir] = 1.f / fmaxf(fabsf(den), __expf(-(Gt + Mt)));
            wsc2[dir] = winter * scale;
        }
        float ss = 0.f;
        bf16_t* dp = BRa + (size_t)(row0 + t) * 1024 + h * 256 + 4 * q;
        const int ci0 = oc, ci1 = oc < 2 ? 1 - oc : 35 - oc;
        constexpr int SP = 136, SBUF = 64 * SP;
        bf16_t* stg = (bf16_t*)(sm + 36864);
        const bf16_t* cg0 = Cst + ((size_t)((b * 4 + h) * 2 + 0) * MLNC + ci0) * 256 * 128;
        const bf16_t* cg1 = Cst + ((size_t)((b * 4 + h) * 2 + 1) * MLNC + ci1) * 256 * 128;
        const bf16_t* vg = KVt + (size_t)(512 + h * 256) * MROWS + row0;
        u32x4 sreg[6];
#define MLO_SLOAD(s_) do { _Pragma("unroll") for (int k = 0; k < 6; ++k) { const int c = tid + 512 * k, which = c >> 10, idx = c & 1023, r = idx >> 4, cc = idx & 15; \
            const bf16_t* src = which == 0 ? cg0 + (size_t)(64 * (s_) + r) * 128 + cc * 8 : (which == 1 ? cg1 + (size_t)(64 * (s_) + r) * 128 + cc * 8 : vg + (size_t)(64 * (s_) + r) * MROWS + cc * 8); \
            sreg[k] = *(const u32x4*)src; } } while (0)
#define MLO_SSTORE(buf_) do { _Pragma("unroll") for (int k = 0; k < 6; ++k) { const int c = tid + 512 * k, which = c >> 10, idx = c & 1023, r = idx >> 4, cc = idx & 15; \
            *(u32x4*)(stg + (buf_) * 3 * SBUF + which * SBUF + r * SP + cc * 8) = sreg[k]; } } while (0)
        MLO_SLOAD(0); __builtin_amdgcn_sched_barrier(0); MLO_SSTORE(0); __syncthreads();
#pragma unroll 1
        for (int st = 0; st < ((a.sub & 8) ? 0 : 4); ++st) {
            if (st + 1 < 4) MLO_SLOAD(st + 1);
            __builtin_amdgcn_sched_barrier(0);
            const bf16_t* sb = stg + (st & 1) * 3 * SBUF;
#pragma unroll
            for (int d4 = 0; d4 < 4; ++d4) {
                f32x4 hsum = (f32x4){0.f, 0.f, 0.f, 0.f};
                const bf16_t* vrow = sb + 2 * SBUF + (16 * d4 + cidx) * SP + 4 * q;
#pragma unroll
                for (int dir = 0; dir < 2; ++dir) {
                    const bf16_t* crow = sb + dir * SBUF + (16 * d4 + cidx) * SP + 8 * q;
                    f32x4 acc = (f32x4){0.f, 0.f, 0.f, 0.f};
#pragma unroll
                    for (int ks = 0; ks < 4; ++ks) acc = mfma16(*(const bf16x8*)(crow + 32 * ks), qf[ks], acc);
                    acc *= wsc2[dir];
#pragma unroll
                    for (int i = 0; i < 4; ++i) { const u32x2 lo = *(const u32x2*)(vrow + 32 * i), hi = *(const u32x2*)(vrow + 32 * i + 16);
                        const u32x4 av = (u32x4){lo.x, lo.y, hi.x, hi.y}; acc = mfma16(__builtin_bit_cast(bf16x8, av), pf[dir][i], acc); }
                    hsum += acc * inv2[dir];
                }
                ss += hsum[0] * hsum[0] + hsum[1] * hsum[1] + hsum[2] * hsum[2] + hsum[3] * hsum[3];
                u32x2 r_; r_.x = cvt_pk(hsum[0], hsum[1]); r_.y = cvt_pk(hsum[2], hsum[3]); *(u32x2*)(dp + 16 * (4 * st + d4)) = r_;
            }
            __builtin_amdgcn_sched_barrier(0);
            if (st + 1 < 4) MLO_SSTORE((st + 1) & 1);
            __syncthreads();
        }
#undef MLO_SLOAD
#undef MLO_SSTORE
        ss += __shfl_xor(ss, 16); ss += __shfl_xor(ss, 32);
        const float rs = rsqrtf(ss * (1.f / 256.f) + EPS);
        const float* ng = gin(a.in[lidx(I_MLNG)]) + (size_t)l * 1024 + h * 256 + 4 * q;
        const bf16_t* op = z1 + (size_t)(row0 + t) * LDZ + ZO + h * 256 + 4 * q;
#pragma unroll 1
        for (int i0 = 0; i0 < 16; i0 += 4) {
            u32x2 ov[4], hv[4]; f32x4 g4[4];
#pragma unroll
            for (int k = 0; k < 4; ++k) { ov[k] = *(const u32x2*)(op + 16 * (i0 + k)); g4[k] = *(const f32x4*)(ng + 16 * (i0 + k)); hv[k] = *(const u32x2*)(dp + 16 * (i0 + k)); }
            __builtin_amdgcn_sched_barrier(0);
#pragma unroll
            for (int k = 0; k < 4; ++k) {
                const float o0 = __uint_as_float(ov[k].x << 16), o1 = __uint_as_float(ov[k].x & 0xffff0000u), o2 = __uint_as_float(ov[k].y << 16), o3 = __uint_as_float(ov[k].y & 0xffff0000u);
                const float h0 = __uint_as_float(hv[k].x << 16), h1 = __uint_as_float(hv[k].x & 0xffff0000u), h2 = __uint_as_float(hv[k].y << 16), h3 = __uint_as_float(hv[k].y & 0xffff0000u);
                u32x2 r; r.x = cvt_pk(h0 * rs * g4[k][0] * sigmoidf_(o0), h1 * rs * g4[k][1] * sigmoidf_(o1)); r.y = cvt_pk(h2 * rs * g4[k][2] * sigmoidf_(o2), h3 * rs * g4[k][3] * sigmoidf_(o3));
                *(u32x2*)(dp + 16 * (i0 + k)) = r;
            }
        }
    }
    __syncthreads();
}

constexpr int VPITCH = 72, KTILE_B = 64 * 24 * 16, VTILE_B = 128 * VPITCH * 2;
__device__ __forceinline__ void attn_phase(unsigned char* ws, unsigned char* sm, bool with_ctx, int tid) {
    const int w = tid >> 6, lane = tid & 63, cidx = lane & 15, q = lane >> 4;
    const bf16_t* Q = (const bf16_t*)(ws + O_Q); const bf16_t* K = (const bf16_t*)(ws + O_K); const bf16_t* Vt = (const bf16_t*)(ws + O_VTA);
    bf16_t* out = (bf16_t*)(ws + O_BR + BRSZ);
    const float C = 0.07216878364870322f * 1.4426950408889634f;
    const int nunits = 512 + (with_ctx ? 32 : 0);
    for (int u = vbid(); u < nunits; u += lidx((int)gridDim.x)) {
        int b, h, qrow0, ntiles;
        if (u < 512) { b = u >> 7; h = (u >> 4) & 7; qrow0 = b * SEQ + (u & 15) * 256; ntiles = 68; }
        else { const int uu = u - 512; b = uu >> 3; h = uu & 7; qrow0 = NLAT + b * CTXL; ntiles = 4; }
        bf16x8 qf[2][6];
#pragma unroll
        for (int qq = 0; qq < 2; ++qq)
#pragma unroll
            for (int ks = 0; ks < 6; ++ks) qf[qq][ks] = ldg8(Q + (size_t)(qrow0 + 32 * w + 16 * qq + cidx) * 1536 + h * 192 + 32 * ks + 8 * q);
        f32x4 o[8][2];
#pragma unroll
        for (int i = 0; i < 8; ++i) { o[i][0] = (f32x4){0.f, 0.f, 0.f, 0.f}; o[i][1] = (f32x4){0.f, 0.f, 0.f, 0.f}; }
        float mrun[2] = {-1e30f, -1e30f}, lsum[2] = {0.f, 0.f};
        unsigned koff[4], voff[3];
#pragma unroll
        for (int i = 0; i < 3; ++i) { const int L = (w + 8 * i) * 64 + lane, r = L / 24, cl = L - r * 24, cc = cl ^ (r & 7); koff[i] = (unsigned)((r * 1536 + h * 192 + cc * 8) * 2); }
        koff[3] = 0u;
#pragma unroll
        for (int i = 0; i < 3; ++i) { const int c = (w + 8 * i) * 64 + lane, r = c / 9; int cc = c - r * 9; if (cc == 8) cc = 0; voff[i] = (unsigned)(((h * 128 + r) * MROWS + cc * 8) * 2); }
#define ATT_LOAD(j, buf) do { const int _kr = (j) < 4 ? NLAT + b * CTXL + 64 * (j) : b * SEQ + 64 * ((j) - 4); \
        const char* _kg = (const char*)(K + (size_t)_kr * 1536); const char* _vg = (const char*)(Vt + _kr); \
        LAS unsigned char* _kb = (LAS unsigned char*)sm + (buf) * (KTILE_B + VTILE_B); LAS unsigned char* _vb = _kb + KTILE_B; \
        _Pragma("unroll") for (int _i = 0; _i < 3; ++_i) __builtin_amdgcn_global_load_lds((const unsigned*)(_kg + koff[_i]), (LAS unsigned*)(_kb + (w + 8 * _i) * 1024), 16, 0, 0); \
        _Pragma("unroll") for (int _i = 0; _i < 3; ++_i) if (w + 8 * _i < 18) __builtin_amdgcn_global_load_lds((const unsigned*)(_vg + voff[_i]), (LAS unsigned*)(_vb + (w + 8 * _i) * 1024), 16, 0, 0); } while (0)
#define ATT_STORE(buf) do { } while (0)
        ATT_LOAD(0, 0); asm volatile("s_waitcnt vmcnt(0)" ::: "memory"); __syncthreads();
        for (int j = 0; j < ntiles; ++j) {
            if (j + 1 < ntiles) ATT_LOAD(j + 1, (j + 1) & 1);
            const unsigned char* kb_ = sm + (j & 1) * (KTILE_B + VTILE_B); const unsigned char* vb_ = kb_ + KTILE_B;
            f32x4 s[4][2];
#pragma unroll
            for (int kb = 0; kb < 4; ++kb) { s[kb][0] = (f32x4){0.f, 0.f, 0.f, 0.f}; s[kb][1] = (f32x4){0.f, 0.f, 0.f, 0.f};
#pragma unroll
                for (int ks = 0; ks < 6; ++ks) { const bf16x8 af = *(const bf16x8*)(kb_ + ((16 * kb + cidx) * 24 + ((4 * ks + q) ^ (cidx & 7))) * 16);
                    s[kb][0] = mfma16(af, qf[0][ks], s[kb][0]); s[kb][1] = mfma16(af, qf[1][ks], s[kb][1]); } }
            bf16x8 pf[2][2];
#pragma unroll
            for (int qq = 0; qq < 2; ++qq) {
                float mx = fmaxf(fmaxf(s[0][qq][0], s[0][qq][1]), fmaxf(s[0][qq][2], s[0][qq][3]));
#pragma unroll
                for (int kb = 1; kb < 4; ++kb) mx = fmaxf(mx, fmaxf(fmaxf(s[kb][qq][0], s[kb][qq][1]), fmaxf(s[kb][qq][2], s[kb][qq][3])));
                if (!__all(mx - mrun[qq] <= 110.851251684f)) {
                    mx = fmaxf(mx, __shfl_xor(mx, 16)); mx = fmaxf(mx, __shfl_xor(mx, 32));
                    const float mnew = fmaxf(mrun[qq], mx), alpha = __builtin_amdgcn_exp2f((mrun[qq] - mnew) * C);
                    mrun[qq] = mnew; lsum[qq] *= alpha;
#pragma unroll
                    for (int i = 0; i < 8; ++i) o[i][qq] *= alpha;
                }
                const float mc = mrun[qq] * C;
                float ps = 0.f; float pv[4][4];
#pragma unroll
                for (int kb = 0; kb < 4; ++kb)
#pragma unroll
                    for (int r = 0; r < 4; ++r) { pv[kb][r] = __builtin_amdgcn_exp2f(fmaf(s[kb][qq][r], C, -mc)); ps += pv[kb][r]; }
                lsum[qq] += ps;
#pragma unroll
                for (int i = 0; i < 2; ++i) { u32x4 pw; pw.x = cvt_pk(pv[2 * i][0], pv[2 * i][1]); pw.y = cvt_pk(pv[2 * i][2], pv[2 * i][3]); pw.z = cvt_pk(pv[2 * i + 1][0], pv[2 * i + 1][1]); pw.w = cvt_pk(pv[2 * i + 1][2], pv[2 * i + 1][3]);
                    pf[qq][i] = __builtin_bit_cast(bf16x8, pw); }
            }
#pragma unroll
            for (int dvb = 0; dvb < 8; ++dvb)
#pragma unroll
                for (int i = 0; i < 2; ++i) {
                    const unsigned char* vq = vb_ + ((16 * dvb + cidx) * VPITCH + 32 * i + 4 * q) * 2;
                    const u32x2 lo = *(const u32x2*)vq; asm volatile("" ::: "memory"); const u32x2 hi = *(const u32x2*)(vq + 32); asm volatile("" ::: "memory");
                    const bf16x8 af = __builtin_bit_cast(bf16x8, ((u32x4){lo.x, lo.y, hi.x, hi.y}));
                    o[dvb][0] = mfma16(af, pf[0][i], o[dvb][0]); o[dvb][1] = mfma16(af, pf[1][i], o[dvb][1]);
                }
            asm volatile("s_waitcnt vmcnt(0)" ::: "memory");
            __syncthreads();
        }
#pragma unroll
        for (int qq = 0; qq < 2; ++qq) {
            float lt = lsum[qq]; lt += __shfl_xor(lt, 16); lt += __shfl_xor(lt, 32);
            const float inv = 1.f / lt;
            bf16_t* dp = out + (size_t)(qrow0 + 32 * w + 16 * qq + cidx) * 1024 + h * 128 + 4 * q;
#pragma unroll
            for (int dvb = 0; dvb < 8; ++dvb) { u32x2 r; r.x = cvt_pk(o[dvb][qq][0] * inv, o[dvb][qq][1] * inv); r.y = cvt_pk(o[dvb][qq][2] * inv, o[dvb][qq][3] * inv); *(u32x2*)(dp + 16 * dvb) = r; }
        }
    }
#undef ATT_LOAD
#undef ATT_STORE
}


#define XB_TMO      128
#define XB_XCNT(j)  (256  + 64 * (j))
#define XB_XSUB(j)  (1280 + 64 * (j))
#define XB_XGEN(j)  (2304 + 64 * (j))
#define XB_TOP      3328
#define XB_TOPGEN   3392
#define XCD_BAR_WORDS 3456
#define XB_SPIN_CAP (1u << 18)
__device__ __forceinline__ unsigned xb_ld(unsigned* p)              { return __hip_atomic_load(p, __ATOMIC_RELAXED, __HIP_MEMORY_SCOPE_AGENT); }
__device__ __forceinline__ unsigned xb_add(unsigned* p, unsigned v) { return __hip_atomic_fetch_add(p, v, __ATOMIC_RELAXED, __HIP_MEMORY_SCOPE_AGENT); }
__device__ __forceinline__ unsigned xb_xcc_id() { return (unsigned)__builtin_amdgcn_s_getreg((3 << 11) | 20) & 0xFu; }
#define XB_SPIN(cond, bar) do { unsigned _sp = 0; while (cond) { __builtin_amdgcn_s_sleep(1); \
    if ((++_sp & 255u) == 0u) { if (xb_ld(&(bar)[XB_TMO])) break; if (_sp > XB_SPIN_CAP) { atomicAdd(&(bar)[XB_TMO], 1u); break; } } } } while (0)
struct XcdBarrier { unsigned* bar; unsigned x; volatile LAS unsigned* st; };
__device__ __forceinline__ XcdBarrier xcd_barrier_post(unsigned* bar, volatile LAS unsigned* st) {
    XcdBarrier b; b.bar = bar; b.x = xb_xcc_id(); b.st = st;
    if (threadIdx.x == 0) (void)xb_add(&bar[XB_XCNT(b.x)], 1u);
    return b;
}
__device__ __forceinline__ void xcd_barrier_complete(unsigned* bar, unsigned x, unsigned& nloc, unsigned& nx) {
    const unsigned G = gridDim.x * gridDim.y * gridDim.z;
    unsigned sum, cnt, mine, sp = 0u;
    for (;;) {
        sum = 0u; cnt = 0u; mine = 0u;
#pragma unroll
        for (unsigned j = 0; j < 16; ++j) { const unsigned c = xb_ld(&bar[XB_XCNT(j)]); sum += c; cnt += (c > 0u) ? 1u : 0u; mine = (j == x) ? c : mine; }
        if (sum == G) break;
        __builtin_amdgcn_s_sleep(1);
        if ((++sp & 255u) == 0u) { if (xb_ld(&bar[XB_TMO])) break; if (sp > XB_SPIN_CAP) { atomicAdd(&bar[XB_TMO], 1u); break; } }
    }
    nloc = mine > 0u ? mine : 1u; nx = cnt > 0u ? cnt : 1u;
}
__device__ __forceinline__ void xcd_barrier(const XcdBarrier& b) {
    asm volatile("s_waitcnt vmcnt(0)" ::: "memory");
    __syncthreads();
    if (threadIdx.x == 0) {
        unsigned* bar = b.bar;
        __builtin_amdgcn_s_waitcnt(0);
        unsigned nloc = b.st[0], nx = b.st[1];
        if (nloc == 0u) { xcd_barrier_complete(bar, b.x, nloc, nx); b.st[0] = nloc; b.st[1] = nx; }
        const unsigned old = xb_add(&bar[XB_XSUB(b.x)], 1u);
        const unsigned gen = old / nloc;
        if (old + 1u == (gen + 1u) * nloc) {
            __builtin_amdgcn_fence(__ATOMIC_RELEASE, "agent");
            asm volatile("s_waitcnt vmcnt(0)" ::: "memory");
            const unsigned og = xb_add(&bar[XB_TOP], 1u);
            const unsigned tg = og / nx;
            if (og + 1u == (tg + 1u) * nx) xb_add(&bar[XB_TOPGEN], 1u);
            else XB_SPIN(xb_ld(&bar[XB_TOPGEN]) == tg, bar);
            __builtin_amdgcn_fence(__ATOMIC_ACQUIRE, "agent");
            xb_add(&bar[XB_XGEN(b.x)], 1u);
            asm volatile("s_waitcnt vmcnt(0)" ::: "memory");
        } else {
            XB_SPIN(xb_ld(&bar[XB_XGEN(b.x)]) == gen, bar);
            __builtin_amdgcn_fence(__ATOMIC_ACQUIRE, "agent");
            asm volatile("s_waitcnt vmcnt(0)" ::: "memory");
        }
    }
    __syncthreads();
}

constexpr int LDS_BYTES = 147456;
constexpr int NPHASE = 25;
constexpr int PROBE_LO = -1, PROBE_HI = -1, PROBE_SUB = 7;
__global__ void __launch_bounds__(512, 2) mega(Args a) {
    extern __shared__ __attribute__((aligned(16))) unsigned char lds[];
    cg::grid_group grid = cg::this_grid();
    const int NGW = lidx((int)gridDim.x) * 8;
#define tid (ltid())
#define lane (ltid() & 63)
#define gw ((int)(lidx((int)blockIdx.x) * 8 + (ltid() >> 6)))
unsigned char* const wsraw_ = (unsigned char*)a.ws;
#define ws (lptr(a.ws))
    LAS unsigned char* ldsl = (LAS unsigned char*)lds;
    const int lo = a.ph_lo, hi = a.ph_hi;
#define IN(p) ((p) >= lo && (p) < hi)
    volatile LAS unsigned* xst = (volatile LAS unsigned*)(ldsl + LDS_BYTES - 64);
    if (threadIdx.x < 2) xst[threadIdx.x] = 0u;
    __syncthreads();
    const XcdBarrier xbar = xcd_barrier_post((unsigned*)(wsraw_ + O_BARW) + a.bar_region * 4096, xst);
#define SEAM(p) do { if ((p) + 1 < hi) { if ((p) == 0) grid.sync(); else xcd_barrier(xbar); } } while (0)
    if (IN(0)) { phase0(a, ws, (float*)lds, tid); SEAM(0); }
    const int G = lidx((int)gridDim.x), cb = lidx((int)blockIdx.x);
    float* outl = (float*)a.out; float* outc = (float*)(ws + O_CTXX);
#pragma unroll 1
    for (int l = 0; l < 2; ++l) {
        const int P = 1 + 12 * l;
        const bool wctx = (l == 0);
        const int Mlate = wctx ? MROWS : NLAT;
        const float* xl = l == 0 ? gin(a.in[lidx(I_X)]) : outl; const float* xc = l == 0 ? gin(a.in[lidx(I_CTX)]) : outc;
        const float* modl = (const float*)(ws + O_MOD) + (size_t)l * 5 * 12288;
        const bf16_t* HX = (const bf16_t*)(ws + O_HX); const bf16_t* Z1 = (const bf16_t*)(ws + O_Z1);
        if (IN(P + 0)) { phaseA(a, ws, lds, l, xl, xc, tid, (l == 0 || G <= 64) ? 0 : 2, 0, G); SEAM(P + 0); }
        if (IN(P + 1)) {
            { pg8::Gemm g{HX, (const bf16_t*)(ws + O_WZ1), DM, DM, DM, 0, 0}; pg8::Order<1> S; S.init(MROWS, NZ1, G, cb);
              pg8::Epi<FZ1> E{{(bf16_t*)(ws + O_Z1), (float*)(ws + O_MISC), (const float*)(ws + O_BIAS)}};
#ifndef NO_G0
            pg8::gemm_phase(ldsl, g, S, E);
#endif
 }
            { pg8::Gemm g{(const bf16_t*)(ws + O_WKV), HX, DM, DM, DM, 0, 0}; pg8::Order<1> S; S.init(1536, MROWS, G, cb);
              pg8::Epi<FRowBias> E{{(bf16_t*)(ws + O_KVT), MROWS, (const float*)(ws + O_BIAS) + 4352}};
#ifndef NO_G1
            pg8::gemm_phase(ldsl, g, S, E);
#endif
 }
            SEAM(P + 1);
        }
        if (IN(P + 2)) { if (a.sub & 1) mla_norm(a, ws, l, gw, NGW, lane); if (a.sub & 2) s5_pass1(ws, lds, tid); if (a.sub & 4) ml_state_pass(a, ws, (float*)lds, l, tid); SEAM(P + 2); }
        if (IN(P + 3)) {
            { pg8::Gemm g{Z1 + ZQA, (const bf16_t*)(ws + O_WUQ), LDZ, 512, 512, 0, 0}; pg8::Order<1> S; S.init(MROWS, 1536, G, cb);
              pg8::Epi<FPlain> E{{(bf16_t*)(ws + O_Q), 1536}};
#ifndef NO_G2
            pg8::gemm_phase(ldsl, g, S, E);
#endif
 }
            { pg8::Gemm g{Z1 + ZKVA, (const bf16_t*)(ws + O_WUKVK), LDZ, 512, 512, 0, 0}; pg8::Order<1> S; S.init(MROWS, 1024, G, cb);
              pg8::Epi<FKn> E{{(bf16_t*)(ws + O_K)}};
#ifndef NO_G3
            pg8::gemm_phase(ldsl, g, S, E);
#endif
 }
            { pg8::Gemm g{(const bf16_t*)(ws + O_WUKVV), Z1 + ZKVA, 512, LDZ, 512, 0, 0}; pg8::Order<1> S; S.init(1024, MROWS, G, cb);
              pg8::Epi<FRowBias> E{{(bf16_t*)(ws + O_VTA), MROWS, nullptr}};
#ifndef NO_G4
            pg8::gemm_phase(ldsl, g, S, E);
#endif
 }
            s5_scan(ws, l, tid);
            SEAM(P + 3);
        }
        if (IN(P + 4)) { if (a.sub & 1) qk_prep(a, ws, l, gw, NGW, lane); if (a.sub & 2) s5_pass2(ws, lds, tid); if (a.sub & 4) ml_out_pass(a, ws, lds, l, wctx, tid); SEAM(P + 4); }
        if (IN(P + 5)) {
            attn_phase(ws, lds, wctx, tid);
            { pg8::Gemm g{(const bf16_t*)(ws + O_GS), (const bf16_t*)(ws + O_WGLU), 1024, 1024, 1024, 0, 0}; pg8::Order<1> S; S.init(Mlate, 1024, G, cb);
              pg8::Epi<FGlu> E{{(bf16_t*)(ws + O_BR + 2 * BRSZ), (const bf16_t*)(ws + O_GS), gin(a.in[lidx(I_BGLU)]) + l * 1024}};
#ifndef NO_G5
            pg8::gemm_phase(ldsl, g, S, E);
#endif
 }
            SEAM(P + 5);
        }
        if (IN(P + 6)) {
            pg8::Gemm g{HX, (const bf16_t*)(ws + O_WG), DM, DM, DM, 0, 0}; pg8::Order<1> S; S.init(Mlate, 6144, G, cb);
            pg8::Epi<FGate> E{{(bf16_t*)(ws + O_GATES), (const float*)(ws + O_BIAS) + 4352 + 1536}};
#ifndef NO_G6
            pg8::gemm_phase(ldsl, g, S, E);
#endif

            SEAM(P + 6);
        }
        if (IN(P + 7)) {
            pg8::Gemm g{(const bf16_t*)(ws + O_BR), (const bf16_t*)(ws + O_WBR), 1024, 1024, 1024, (size_t)MROWS * 1024, (size_t)2048 * 1024}; pg8::Order<3> S; S.init(Mlate, DM, G, cb);
            pg8::Epi<FMerge> E{{(bf16_t*)(ws + O_HX), (const bf16_t*)(ws + O_GATES)}};
#ifndef NO_G7
            pg8::gemm_phase(ldsl, g, S, E);
#endif

            SEAM(P + 7);
        }
        if (IN(P + 8)) {
            pg8::Gemm g{HX, (const bf16_t*)(ws + O_WOUT), DM, DM, DM, 0, 0}; pg8::Order<1> S; S.init(Mlate, DM, G, cb);
            pg8::Epi<FResid> E{{xl, xc, outl, outc, modl, 2}};
#ifndef NO_G8
            pg8::gemm_phase(ldsl, g, S, E);
#endif

            SEAM(P + 8);
        }
        if (IN(P + 9)) { norm_mod_rows(outl, outc, gin(a.in[lidx(I_NORMG)]) + (size_t)(l * 2 + 1) * DM, modl, 3, (bf16_t*)(ws + O_HX), Mlate, gw, NGW, lane); SEAM(P + 9); }
        if (IN(P + 10)) {
            pg8::Gemm g{HX, (const bf16_t*)(ws + O_W1), DM, DM, DM, 0, 0}; pg8::Order<1> S; S.init(Mlate, DFF, G, cb);
            pg8::Epi<FFF1> E{{(bf16_t*)(ws + O_HID)}};
#ifndef NO_G9
            pg8::gemm_phase(ldsl, g, S, E);
#endif

            SEAM(P + 10);
        }
        if (IN(P + 11)) {
            pg8::Gemm g{(const bf16_t*)(ws + O_HID), (const bf16_t*)(ws + (l == 0 ? O_W2 : O_W2B)), DFF, DFF, DFF, 0, 0}; pg8::Order<1> S; S.init(Mlate, DM, G, cb);
            pg8::Epi<FResid> E{{outl, outc, outl, outc, modl, 5}};
#ifndef NO_G10
            pg8::gemm_phase(ldsl, g, S, E);
#endif
            if (wctx && cb >= 32 && G > 64) phaseA(a, ws, lds, 1, nullptr, nullptr, tid, 1, 32, G - 32);

            SEAM(P + 11);
        }
    }
#undef IN
#undef SEAM
#undef tid
#undef lane
#undef gw
#undef ws
}

extern "C" void kernel_launch(void* const* d_in, const int* in_sizes, int n_in, void* d_out, int out_size, void* d_ws, size_t ws_size, hipStream_t stream) {
    static int grid = 0;
    if (grid == 0) {
        int dev = 0, cus = 0, per_cu = 0;
        (void)hipGetDevice(&dev);
        (void)hipDeviceGetAttribute(&cus, hipDeviceAttributeMultiprocessorCount, dev);
        (void)hipFuncSetAttribute((const void*)mega, hipFuncAttributeMaxDynamicSharedMemorySize, LDS_BYTES);
        (void)hipOccupancyMaxActiveBlocksPerMultiprocessor(&per_cu, (const void*)mega, 512, LDS_BYTES);
        if (per_cu < 1) per_cu = 1;
        grid = cus * per_cu;
        if (ws_size < O_END2) fprintf(stderr, "kernel_launch: workspace too small: %zu < %zu\n", ws_size, (size_t)O_END2);
    }
    (void)hipMemsetAsync((unsigned char*)d_ws + O_BARW, 0, 2 * 16384, stream);
    Args a{};
    for (int i = 0; i < 31 && i < n_in; ++i) a.in[i] = (GAS const float*)d_in[i];
    a.out = (GAS float*)d_out; a.ws = (GAS unsigned char*)d_ws; a.ph_lo = 0; a.ph_hi = NPHASE; a.sub = 7;
    void* args[] = {&a};
    hipError_t e = hipLaunchCooperativeKernel((const void*)mega, dim3(grid), dim3(512), args, LDS_BYTES, stream);
    if (e != hipSuccess) fprintf(stderr, "cooperative launch failed: %s (grid %d)\n", hipGetErrorString(e), grid);
    if (PROBE_LO >= 0) { Args b2 = a; b2.ph_lo = PROBE_LO; b2.ph_hi = PROBE_HI; b2.sub = PROBE_SUB; b2.bar_region = 1; void* args2[] = {&b2};
        (void)hipLaunchCooperativeKernel((const void*)mega, dim3(grid), dim3(512), args2, LDS_BYTES, stream); }
}
```

```cpp
#include <hip/hip_runtime.h>
#include <hip/hip_cooperative_groups.h>
#include <cstdio>
#include <cstdint>
namespace cg = cooperative_groups;

typedef unsigned short bf16_t;
typedef short bf16x8 __attribute__((ext_vector_type(8)));
typedef float f32x4 __attribute__((ext_vector_type(4)));
typedef float f32x2 __attribute__((ext_vector_type(2)));
typedef unsigned u32x4 __attribute__((ext_vector_type(4)));
typedef unsigned u32x2 __attribute__((ext_vector_type(2)));
#define LAS __attribute__((address_space(3)))
#define GAS __attribute__((address_space(1)))

constexpr int DM = 2048, NB = 4, SEQ = 4096, CTXL = 256, NLAT = NB * SEQ, NCTX = NB * CTXL, MROWS = NLAT + NCTX;
constexpr int DIN = 11344, DFF = 8192;
constexpr int NZ1 = 4352;
constexpr int LDZ = 4096;
constexpr int ZQ = 0, ZK = 512, ZO = 1024, ZQA = 2048, ZKVA = 2560, ZU = 3072;
constexpr int NMISC = 80;
constexpr int MLCH = 128, MLNC = 34;
constexpr int S5NCH = 68, S5COLS = NB * S5NCH;
constexpr float EPS = 1e-6f;

constexpr size_t al256(size_t x) { return (x + 255) & ~(size_t)255; }
constexpr size_t O_WZ1 = 0;
constexpr size_t O_WKV = O_WZ1 + (size_t)NZ1 * DM * 2;
constexpr size_t O_WG = O_WKV + (size_t)1536 * DM * 2;
constexpr size_t O_WUQ = O_WG + (size_t)6144 * DM * 2;
constexpr size_t O_WUKVK = O_WUQ + (size_t)1536 * 512 * 2;
constexpr size_t O_WUKVV = O_WUKVK + (size_t)1024 * 512 * 2;
constexpr size_t O_WGLU = O_WUKVV + (size_t)1024 * 512 * 2;
constexpr size_t O_WBR = O_WGLU + (size_t)1024 * 1024 * 2;
constexpr size_t O_WOUT = O_WBR + (size_t)3 * 2048 * 1024 * 2;
constexpr size_t O_W1 = O_WOUT + (size_t)2048 * 2048 * 2;
constexpr size_t O_W2 = O_W1 + (size_t)8192 * 2048 * 2;
constexpr size_t O_BIAS = O_W2 + (size_t)8192 * 2048 * 2;
constexpr size_t O_T1 = al256(O_BIAS + (size_t)(4352 + 1536 + 6144) * 4);
constexpr size_t O_T2 = O_T1 + (size_t)64 * 256 * 1024 * 2;
constexpr size_t O_KC = O_T2 + (size_t)64 * 1024 * 256 * 2;
constexpr size_t O_LAMP = O_KC + (size_t)64 * 128 * 256 * 2;
constexpr size_t O_BBAR = O_LAMP + (size_t)2 * 64 * 2 * 65 * 64 * 8;
constexpr size_t O_MOD = O_BBAR + (size_t)2 * 64 * 2 * 64 * 16 * 8;
constexpr size_t O_CTXX = al256(O_MOD + (size_t)2 * 5 * 12288 * 4);
constexpr size_t O_MLG = O_CTXX + (size_t)NCTX * DM * 4;
constexpr size_t O_MLN = O_MLG + (size_t)3 * 8 * MROWS * 4;
constexpr size_t O_MLM = O_MLN + (size_t)32 * MLNC * 128 * 4;
constexpr size_t O_HX = al256(O_MLM + (size_t)32 * MLNC * 4);
constexpr size_t O_BR = O_HX + (size_t)MROWS * DM * 2;
constexpr size_t BRSZ = (size_t)MROWS * 1024 * 2;
constexpr size_t O_R1 = O_BR + 3 * BRSZ;
constexpr size_t O_Z1 = O_R1;
constexpr size_t O_MISC = O_Z1 + (size_t)MROWS * LDZ * 2;
constexpr size_t O_KVT = O_MISC + (size_t)MROWS * NMISC * 4;
constexpr size_t O_Q = O_KVT + (size_t)1536 * MROWS * 2;
constexpr size_t O_K = O_Q + (size_t)MROWS * 1536 * 2;
constexpr size_t O_VTA = O_K + (size_t)MROWS * 1536 * 2;
constexpr size_t O_E = O_VTA + (size_t)1024 * MROWS * 2;
constexpr size_t O_X = O_E + (size_t)64 * S5COLS * 256 * 4;
constexpr size_t O_GS = O_X + (size_t)64 * S5COLS * 256 * 2;
constexpr size_t O_END = O_GS + (size_t)MROWS * 1024 * 2;
constexpr size_t O_W2B = O_END;
constexpr size_t O_ROPE = O_W2B + (size_t)8192 * 2048 * 2;
constexpr size_t O_BARW = O_ROPE + 64 * 16 * 8;
constexpr size_t O_END2 = O_BARW + 2 * 16384;
constexpr size_t O_GATES = O_R1;
constexpr size_t O_HID = O_R1;
static_assert(O_GATES + (size_t)MROWS * 6144 * 2 <= O_GS, "gates alias");
static_assert(O_HID + (size_t)MROWS * 8192 * 2 <= O_END, "hidden alias");

__device__ __forceinline__ float bf2f(unsigned u) { return __uint_as_float(u << 16); }
__device__ __forceinline__ unsigned cvt_pk(float lo, float hi) { unsigned r; asm volatile("v_cvt_pk_bf16_f32 %0, %1, %2" : "=v"(r) : "v"(lo), "v"(hi)); return r; }
__device__ __forceinline__ float wave_sum(float v) {
#pragma unroll
    for (int o = 1; o < 64; o <<= 1) v += __shfl_xor(v, o);
    return v;
}
__device__ __forceinline__ float sigmoidf_(float x) { return 1.f / (1.f + __expf(-x)); }
__device__ __forceinline__ f32x4 mfma16(bf16x8 a, bf16x8 b, f32x4 c) { return __builtin_amdgcn_mfma_f32_16x16x32_bf16(a, b, c, 0, 0, 0); }
__device__ __forceinline__ bf16x8 ldg8(const bf16_t* p) { return *(const bf16x8*)p; }
__device__ __forceinline__ void unpack8(bf16x8 v, float* f) {
    const u32x4 w = __builtin_bit_cast(u32x4, v);
    f[0] = __uint_as_float(w.x << 16); f[1] = __uint_as_float(w.x & 0xffff0000u); f[2] = __uint_as_float(w.y << 16); f[3] = __uint_as_float(w.y & 0xffff0000u);
    f[4] = __uint_as_float(w.z << 16); f[5] = __uint_as_float(w.z & 0xffff0000u); f[6] = __uint_as_float(w.w << 16); f[7] = __uint_as_float(w.w & 0xffff0000u);
}
__device__ __forceinline__ bf16x8 pack8(const float* f) { u32x4 w; w.x = cvt_pk(f[0], f[1]); w.y = cvt_pk(f[2], f[3]); w.z = cvt_pk(f[4], f[5]); w.w = cvt_pk(f[6], f[7]); return __builtin_bit_cast(bf16x8, w); }

__device__ __forceinline__ int ltid() { int t = threadIdx.x; asm volatile("" : "+v"(t)); return t; }
__device__ __forceinline__ int lidx(int i) { asm volatile("" : "+s"(i)); return i; }
template <class T> __device__ __forceinline__ T* lptr(GAS T* p) { asm volatile("" : "+s"(p)); return (T*)p; }
__device__ __forceinline__ const float* gin(GAS const float* p) { return (const float*)p; }
__device__ __forceinline__ int vbid() { const int G = lidx((int)gridDim.x), b = lidx((int)blockIdx.x); return (G % 8 == 0) ? (b % 8) * (G / 8) + b / 8 : b; }
namespace pg8 {
constexpr int BM = 256, BK = 64, HALF = 128, HTB = HALF * BK * 2, STAGE_BYTES = 8 * HTB, NXCD = 8, WGM = 8;
__host__ __device__ __forceinline__ int lds_byte(int r, int c) { const int st = (r >> 4) * 2 + (c >> 5), rr = r & 15, cc = c & 31, ob = rr * 64 + cc * 2; return st * 1024 + (ob ^ (((ob >> 9) & 1) << 5)); }
__host__ __device__ __forceinline__ void stage_rc(int b, int& R, int& C) { const int st = b / 1024, sb = b % 1024, swz = sb ^ (((sb >> 9) & 1) << 5); R = (st >> 1) * 16 + swz / 64; C = (st & 1) * 32 + (swz % 64) / 2; }
__host__ __device__ __forceinline__ int perm32(int rho) { const int n = rho >> 4, i = rho & 15; return 8 * (i >> 2) + 4 * n + (i & 3); }
struct Unit { int pm, pn, r; };
struct Gemm { const bf16_t* A; const bf16_t* Bt; int lda, ldb, K; size_t rsA, rsB; };
template <int NR> struct Order {
    int nM, nN, nwg, G, c;
    __device__ void init(int M, int N, int G_, int c_) { nM = M / BM; nN = N / BM; nwg = nM * nN; G = G_; c = c_; }
    __device__ bool next(int i, Unit& u) const {
        const int ti = i / NR; u.r = i - ti * NR;
        const long L = (long)ti * G + c; if (L >= nwg) return false;
        int wgid = (int)L; { const int q = nwg / NXCD, r = nwg % NXCD, xcd = wgid % NXCD, off = wgid / NXCD; wgid = (xcd < r ? xcd * (q + 1) : r * (q + 1) + (xcd - r) * q) + off; }
        const int nig = WGM * nN, gid = wgid / nig, fm = gid * WGM, gsz = (nM - fm) < WGM ? (nM - fm) : WGM;
        u.pm = fm + ((wgid % nig) % gsz); u.pn = (wgid % nig) / gsz; return true;
    }
};
template <class F> struct Epi {
    F f;
    __device__ __forceinline__ void operator()(const f32x4 (&acc)[2][2][4][2], const Unit& u, int wr, int wc, int fr, int fq) const {
        typename F::Pre pre[2];
        const int row0 = u.pm * BM + wr * 64 + fr, col0 = u.pn * BM + wc * 32 + 8 * fq;
#pragma unroll
        for (int bj = 0; bj < 2; ++bj) f.pre(u.r, row0, col0 + bj * HALF, pre[bj]);
        constexpr int MB = sizeof(typename F::Aux) <= 16 ? 4 : 2;
#pragma unroll
        for (int ai = 0; ai < 2; ++ai)
#pragma unroll
            for (int m2 = 0; m2 < 4; m2 += MB) {
                typename F::Aux ax[MB][2];
#pragma unroll
                for (int mm = 0; mm < MB; ++mm)
#pragma unroll
                    for (int bj = 0; bj < 2; ++bj) f.ld(u.r, row0 + ai * HALF + (m2 + mm) * 16, col0 + bj * HALF, ax[mm][bj]);
                __builtin_amdgcn_sched_barrier(0);
#pragma unroll
                for (int mm = 0; mm < MB; ++mm)
#pragma unroll
                    for (int bj = 0; bj < 2; ++bj) f.st(u.r, row0 + ai * HALF + (m2 + mm) * 16, col0 + bj * HALF, acc[ai][bj][m2 + mm][0], acc[ai][bj][m2 + mm][1], pre[bj], ax[mm][bj]);
                __builtin_amdgcn_sched_barrier(0);
            }
    }
};

template <class EpiT, class Sched>
__device__ __forceinline__ void gemm_phase(LAS unsigned char* lds, const Gemm g, const Sched& S, const EpiT& E) {
    const int tid = ltid(), wid = __builtin_amdgcn_readfirstlane(tid >> 6), lane = tid & 63, wr = wid >> 2, wc = wid & 3, fr = lane & 15, fq = lane >> 4;
    const int K = g.K, nt = K / BK;
    unsigned voffA[2], voffB[2];
#pragma unroll
    for (int i = 0; i < 2; ++i) { int R, C; stage_rc(tid * 16 + i * 8192, R, C); const int Rb = (R & ~31) + perm32(R & 31);
        voffA[i] = (unsigned)(R * g.lda + C) * 2u; voffB[i] = (unsigned)(Rb * g.ldb + C) * 2u; }
    const size_t kstep = (size_t)(BK * 2);
    const size_t hstepA = (size_t)HALF * g.lda * 2, hstepB = (size_t)HALF * g.ldb * 2;
    const size_t tstepA = 2 * hstepA, tstepB = 2 * hstepB;
    const unsigned ldsw = (unsigned)wid * 1024u;
    const int aoff = lds_byte(wr * 64 + fr, fq * 8), boff = lds_byte(wc * 32 + fr, fq * 8);
#define PG8_SA(b, h) (((b) * 2 + (h)) * HTB)
#define PG8_SB(b, h) ((4 + (b) * 2 + (h)) * HTB)
#define PG8_STAGE(bufoff, gbase, voff) do { _Pragma("unroll") for (int _i = 0; _i < 2; ++_i) \
        __builtin_amdgcn_global_load_lds((const unsigned*)((const char*)(gbase) + (voff)[_i]), (LAS unsigned*)(lds + (bufoff) + ldsw + _i * 8192), 16, 0, 0); } while (0)
#define PG8_LDA(dst, b, h) do { _Pragma("unroll") for (int m = 0; m < 4; ++m) _Pragma("unroll") for (int k = 0; k < 2; ++k) dst[m][k] = *(const LAS bf16x8*)(lds + PG8_SA(b, h) + aoff + m * 2048 + k * 1024); } while (0)
#define PG8_LDB(dst, b, h) do { _Pragma("unroll") for (int n = 0; n < 2; ++n) _Pragma("unroll") for (int k = 0; k < 2; ++k) dst[n][k] = *(const LAS bf16x8*)(lds + PG8_SB(b, h) + boff + n * 2048 + k * 1024); } while (0)
#define PG8_MMA(ai, bj, At, Bt) do { __builtin_amdgcn_s_setprio(1); _Pragma("unroll") for (int m = 0; m < 4; ++m) _Pragma("unroll") for (int n = 0; n < 2; ++n) _Pragma("unroll") for (int k = 0; k < 2; ++k) \
        acc[ai][bj][m][n] = __builtin_amdgcn_mfma_f32_16x16x32_bf16(Bt[n][k], At[m][k], acc[ai][bj][m][n], 0, 0, 0); __builtin_amdgcn_s_setprio(0); } while (0)
#define PG8_WAIT_V(n) asm volatile("s_waitcnt vmcnt(" #n ")" ::: "memory")
#define PG8_WAIT_L(n) asm volatile("s_waitcnt lgkmcnt(" #n ")" ::: "memory")
#define PG8_BAR __builtin_amdgcn_s_barrier()
#define PG8_SCHED __builtin_amdgcn_sched_barrier(0)
    Unit cur, nxt; int ui = 0;
    if (!S.next(0, cur)) return;
    f32x4 acc[2][2][4][2];
#pragma unroll
    for (int a = 0; a < 2; ++a)
#pragma unroll
        for (int b = 0; b < 2; ++b)
#pragma unroll
            for (int m = 0; m < 4; ++m)
#pragma unroll
                for (int n = 0; n < 2; ++n) acc[a][b][m][n] = (f32x4){0.f, 0.f, 0.f, 0.f};
    bf16x8 At[4][2], B0[2][2], B1[2][2];
    const char* cA = (const char*)g.A + (size_t)cur.pm * tstepA + (size_t)cur.r * g.rsA * 2; const char* cB = (const char*)g.Bt + (size_t)cur.pn * tstepB + (size_t)cur.r * g.rsB * 2;
    PG8_STAGE(PG8_SB(0, 0), cB, voffB); PG8_STAGE(PG8_SB(0, 1), cB + hstepB, voffB); PG8_STAGE(PG8_SA(0, 0), cA, voffA); PG8_STAGE(PG8_SA(0, 1), cA + hstepA, voffA);
    if (wr == 1) PG8_BAR;
    PG8_WAIT_V(2); PG8_BAR;
    PG8_STAGE(PG8_SB(1, 0), cB + kstep, voffB); PG8_STAGE(PG8_SA(1, 0), cA + kstep, voffA); PG8_STAGE(PG8_SB(1, 1), cB + hstepB + kstep, voffB);
    PG8_WAIT_V(6); PG8_BAR;
    for (;;) {
        const bool has_next = S.next(ui + 1, nxt);
        const char* nA = has_next ? (const char*)g.A + (size_t)nxt.pm * tstepA + (size_t)nxt.r * g.rsA * 2 : cA; const char* nB = has_next ? (const char*)g.Bt + (size_t)nxt.pn * tstepB + (size_t)nxt.r * g.rsB * 2 : cB;
        for (int t = 0; t < nt; t += 2) {
            const bool last = (t == nt - 2);
            const char* a1 = cA + (size_t)(t + 1) * kstep;
            const char* a2 = last ? nA : cA + (size_t)(t + 2) * kstep; const char* b2 = last ? nB : cB + (size_t)(t + 2) * kstep;
            const char* a3 = a2 + kstep; const char* b3 = b2 + kstep;
            PG8_LDB(B0, 0, 0); PG8_LDB(B1, 0, 1); PG8_SCHED; PG8_LDA(At, 0, 0); PG8_STAGE(PG8_SA(1, 1), a1 + hstepA, voffA);
            PG8_WAIT_V(8); PG8_WAIT_L(0); PG8_BAR; PG8_MMA(0, 0, At, B0); PG8_MMA(0, 1, At, B1); PG8_BAR; PG8_SCHED;
            PG8_LDA(At, 0, 1); PG8_STAGE(PG8_SB(0, 0), b2, voffB); PG8_STAGE(PG8_SB(0, 1), b2 + hstepB, voffB); PG8_STAGE(PG8_SA(0, 0), a2, voffA);
            PG8_WAIT_V(8); PG8_WAIT_L(0); PG8_BAR; PG8_MMA(1, 0, At, B0); PG8_MMA(1, 1, At, B1); PG8_BAR; PG8_SCHED;
            PG8_LDB(B0, 1, 0); PG8_LDB(B1, 1, 1); PG8_SCHED; PG8_LDA(At, 1, 0); PG8_STAGE(PG8_SA(0, 1), a2 + hstepA, voffA);
            PG8_WAIT_V(8); PG8_WAIT_L(0); PG8_BAR; PG8_MMA(0, 0, At, B0); PG8_MMA(0, 1, At, B1); PG8_BAR; PG8_SCHED;
            PG8_LDA(At, 1, 1); PG8_STAGE(PG8_SB(1, 0), b3, voffB); PG8_STAGE(PG8_SB(1, 1), b3 + hstepB, voffB); PG8_STAGE(PG8_SA(1, 0), a3, voffA);
            PG8_WAIT_V(8); PG8_WAIT_L(0); PG8_BAR; PG8_MMA(1, 0, At, B0); PG8_MMA(1, 1, At, B1); PG8_BAR; PG8_SCHED;
        }
        if (wr == 0) PG8_BAR;
        E(acc, cur, wr, wc, fr, fq);
        if (!has_next) break;
#pragma unroll
        for (int a = 0; a < 2; ++a)
#pragma unroll
            for (int b = 0; b < 2; ++b)
#pragma unroll
                for (int m = 0; m < 4; ++m)
#pragma unroll
                    for (int n = 0; n < 2; ++n) acc[a][b][m][n] = (f32x4){0.f, 0.f, 0.f, 0.f};
        cur = nxt; cA = nA; cB = nB; ++ui;
        if (wr == 1) PG8_BAR;
    }
    PG8_WAIT_V(0);
    PG8_BAR;
#undef PG8_SA
#undef PG8_SB
#undef PG8_STAGE
#undef PG8_LDA
#undef PG8_LDB
#undef PG8_MMA
#undef PG8_WAIT_V
#undef PG8_WAIT_L
#undef PG8_BAR
#undef PG8_SCHED
}
}
__device__ __forceinline__ void st_bf16x8(bf16_t* p, f32x4 v0, f32x4 v1) { u32x4 w; w.x = cvt_pk(v0[0], v0[1]); w.y = cvt_pk(v0[2], v0[3]); w.z = cvt_pk(v1[0], v1[1]); w.w = cvt_pk(v1[2], v1[3]); *(u32x4*)p = w; }
struct NoAux {};
struct ColBias { f32x4 b0, b1; };
struct FZ1 { bf16_t* z1; float* misc; const float* b1; typedef ColBias Pre; typedef NoAux Aux;
    __device__ __forceinline__ void pre(int, int, int col, Pre& p) const { p.b0 = *(const f32x4*)(b1 + col); p.b1 = *(const f32x4*)(b1 + col + 4); }
    __device__ __forceinline__ void ld(int, int, int, Aux&) const {}
    __device__ __forceinline__ void st(int, int row, int col, f32x4 v0, f32x4 v1, const Pre& p, const Aux&) const {
        v0 += p.b0; v1 += p.b1;
        if (col < LDZ) st_bf16x8(z1 + (size_t)row * LDZ + col, v0, v1);
        else { const int c = col - LDZ; if (c < NMISC) { float* q = misc + (size_t)row * NMISC + c; *(f32x4*)q = v0; *(f32x4*)(q + 4) = v1; } }
    } };
struct RowB { float b; };
struct FRowBias { bf16_t* o; int ld_; const float* bias; typedef NoAux Pre; typedef RowB Aux;
    __device__ __forceinline__ void pre(int, int, int, Pre&) const {}
    __device__ __forceinline__ void ld(int, int row, int, Aux& x) const { x.b = bias ? bias[row] : 0.f; }
    __device__ __forceinline__ void st(int, int row, int col, f32x4 v0, f32x4 v1, const Pre&, const Aux& x) const { v0 += x.b; v1 += x.b; st_bf16x8(o + (size_t)row * ld_ + col, v0, v1); } };
struct FGate { bf16_t* o; const float* bg; typedef ColBias Pre; typedef NoAux Aux;
    __device__ __forceinline__ void pre(int, int, int col, Pre& p) const { p.b0 = *(const f32x4*)(bg + col); p.b1 = *(const f32x4*)(bg + col + 4); }
    __device__ __forceinline__ void ld(int, int, int, Aux&) const {}
    __device__ __forceinline__ void st(int, int row, int col, f32x4 v0, f32x4 v1, const Pre& p, const Aux&) const {
        v0 += p.b0; v1 += p.b1;
#pragma unroll
        for (int i = 0; i < 4; ++i) { v0[i] = sigmoidf_(v0[i]); v1[i] = sigmoidf_(v1[i]); }
        st_bf16x8(o + (size_t)row * 6144 + col, v0, v1);
    } };
struct FPlain { bf16_t* o; int ld_; typedef NoAux Pre; typedef NoAux Aux;
    __device__ __forceinline__ void pre(int, int, int, Pre&) const {}
    __device__ __forceinline__ void ld(int, int, int, Aux&) const {}
    __device__ __forceinline__ void st(int, int row, int col, f32x4 v0, f32x4 v1, const Pre&, const Aux&) const { st_bf16x8(o + (size_t)row * ld_ + col, v0, v1); } };
struct FKn { bf16_t* o; typedef NoAux Pre; typedef NoAux Aux;
    __device__ __forceinline__ void pre(int, int, int, Pre&) const {}
    __device__ __forceinline__ void ld(int, int, int, Aux&) const {}
    __device__ __forceinline__ void st(int, int row, int col, f32x4 v0, f32x4 v1, const Pre&, const Aux&) const { const int h = col >> 7, d = col & 127; st_bf16x8(o + (size_t)row * 1536 + h * 192 + d, v0, v1); } };
struct Vec8 { bf16x8 v; };
struct FGlu { bf16_t* o; const bf16_t* g; const float* bias; typedef ColBias Pre; typedef Vec8 Aux;
    __device__ __forceinline__ void pre(int, int, int col, Pre& p) const { p.b0 = *(const f32x4*)(bias + col); p.b1 = *(const f32x4*)(bias + col + 4); }
    __device__ __forceinline__ void ld(int, int row, int col, Aux& x) const { x.v = ldg8(g + (size_t)row * 1024 + col); }
    __device__ __forceinline__ void st(int, int row, int col, f32x4 v0, f32x4 v1, const Pre& p, const Aux& x) const {
        float gv[8]; unpack8(x.v, gv);
        v0 += p.b0; v1 += p.b1;
#pragma unroll
        for (int i = 0; i < 4; ++i) { v0[i] = gv[i] * sigmoidf_(v0[i]); v1[i] = gv[4 + i] * sigmoidf_(v1[i]); }
        st_bf16x8(o + (size_t)row * 1024 + col, v0, v1);
    } };
struct Vec8x2 { bf16x8 g, p; };
struct FMerge { bf16_t* o; const bf16_t* gates; typedef NoAux Pre; typedef Vec8x2 Aux;
    __device__ __forceinline__ void pre(int, int, int, Pre&) const {}
    __device__ __forceinline__ void ld(int r, int row, int col, Aux& x) const { x.g = ldg8(gates + (size_t)row * 6144 + r * 2048 + col); if (r > 0) x.p = ldg8(o + (size_t)row * DM + col); }
    __device__ __forceinline__ void st(int r, int row, int col, f32x4 v0, f32x4 v1, const Pre&, const Aux& x) const {
        float gv[8]; unpack8(x.g, gv);
#pragma unroll
        for (int i = 0; i < 4; ++i) { v0[i] *= gv[i]; v1[i] *= gv[4 + i]; }
        if (r > 0) { float pv[8]; unpack8(x.p, pv);
#pragma unroll
            for (int i = 0; i < 4; ++i) { v0[i] += pv[i]; v1[i] += pv[4 + i]; } }
        st_bf16x8(o + (size_t)row * DM + col, v0, v1);
    } };
struct X8 { f32x4 x0, x1; };
struct FResid { const float* xin_l; const float* xin_c; float* xout_l; float* xout_c; const float* modl; int gi; typedef ColBias Pre; typedef X8 Aux;
    __device__ __forceinline__ void pre(int, int row0, int col, Pre& p) const { const int mr = row0 < NLAT ? (row0 >> 12) : 4; const float* gp = modl + (size_t)mr * 12288 + gi * DM + col; p.b0 = *(const f32x4*)gp; p.b1 = *(const f32x4*)(gp + 4); }
    __device__ __forceinline__ void ld(int, int row, int col, Aux& x) const { const float* xi = row < NLAT ? xin_l + (size_t)row * DM : xin_c + (size_t)(row - NLAT) * DM; x.x0 = *(const f32x4*)(xi + col); x.x1 = *(const f32x4*)(xi + col + 4); }
    __device__ __forceinline__ void st(int, int row, int col, f32x4 v0, f32x4 v1, const Pre& p, const Aux& x) const {
        float* xo = row < NLAT ? xout_l + (size_t)row * DM : xout_c + (size_t)(row - NLAT) * DM;
        *(f32x4*)(xo + col) = x.x0 + p.b0 * v0; *(f32x4*)(xo + col + 4) = x.x1 + p.b1 * v1;
    } };
struct FFF1 { bf16_t* o; typedef NoAux Pre; typedef NoAux Aux;
    __device__ __forceinline__ void pre(int, int, int, Pre&) const {}
    __device__ __forceinline__ void ld(int, int, int, Aux&) const {}
    __device__ __forceinline__ void st(int, int row, int col, f32x4 v0, f32x4 v1, const Pre&, const Aux&) const {
#pragma unroll
        for (int i = 0; i < 4; ++i) { const float a = fmaxf(v0[i], 0.f), b = fmaxf(v1[i], 0.f); v0[i] = a * a; v1[i] = b * b; }
        st_bf16x8(o + (size_t)row * DFF + col, v0, v1);
    } };

struct Args { GAS const float* in[31]; GAS float* out; GAS unsigned char* ws; int ph_lo, ph_hi, sub, bar_region; };
enum { I_X = 0, I_C, I_CTX, I_CCTX, I_WMOD, I_BMOD, I_NORMG, I_WIN, I_BIN, I_MLGB, I_MLNG, I_QAG, I_KVAG, I_WUQ, I_WUKV, I_QNG, I_KNG,
       I_ARE, I_AIM, I_LOGDT, I_BRE, I_BIM, I_CRE, I_CIM, I_S5D, I_WGLU, I_BGLU, I_WBR, I_WOUT, I_FF1, I_FF2 };

__device__ __forceinline__ int seq_row(int b, int pos) { return pos < CTXL ? NLAT + b * CTXL + pos : b * SEQ + (pos - CTXL); }

__device__ __forceinline__ void tr_item(const float* W, int ld, int K, int nblk, bf16_t* WT, int mode, float* scr, int item, int lane) {
    const int kb = item / nblk, nb = item % nblk, k0 = 64 * kb, n0 = 32 * nb;
    float tv[32];
#pragma unroll
    for (int i = 0; i < 32; ++i) { const int kk = 2 * i + (lane >> 5); tv[i] = W[(size_t)(k0 + kk) * ld + n0 + (lane & 31)]; }
    __builtin_amdgcn_sched_barrier(0);
#pragma unroll
    for (int i = 0; i < 32; ++i) { const int kk = 2 * i + (lane >> 5); scr[kk * 33 + (lane & 31)] = tv[i]; }
    asm volatile("s_waitcnt lgkmcnt(0)" ::: "memory");
    const int c = lane & 7;
    int drow0 = n0;
    if (mode == 1) { const int h = n0 >> 8, w = n0 & 255; drow0 = (w < 128) ? (h * 128 + w) : (1024 + h * 128 + (w - 128)); }
#pragma unroll
    for (int j = 0; j < 4; ++j) { const int n = (lane >> 3) + 8 * j; const float* s = scr + (8 * c) * 33 + n;
        u32x4 o; o.x = cvt_pk(s[0 * 33], s[1 * 33]); o.y = cvt_pk(s[2 * 33], s[3 * 33]); o.z = cvt_pk(s[4 * 33], s[5 * 33]); o.w = cvt_pk(s[6 * 33], s[7 * 33]);
        *(u32x4*)(WT + (size_t)(drow0 + n) * K + k0 + 8 * c) = o; }
    asm volatile("s_waitcnt lgkmcnt(0)" ::: "memory");
}
#define TR_JOB(Wp, ld, K, ncols, WTp, mode) do { const int _nblk = (ncols) / 32, _nit = ((K) / 64) * _nblk; \
    for (int it = gw; it < _nit; it += NGW) tr_item((Wp), (ld), (K), _nblk, (WTp), (mode), scr, it, lane); } while (0)

__device__ __forceinline__ void norm_mod_rows(const float* xl, const float* xc, const float* ng, const float* modl, int si, bf16_t* out, int nrows, int gw, int NGW, int lane) {
    for (int row = gw; row < nrows; row += NGW) {
        const float* xr; int mr;
        if (row < NLAT) { xr = xl + (size_t)row * DM; mr = row >> 12; } else { xr = xc + (size_t)(row - NLAT) * DM; mr = 4; }
        f32x4 v[8]; float s = 0.f;
#pragma unroll
        for (int j = 0; j < 8; ++j) { v[j] = *(const f32x4*)(xr + 256 * j + 4 * lane); s += v[j][0] * v[j][0] + v[j][1] * v[j][1] + v[j][2] * v[j][2] + v[j][3] * v[j][3]; }
        const float rs = rsqrtf(wave_sum(s) * (1.f / DM) + EPS);
        const float* sh = modl + (size_t)mr * 12288 + si * DM; const float* sc = sh + DM;
#pragma unroll
        for (int jh = 0; jh < 8; jh += 4) {
            f32x4 g4[4], a4[4], b4[4];
#pragma unroll
            for (int j = 0; j < 4; ++j) { const int c = 256 * (jh + j) + 4 * lane; g4[j] = *(const f32x4*)(ng + c); a4[j] = *(const f32x4*)(sh + c); b4[j] = *(const f32x4*)(sc + c); }
            __builtin_amdgcn_sched_barrier(0);
#pragma unroll
            for (int j = 0; j < 4; ++j) { const int c = 256 * (jh + j) + 4 * lane; f32x4 y;
#pragma unroll
                for (int e = 0; e < 4; ++e) y[e] = v[jh + j][e] * rs * g4[j][e] * (1.f + b4[j][e]) + a4[j][e];
                u32x2 w; w.x = cvt_pk(y[0], y[1]); w.y = cvt_pk(y[2], y[3]); *(u32x2*)(out + (size_t)row * DM + c) = w; }
        }
    }
}
__device__ __forceinline__ void phase0(const Args& a, unsigned char* ws, float* sm, int tid) {
    const int w = tid >> 6, lane = tid & 63;
    float* sl = sm;
    float* red = sm + 5 * 2048;
    for (int i = tid; i < 5 * 2048; i += 512) { const float c = i < 4 * 2048 ? gin(a.in[lidx(I_C)])[i] : gin(a.in[lidx(I_CCTX)])[i - 4 * 2048]; sl[i] = c * sigmoidf_(c); }
    __syncthreads();
    float* mod = (float*)(ws + O_MOD);
    for (int u = vbid(); u < 384; u += lidx((int)gridDim.x)) {
        const int l = u / 192, j = (u % 192) * 64 + lane;
        const float* W = gin(a.in[lidx(I_WMOD)]) + (size_t)l * DM * 12288 + j;
        float acc[5] = {0.f, 0.f, 0.f, 0.f, 0.f};
#pragma unroll 1
        for (int k0 = w * 256; k0 < w * 256 + 256; k0 += 16) { float wv[16];
#pragma unroll
            for (int i = 0; i < 16; ++i) wv[i] = W[(size_t)(k0 + i) * 12288];
            __builtin_amdgcn_sched_barrier(0);
#pragma unroll
            for (int i = 0; i < 16; ++i)
#pragma unroll
                for (int r = 0; r < 5; ++r) acc[r] += sl[r * 2048 + k0 + i] * wv[i]; }
#pragma unroll
        for (int r = 0; r < 5; ++r) red[(w * 5 + r) * 64 + lane] = acc[r];
        __syncthreads();
        if (tid < 320) { const int r = tid >> 6; float s = 0.f;
#pragma unroll
            for (int ww = 0; ww < 8; ++ww) s += red[(ww * 5 + r) * 64 + lane];
            mod[(size_t)(l * 5 + r) * 12288 + j] = s + gin(a.in[lidx(I_BMOD)])[l * 12288 + j]; }
        __syncthreads();
    }
    { f32x2* rope = (f32x2*)(ws + O_ROPE); const int gt0 = lidx((int)blockIdx.x) * 512 + tid;
      if (gt0 < 1024) { const int f = gt0 & 15, pos = gt0 >> 4; float sn, cs; sincosf((float)pos * exp2f(-(float)f * (13.287712379549449f / 16.f)), &sn, &cs); rope[gt0] = (f32x2){cs, sn}; } }
    f32x2* lamp = (f32x2*)(ws + O_LAMP); f32x2* bbar = (f32x2*)(ws + O_BBAR);
    const int gt = lidx((int)blockIdx.x) * 512 + tid, gs = lidx((int)gridDim.x) * 512;
    for (int idx = gt; idx < 2 * 64 * 2 * 65 * 64; idx += gs) {
        const int n = idx & 63, p = (idx >> 6) % 65, rest = idx / (64 * 65), dir = rest & 1, g = (rest >> 1) & 63, l = rest >> 7;
        const int si = ((l * 2 + dir) * 64 + g) * 64 + n;
        const float re = fminf(gin(a.in[lidx(I_ARE)])[si], -1e-4f), im = gin(a.in[lidx(I_AIM)])[si], dt = expf(gin(a.in[lidx(I_LOGDT)])[(l * 2 + dir) * 64 + g]);
        const float mag = expf((float)p * (re * dt)); float s, c; sincosf((float)p * (im * dt), &s, &c);
        lamp[idx] = (f32x2){mag * c, mag * s};
    }
    for (int idx = gt; idx < 2 * 64 * 2 * 64 * 16; idx += gs) {
        const int ci = idx & 15, n = (idx >> 4) & 63, dir = (idx >> 10) & 1, g = (idx >> 11) & 63, l = idx >> 17;
        const int si = ((l * 2 + dir) * 64 + g) * 64 + n;
        const float re = fminf(gin(a.in[lidx(I_ARE)])[si], -1e-4f), im = gin(a.in[lidx(I_AIM)])[si], dt = expf(gin(a.in[lidx(I_LOGDT)])[(l * 2 + dir) * 64 + g]);
        const float mag = expf(re * dt); float s, c; sincosf(im * dt, &s, &c);
        const float nr = mag * c - 1.f, ni = mag * s, d = re * re + im * im;
        const float qr = (nr * re + ni * im) / d, qi = (ni * re - nr * im) / d;
        const float br = gin(a.in[lidx(I_BRE)])[(size_t)si * 16 + ci], bi = gin(a.in[lidx(I_BIM)])[(size_t)si * 16 + ci];
        bbar[idx] = (f32x2){qr * br - qi * bi, qr * bi + qi * br};
    }
}

__device__ __forceinline__ void phaseA(const Args& a, unsigned char* ws, unsigned char* smraw, int l, const float* xl, const float* xc, int tid, int mode, int boff, int nb) {
    const int wave = tid >> 6, lane = tid & 63;
    const int vb_ = lidx((int)blockIdx.x) - boff;
    const int gw = vb_ * 8 + wave, NGW = nb * 8;
    float* scr = (float*)(smraw + wave * 16384);
    const float* win = gin(a.in[lidx(I_WIN)]) + (size_t)l * DM * DIN;
    bf16_t* Wz1 = (bf16_t*)(ws + O_WZ1); bf16_t* Wkv = (bf16_t*)(ws + O_WKV);
    {
        constexpr int NJ = 17;
        constexpr int cum[NJ + 1] = {0, 512, 1024, 2048, 3072, 4096, 4160, 5696, 11840, 12224, 12736, 13248, 14272, 15296, 16320, 18368, 26560, 34752};
        const int it_lo = 0, it_hi = mode == 2 ? 0 : cum[NJ];
        for (int it = it_lo + gw; it < it_hi; it += NGW) {
            int j = 0;
#pragma unroll
            for (int k = 1; k < NJ; ++k) j += (it >= cum[k]) ? 1 : 0;
            int base = 0;
#pragma unroll
            for (int k = 1; k < NJ; ++k) base = (j == k) ? cum[k] : base;
            const float* W; int ld, K, ncols, mode = 0; bf16_t* WT;
            if (j < 8) { ld = DIN; K = DM;
                const int so[8] = {0, 512, 2048, 3088, 4176, 4112, 512, 5200}; const int nc[8] = {512, 512, 1024, 1024, 1024, 64, 1536, 6144}; const int dr[6] = {0, 512, 1024, 2048, 3072, 4096};
                int sof = 0, ncl = 0, dro = 0;
#pragma unroll
                for (int k = 0; k < 8; ++k) { sof = (j == k) ? so[k] : sof; ncl = (j == k) ? nc[k] : ncl; }
#pragma unroll
                for (int k = 0; k < 6; ++k) dro = (j == k) ? dr[k] : dro;
                W = win + sof; ncols = ncl; WT = j < 6 ? Wz1 + (size_t)dro * DM : (j == 6 ? Wkv : (bf16_t*)(ws + O_WG)); }
            else if (j == 8) { W = gin(a.in[lidx(I_WUQ)]) + (size_t)l * 512 * 1536; ld = 1536; K = 512; ncols = 1536; WT = (bf16_t*)(ws + O_WUQ); }
            else if (j == 9) { W = gin(a.in[lidx(I_WUKV)]) + (size_t)l * 512 * 2048; ld = 2048; K = 512; ncols = 2048; WT = (bf16_t*)(ws + O_WUKVK); mode = 1; }
            else if (j == 10) { W = gin(a.in[lidx(I_WGLU)]) + (size_t)l * 1024 * 1024; ld = 1024; K = 1024; ncols = 1024; WT = (bf16_t*)(ws + O_WGLU); }
            else if (j < 14) { const int r = j - 11; W = gin(a.in[lidx(I_WBR)]) + ((size_t)l * 3 + r) * 1024 * 2048; ld = 2048; K = 1024; ncols = 2048; WT = (bf16_t*)(ws + O_WBR) + (size_t)r * 2048 * 1024; }
            else if (j == 14) { W = gin(a.in[lidx(I_WOUT)]) + (size_t)l * DM * DM; ld = DM; K = DM; ncols = DM; WT = (bf16_t*)(ws + O_WOUT); }
            else if (j == 15) { W = gin(a.in[lidx(I_FF1)]) + (size_t)l * DM * DFF; ld = DFF; K = DM; ncols = DFF; WT = (bf16_t*)(ws + O_W1); }
            else { W = gin(a.in[lidx(I_FF2)]) + (size_t)l * DFF * DM; ld = DM; K = DFF; ncols = DM; WT = (bf16_t*)(ws + (l == 0 ? O_W2 : O_W2B)); }
            tr_item(W, ld, K, ncols / 32, WT, mode, scr, it - base, lane);
        }
    }
    const int gt = vb_ * 512 + tid, gs = nb * 512;
    if (mode != 2) {
    for (int idx = gt; idx < 192 * DM; idx += gs) { const int r = idx / DM, k = idx % DM;
        const float v = r < 16 ? win[(size_t)k * DIN + 3072 + r] : 0.f; Wz1[(size_t)(4160 + r) * DM + k] = (bf16_t)(cvt_pk(v, 0.f) & 0xffffu); }
    { float* b1 = (float*)(ws + O_BIAS); float* bkv = b1 + 4352; float* bg = bkv + 1536; const float* bin = gin(a.in[lidx(I_BIN)]) + (size_t)l * DIN;
      for (int i = gt; i < 4352; i += gs) { int src = -1;
          if (i < 1024) src = i; else if (i < 2048) src = 2048 + (i - 1024); else if (i < 3072) src = 3088 + (i - 2048); else if (i < 4096) src = 4176 + (i - 3072);
          else if (i < 4160) src = 4112 + (i - 4096); else if (i < 4176) src = 3072 + (i - 4160);
          b1[i] = src >= 0 ? bin[src] : 0.f; }
      for (int i = gt; i < 1536; i += gs) bkv[i] = bin[512 + i];
      for (int i = gt; i < 6144; i += gs) bg[i] = bin[5200 + i]; }
    const f32x2* lamp = (const f32x2*)(ws + O_LAMP) + (size_t)l * 64 * 2 * 65 * 64; const f32x2* bbar = (const f32x2*)(ws + O_BBAR) + (size_t)l * 64 * 2 * 64 * 16;
    bf16_t* T1 = (bf16_t*)(ws + O_T1); bf16_t* T2 = (bf16_t*)(ws + O_T2); bf16_t* KC = (bf16_t*)(ws + O_KC);
    for (int idx = gt; idx < 64 * 16 * 32 * 64; idx += gs) {
        const int ln = idx & 63, ks = (idx >> 6) & 31, rbk = (idx >> 11) & 15, g = idx >> 15;
        const int row = rbk * 16 + (ln & 15), k0 = 32 * ks + 8 * (ln >> 4);
        const int dir = row >> 7, n = (row >> 1) & 63, reim = row & 1, j = k0 >> 4, ci0 = k0 & 15;
        const int p = dir ? j : 63 - j;
        const f32x2 lp = lamp[((g * 2 + dir) * 65 + p) * 64 + n];
        const f32x2* bb = bbar + ((size_t)(g * 2 + dir) * 64 + n) * 16 + ci0;
        float v[8];
#pragma unroll
        for (int e = 0; e < 8; ++e) { const f32x2 b = bb[e]; v[e] = reim ? (lp.x * b.y + lp.y * b.x) : (lp.x * b.x - lp.y * b.y); }
        *(bf16x8*)(T1 + (size_t)g * 256 * 1024 + (size_t)idx % (16 * 32 * 64) * 8) = pack8(v);
    }
    for (int idx = gt; idx < 64 * 64 * 16 * 2 * 16; idx += gs) {
        const int co = idx & 15, q_ = (idx >> 4) & 3, ksl = (idx >> 6) & 3, dir = (idx >> 8) & 1, t = (idx >> 9) & 63, g = idx >> 15, nq = ksl * 4 + q_;
        const int p = dir ? 64 - t : t + 1, n0 = 4 * nq;
        const f32x4 cr = *(const f32x4*)(gin(a.in[lidx(I_CRE)]) + ((size_t)((l * 2 + dir) * 64 + g) * 16 + co) * 64 + n0), ci4 = *(const f32x4*)(gin(a.in[lidx(I_CIM)]) + ((size_t)((l * 2 + dir) * 64 + g) * 16 + co) * 64 + n0);
        const f32x2* lpp = lamp + ((g * 2 + dir) * 65 + p) * 64 + n0;
        float v[8];
#pragma unroll
        for (int e = 0; e < 4; ++e) { const f32x2 lp = lpp[e]; v[2 * e] = cr[e] * lp.x - ci4[e] * lp.y; v[2 * e + 1] = -(cr[e] * lp.y + ci4[e] * lp.x); }
        *(bf16x8*)(T2 + (size_t)g * 1024 * 256 + (size_t)((t * 8 + dir * 4 + (nq >> 2)) * 64 + (nq & 3) * 16 + co) * 8) = pack8(v);
    }
    { f32x2* lps = (f32x2*)smraw; float* ex = (float*)(smraw + 2 * 32 * 64 * 8);
      for (int u = vb_; u < 128; u += nb) {
        const int g = u >> 1, ph = u & 1;
        __syncthreads();
        for (int i = tid; i < 2 * 32 * 64; i += 512) { const int n = i & 63, pp = (i >> 6) & 31, dir = i >> 11; lps[i] = lamp[((g * 2 + dir) * 65 + 32 * ph + pp) * 64 + n]; }
        __syncthreads();
        const int pair = tid & 255, co = pair >> 4, ci = pair & 15, dir = tid >> 8;
        const float* cre = gin(a.in[lidx(I_CRE)]) + ((size_t)((l * 2 + dir) * 64 + g) * 16 + co) * 64; const float* cim = gin(a.in[lidx(I_CIM)]) + ((size_t)((l * 2 + dir) * 64 + g) * 16 + co) * 64;
        const f32x2* bb = bbar + ((size_t)(g * 2 + dir) * 64) * 16 + ci;
        float acc[32];
#pragma unroll
        for (int pp = 0; pp < 32; ++pp) acc[pp] = 0.f;
        for (int n = 0; n < 64; ++n) {
            const f32x2 b = bb[n * 16]; const float cr = cre[n], cm = cim[n];
            const float xr = cr * b.x - cm * b.y, xi = cr * b.y + cm * b.x;
            const f32x2* lq = lps + dir * 2048 + n;
#pragma unroll
            for (int pp = 0; pp < 32; ++pp) { const f32x2 lp = lq[pp * 64]; acc[pp] += xr * lp.x - xi * lp.y; }
        }
        if (ph == 0 && dir == 1) ex[pair] = acc[0];
        __syncthreads();
        bf16_t* kc = KC + (size_t)g * 128 * 256 + pair;
#pragma unroll
        for (int pp = 0; pp < 32; ++pp) {
            const int p = 32 * ph + pp;
            if (p == 0) { if (dir == 0) { const float v = acc[0] + ex[pair] + (co == ci ? gin(a.in[lidx(I_S5D)])[l * 1024 + g * 16 + co] : 0.f); kc[63 * 256] = (bf16_t)(cvt_pk(v, 0.f) & 0xffffu); kc[127 * 256] = 0; } }
            else kc[(dir == 0 ? 63 + p : 63 - p) * 256] = (bf16_t)(cvt_pk(acc[pp], 0.f) & 0xffffu);
        }
      }
      __syncthreads(); }
    }
    if (mode != 1) {
    norm_mod_rows(xl, xc, gin(a.in[lidx(I_NORMG)]) + (size_t)(l * 2 + 0) * DM, (const float*)(ws + O_MOD) + (size_t)l * 5 * 12288, 0, (bf16_t*)(ws + O_HX), MROWS, gw, NGW, lane);
    }
}

__device__ __forceinline__ void mla_norm(const Args& a, unsigned char* ws, int l, int gw, int NGW, int lane) {
    bf16_t* z1 = (bf16_t*)(ws + O_Z1);
    for (int it = gw; it < MROWS * 2; it += NGW) {
        const int row = it >> 1, which = it & 1;
        bf16_t* p = z1 + (size_t)row * LDZ + (which ? ZKVA : ZQA) + lane * 8;
        float v[8]; unpack8(*(const bf16x8*)p, v);
        float s = 0.f;
#pragma unroll
        for (int e = 0; e < 8; ++e) s += v[e] * v[e];
        const float rs = rsqrtf(wave_sum(s) * (1.f / 512.f) + EPS);
        const float* g = (which ? gin(a.in[lidx(I_KVAG)]) : gin(a.in[lidx(I_QAG)])) + l * 512 + lane * 8;
#pragma unroll
        for (int e = 0; e < 8; ++e) v[e] = v[e] * rs * g[e];
        *(bf16x8*)p = pack8(v);
    }
}
__device__ __forceinline__ float logsigmoidf_(float x) { return fminf(x, 0.f) - log1pf(__expf(-fabsf(x))); }
__device__ __forceinline__ float scan_add_incl(float v, int lane) {
#pragma unroll
    for (int o = 1; o < 64; o <<= 1) { const float t = __shfl_up(v, o); if (lane >= o) v += t; }
    return v;
}
__device__ __forceinline__ float scan_max_incl(float v, int lane) {
#pragma unroll
    for (int o = 1; o < 64; o <<= 1) { const float t = __shfl_up(v, o); if (lane >= o) v = fmaxf(v, t); }
    return v;
}
__device__ __forceinline__ void ml_state_pass(const Args& a, unsigned char* ws, float* sm, int l, int tid) {
    const int w = tid >> 6, lane = tid & 63, cidx = lane & 15, q = lane >> 4;
    const float* misc = (const float*)(ws + O_MISC); const bf16_t* KVt = (const bf16_t*)(ws + O_KVT);
    bf16_t* Cst = (bf16_t*)(ws + O_BR + BRSZ); float* MLG = (float*)(ws + O_MLG); float* MLN = (float*)(ws + O_MLN); float* MLM = (float*)(ws + O_MLM);
    float* wsh = sm + w * 128;
    constexpr int SP = 136, BUFB = (128 + 32) * SP * 2 + 1024;
    unsigned char* sbase = (unsigned char*)sm + 4096;
#define MLS_ROW0(ci_) ({ const int _oc = dir == 0 ? (ci_) : ((ci_) < 2 ? 1 - (ci_) : 35 - (ci_)); _oc < 2 ? NLAT + b * CTXL + _oc * MLCH : b * SEQ + (_oc - 2) * MLCH; })
#define MLS_LOAD(ci_) do { const int _r0 = MLS_ROW0(ci_); \
        _Pragma("unroll") for (int k = 0; k < 4; ++k) { const int c = tid + 512 * k, r = c >> 4, cc = c & 15; kreg[k] = *(const u32x4*)(KVt + (size_t)(h * 128 + r) * MROWS + _r0 + cc * 8); } \
        { const int r = tid >> 4, cc = tid & 15; vreg = *(const u32x4*)(KVt + (size_t)(512 + h * 256 + slice * 32 + r) * MROWS + _r0 + cc * 8); } \
        greg = 0.f; if (tid < 256) greg = misc[(size_t)(_r0 + (tid & 127)) * NMISC + 64 + (dir * 2 + (tid >> 7)) * 4 + h]; } while (0)
#define MLS_STORE(buf_) do { unsigned char* _b = sbase + (buf_) * BUFB; \
        _Pragma("unroll") for (int k = 0; k < 4; ++k) { const int c = tid + 512 * k, r = c >> 4, cc = c & 15; *(u32x4*)(_b + (r * SP + cc * 8) * 2) = kreg[k]; } \
        { const int r = tid >> 4, cc = tid & 15; *(u32x4*)(_b + ((128 + r) * SP + cc * 8) * 2) = vreg; } \
        if (tid < 256) ((float*)(_b + 160 * SP * 2))[tid] = greg; } while (0)
    for (int u = vbid(); u < 256; u += lidx((int)gridDim.x)) {
        const int chain = u >> 3, slice = u & 7, dir = chain & 1, h = (chain >> 1) & 3, b = chain >> 3;
        const float bi = gin(a.in[lidx(I_MLGB)])[l * 16 + (dir * 2 + 0) * 4 + h], bf = gin(a.in[lidx(I_MLGB)])[l * 16 + (dir * 2 + 1) * 4 + h];
        const int i0 = 2 * lane, j0 = dir ? 127 - i0 : i0, j1 = dir ? 126 - i0 : i0 + 1;
        f32x4 acc[2] = {(f32x4){0.f, 0.f, 0.f, 0.f}, (f32x4){0.f, 0.f, 0.f, 0.f}};
        float nv = 0.f, m = 0.f;
        u32x4 kreg[4], vreg; float greg;
        __syncthreads();
        MLS_LOAD(0); __builtin_amdgcn_sched_barrier(0); MLS_STORE(0); __syncthreads();
#pragma unroll 1
        for (int ci = 0; ci < MLNC; ++ci) {
            const int row0 = MLS_ROW0(ci);
            if (ci + 1 < MLNC) MLS_LOAD(ci + 1);
            __builtin_amdgcn_sched_barrier(0);
            const unsigned char* cb_ = sbase + (ci & 1) * BUFB;
            const bf16_t* Ksh = (const bf16_t*)cb_; const bf16_t* Vsh = Ksh + 128 * SP; const float* gs = (const float*)(cb_ + 160 * SP * 2);
            const float li0 = gs[j0] + bi, li1 = gs[j1] + bi;
            const float lf0 = logsigmoidf_(gs[128 + j0] + bf), lf1 = logsigmoidf_(gs[128 + j1] + bf);
            const float S = scan_add_incl(lf0 + lf1, lane);
            const float G1 = S, G0 = S - lf1, a0 = li0 - G0, a1 = li1 - G1;
            const float pmx = scan_max_incl(fmaxf(a0, a1), lane);
            float prev = __shfl_up(pmx, 1); if (lane == 0) prev = -1e30f;
            const float pm0 = fmaxf(prev, a0), pm1 = pmx;
            const float Ftot = __shfl(S, 63), Ac = __shfl(pmx, 63);
            const float Mx = fmaxf(m, Ac), decay = __expf(m - Mx);
            asm volatile("s_waitcnt lgkmcnt(0)" ::: "memory");
            wsh[j0] = __expf(a0 - Mx); wsh[j1] = __expf(a1 - Mx);
            if (slice == 0 && w == 0) { const size_t o = (size_t)(dir * 4 + h) * MROWS + row0;
                MLG[o + j0] = G0; MLG[o + j1] = G1; MLG[(size_t)8 * MROWS + o + j0] = a0; MLG[(size_t)8 * MROWS + o + j1] = a1; MLG[(size_t)16 * MROWS + o + j0] = pm0; MLG[(size_t)16 * MROWS + o + j1] = pm1;
                if (lane == 0) MLM[chain * MLNC + ci] = m; }
            if (slice == 0 && q == 0) MLN[((size_t)chain * MLNC + ci) * 128 + 16 * w + cidx] = nv;
#pragma unroll
            for (int i = 0; i < 2; ++i)
#pragma unroll
                for (int r = 0; r < 4; ++r) Cst[(((size_t)chain * MLNC + ci) * 256 + slice * 32 + 16 * i + 4 * q + r) * 128 + 16 * w + cidx] = (bf16_t)(cvt_pk(acc[i][r], 0.f) & 0xffffu);
            asm volatile("s_waitcnt lgkmcnt(0)" ::: "memory");
            acc[0] *= decay; acc[1] *= decay;
            float nsum = 0.f;
#pragma unroll
            for (int ks = 0; ks < 4; ++ks) {
                const f32x4 w0 = *(const f32x4*)(wsh + 32 * ks + 8 * q), w1 = *(const f32x4*)(wsh + 32 * ks + 8 * q + 4);
                float kf[8]; unpack8(*(const bf16x8*)(Ksh + (16 * w + cidx) * SP + 32 * ks + 8 * q), kf);
#pragma unroll
                for (int e = 0; e < 4; ++e) { kf[e] *= w0[e]; kf[4 + e] *= w1[e]; nsum += kf[e] + kf[4 + e]; }
                const bf16x8 kb = pack8(kf);
#pragma unroll
                for (int i = 0; i < 2; ++i) acc[i] = mfma16(*(const bf16x8*)(Vsh + (16 * i + cidx) * SP + 32 * ks + 8 * q), kb, acc[i]);
            }
            nsum += __shfl_xor(nsum, 16); nsum += __shfl_xor(nsum, 32);
            nv = decay * nv + nsum;
            m = Ftot + Mx;
            __builtin_amdgcn_sched_barrier(0);
            if (ci + 1 < MLNC) MLS_STORE((ci + 1) & 1);
            __syncthreads();
        }
    }
#undef MLS_LOAD
#undef MLS_STORE
#undef MLS_ROW0
    __syncthreads();
}
__device__ __forceinline__ int s5_rowbase(int cc) { const int b = cc / S5NCH, ch = cc - b * S5NCH; const int r1 = NLAT + b * CTXL + ch * 64, r2 = b * SEQ + (ch - 4) * 64; return __builtin_amdgcn_readfirstlane(0) + ((ch < 4) ? r1 : r2); }
constexpr int UPITCH = 1032, XPITCH = 264;
__device__ __forceinline__ void s5_stage_u(const bf16_t* z1, bf16_t* Us, int g, int cb, int tid) {
    u32x4 tmp[4];
#pragma unroll
    for (int i = 0; i < 4; ++i) { const int c = tid + 512 * i, cc = c >> 7, j = (c >> 1) & 63, hf = c & 1;
        const int rowb = s5_rowbase(cb * 16 + cc);
        tmp[i] = *(const u32x4*)(z1 + (size_t)(rowb + j) * LDZ + ZU + g * 16 + 8 * hf); }
    __builtin_amdgcn_sched_barrier(0);
#pragma unroll
    for (int i = 0; i < 4; ++i) { const int c = tid + 512 * i, cc = c >> 7, j = (c >> 1) & 63, hf = c & 1;
        *(u32x4*)(Us + cc * UPITCH + j * 16 + 8 * hf) = tmp[i]; }
}
__device__ __forceinline__ void s5_pass1(unsigned char* ws, unsigned char* sm, int tid) {
    const int w = tid >> 6, lane = tid & 63, cidx = lane & 15, q = lane >> 4;
    const bf16_t* z1 = (const bf16_t*)(ws + O_Z1); const bf16_t* T1 = (const bf16_t*)(ws + O_T1); float* E = (float*)(ws + O_E);
    bf16_t* Us = (bf16_t*)sm;
    for (int u = vbid(); u < 64 * 17; u += lidx((int)gridDim.x)) {
        const int cb = u % 17, g = u / 17;
        __syncthreads();
        s5_stage_u(z1, Us, g, cb, tid);
        __syncthreads();
        f32x4 acc[2] = {(f32x4){0.f, 0.f, 0.f, 0.f}, (f32x4){0.f, 0.f, 0.f, 0.f}};
        const bf16_t* tp = T1 + (size_t)g * 256 * 1024 + (size_t)(2 * w) * 32 * 512 + lane * 8;
        const bf16_t* up = Us + cidx * UPITCH + 8 * q;
#pragma unroll 1
        for (int ks0 = 0; ks0 < 32; ks0 += 8) {
            bf16x8 af[8][2];
#pragma unroll
            for (int i = 0; i < 8; ++i) { af[i][0] = ldg8(tp + 512 * (ks0 + i)); af[i][1] = ldg8(tp + 32 * 512 + 512 * (ks0 + i)); }
            __builtin_amdgcn_sched_barrier(0);
#pragma unroll
            for (int i = 0; i < 8; ++i) { const bf16x8 bfr = *(const bf16x8*)(up + 32 * (ks0 + i)); acc[0] = mfma16(af[i][0], bfr, acc[0]); acc[1] = mfma16(af[i][1], bfr, acc[1]); }
            __builtin_amdgcn_sched_barrier(0);
        }
        const int cc = cb * 16 + cidx;
        *(f32x4*)(E + ((size_t)g * S5COLS + cc) * 256 + (w * 2) * 16 + 4 * q) = acc[0];
        *(f32x4*)(E + ((size_t)g * S5COLS + cc) * 256 + (w * 2 + 1) * 16 + 4 * q) = acc[1];
    }
    __syncthreads();
}
__device__ __forceinline__ void s5_scan(unsigned char* ws, int l, int tid) {
    const f32x2* lamp = (const f32x2*)(ws + O_LAMP) + (size_t)l * 64 * 2 * 65 * 64; const float* E = (const float*)(ws + O_E); bf16_t* X = (bf16_t*)(ws + O_X);
    for (int idx = lidx((int)blockIdx.x) * 512 + tid; idx < 64 * 4 * 2 * 64; idx += lidx((int)gridDim.x) * 512) {
        const int n = idx & 63, dir = (idx >> 6) & 1, b = (idx >> 7) & 3, g = idx >> 9;
        const f32x2 l64 = lamp[((g * 2 + dir) * 65 + 64) * 64 + n];
        float xr = 0.f, xi = 0.f;
#pragma unroll 1
        for (int s0 = 0; s0 < S5NCH; s0 += 17) {
            f32x2 ev[17];
#pragma unroll
            for (int k = 0; k < 17; ++k) { const int step = s0 + k, ch = dir == 0 ? step : (step < 4 ? 3 - step : 71 - step);
                ev[k] = *(const f32x2*)(E + ((size_t)g * S5COLS + b * S5NCH + ch) * 256 + dir * 128 + 2 * n); }
            __builtin_amdgcn_sched_barrier(0);
#pragma unroll
            for (int k = 0; k < 17; ++k) { const int step = s0 + k, ch = dir == 0 ? step : (step < 4 ? 3 - step : 71 - step);
                const size_t o = ((size_t)g * S5COLS + b * S5NCH + ch) * 256 + dir * 128 + 2 * n;
                *(unsigned*)(X + o) = cvt_pk(xr, xi);
                const float nr = l64.x * xr - l64.y * xi + ev[k].x, ni = l64.x * xi + l64.y * xr + ev[k].y; xr = nr; xi = ni; }
        }
    }
}
__device__ __forceinline__ float gelu_tanh(float x) { const float u = 0.7978845608028654f * (x + 0.044715f * x * x * x); return 0.5f * x * (1.f + tanhf(u)); }
__device__ __forceinline__ void s5_pass2(unsigned char* ws, unsigned char* sm, int tid) {
    const int w = tid >> 6, lane = tid & 63, cidx = lane & 15, q = lane >> 4;
    const bf16_t* z1 = (const bf16_t*)(ws + O_Z1); const bf16_t* T2 = (const bf16_t*)(ws + O_T2); const bf16_t* KC = (const bf16_t*)(ws + O_KC); const bf16_t* X = (const bf16_t*)(ws + O_X);
    bf16_t* Gs = (bf16_t*)(ws + O_GS);
    bf16_t* Us = (bf16_t*)sm; bf16_t* Xs = Us + 16 * UPITCH; bf16_t* KCs = Xs + 16 * XPITCH;
    for (int u = vbid(); u < 64 * 17; u += lidx((int)gridDim.x)) {
        const int cb = u % 17, g = u / 17;
        __syncthreads();
        s5_stage_u(z1, Us, g, cb, tid);
        { u32x4 kt[8]; const int cc = tid >> 5, part = tid & 31; const u32x4 xt = *(const u32x4*)(X + ((size_t)g * S5COLS + cb * 16 + cc) * 256 + part * 8);
#pragma unroll
          for (int i = 0; i < 8; ++i) { const int c = tid + 512 * i; kt[i] = *(const u32x4*)(KC + (size_t)g * 128 * 256 + c * 8); }
          __builtin_amdgcn_sched_barrier(0);
          *(u32x4*)(Xs + cc * XPITCH + part * 8) = xt;
#pragma unroll
          for (int i = 0; i < 8; ++i) { const int c = tid + 512 * i; *(u32x4*)(KCs + c * 8) = kt[i]; } }
        __syncthreads();
        f32x4 acc[8];
#pragma unroll
        for (int i = 0; i < 8; ++i) acc[i] = (f32x4){0.f, 0.f, 0.f, 0.f};
        const bf16_t* kp = KCs + (63 - (q >> 1) + 8 * w) * 256 + cidx * 16 + 8 * (q & 1);
        const bf16_t* up = Us + cidx * UPITCH + 8 * q;
#pragma unroll 4
        for (int ks = 0; ks < 32; ++ks) {
            const bf16x8 bfr = *(const bf16x8*)(up + 32 * ks);
#pragma unroll
            for (int tb = 0; tb < 8; ++tb) acc[tb] = mfma16(*(const bf16x8*)(kp + (tb - 2 * ks) * 256), bfr, acc[tb]);
        }
        const bf16_t* xp = Xs + cidx * XPITCH + 8 * q;
        const bf16_t* tp = T2 + (size_t)g * 1024 * 256 + (size_t)(8 * w) * 8 * 512 + lane * 8;
#pragma unroll 1
        for (int ks0 = 0; ks0 < 8; ks0 += 2) {
            bf16x8 af[2][8];
#pragma unroll
            for (int i = 0; i < 2; ++i)
#pragma unroll
                for (int tb = 0; tb < 8; ++tb) af[i][tb] = ldg8(tp + (size_t)tb * 8 * 512 + 512 * (ks0 + i));
            __builtin_amdgcn_sched_barrier(0);
#pragma unroll
            for (int i = 0; i < 2; ++i) { const bf16x8 bfr = *(const bf16x8*)(xp + 32 * (ks0 + i));
#pragma unroll
                for (int tb = 0; tb < 8; ++tb) acc[tb] = mfma16(af[i][tb], bfr, acc[tb]); }
            __builtin_amdgcn_sched_barrier(0);
        }
        const int rowb = s5_rowbase(cb * 16 + cidx);
#pragma unroll
        for (int tb = 0; tb < 8; ++tb) { u32x2 o; o.x = cvt_pk(gelu_tanh(acc[tb][0]), gelu_tanh(acc[tb][1])); o.y = cvt_pk(gelu_tanh(acc[tb][2]), gelu_tanh(acc[tb][3]));
            *(u32x2*)(Gs + (size_t)(rowb + 8 * w + tb) * 1024 + g * 16 + 4 * q) = o; }
    }
    __syncthreads();
}
__device__ __forceinline__ void qk_prep(const Args& a, unsigned char* ws, int l, int gw, int NGW, int lane) {
    const int h = lane >> 3, sub = lane & 7;
    const float* misc = (const float*)(ws + O_MISC);
    for (int it = gw; it < MROWS * 2; it += NGW) {
        const int row = it >> 1, which = it & 1;
        bf16_t* p = (bf16_t*)(ws + (which ? O_K : O_Q)) + (size_t)row * 1536 + h * 192 + 8 * sub;
        const float* gn = (which ? gin(a.in[lidx(I_KNG)]) : gin(a.in[lidx(I_QNG)])) + l * 192 + 8 * sub;
        float v[3][8];
        unpack8(*(const bf16x8*)p, v[0]); unpack8(*(const bf16x8*)(p + 64), v[1]);
        if (which) { const f32x4 k0 = *(const f32x4*)(misc + (size_t)row * NMISC + 8 * sub), k1 = *(const f32x4*)(misc + (size_t)row * NMISC + 8 * sub + 4);
#pragma unroll
            for (int e = 0; e < 4; ++e) { v[2][e] = k0[e]; v[2][4 + e] = k1[e]; } }
        else unpack8(*(const bf16x8*)(p + 128), v[2]);
        float s = 0.f;
#pragma unroll
        for (int j = 0; j < 3; ++j)
#pragma unroll
            for (int e = 0; e < 8; ++e) s += v[j][e] * v[j][e];
        s += __shfl_xor(s, 1); s += __shfl_xor(s, 2); s += __shfl_xor(s, 4);
        const float rs = rsqrtf(s * (1.f / 192.f) + EPS);
#pragma unroll
        for (int j = 0; j < 3; ++j)
#pragma unroll
            for (int e = 0; e < 8; ++e) v[j][e] = v[j][e] * rs * gn[64 * j + e];
        if (row < NLAT) {
            const int t = row & (SEQ - 1);
            const int pos = (sub >> 2) ? (t & 63) : (t >> 6);
            const f32x2* rp = (const f32x2*)(ws + O_ROPE) + pos * 16 + 8 * (sub & 1);
            f32x2 cs8[8];
#pragma unroll
            for (int e = 0; e < 8; ++e) cs8[e] = rp[e];
#pragma unroll
            for (int e = 0; e < 8; ++e) {
                const float partner = __shfl_xor(v[2][e], 2);
                v[2][e] = (sub & 2) ? (v[2][e] * cs8[e].x + partner * cs8[e].y) : (v[2][e] * cs8[e].x - partner * cs8[e].y);
            }
        }
        *(bf16x8*)p = pack8(v[0]); *(bf16x8*)(p + 64) = pack8(v[1]); *(bf16x8*)(p + 128) = pack8(v[2]);
    }
}

__device__ __forceinline__ void ml_out_pass(const Args& a, unsigned char* ws, unsigned char* sm, int l, bool with_ctx, int tid) {
    const int w = tid >> 6, lane = tid & 63, cidx = lane & 15, q = lane >> 4;
    const bf16_t* z1 = (const bf16_t*)(ws + O_Z1); const bf16_t* KVt = (const bf16_t*)(ws + O_KVT); const bf16_t* Cst = (const bf16_t*)(ws + O_BR + BRSZ);
    const float* MLG = (const float*)(ws + O_MLG); const float* MLN = (const float*)(ws + O_MLN); const float* MLM = (const float*)(ws + O_MLM);
    bf16_t* BRa = (bf16_t*)(ws + O_BR);
    constexpr int KP = 136;
    bf16_t* Ks = (bf16_t*)sm; float* As = (float*)(sm + 128 * KP * 2);
    const float scale = 0.08838834764831845f;
    for (int u = vbid(); u < 4 * 4 * MLNC; u += lidx((int)gridDim.x)) {
        const int oc = u % MLNC, h = (u / MLNC) & 3, b = u / (4 * MLNC);
        if (!with_ctx && oc < 2) continue;
        const int row0 = oc < 2 ? NLAT + b * CTXL + oc * MLCH : b * SEQ + (oc - 2) * MLCH;
        const int rb = w, t = 16 * rb + cidx;
        __syncthreads();
        { u32x4 kt[4];
#pragma unroll
          for (int i = 0; i < 4; ++i) { const int c = tid + 512 * i, r = c >> 4, cc = c & 15; kt[i] = *(const u32x4*)(z1 + (size_t)(row0 + r) * LDZ + ZK + h * 128 + cc * 8); }
          float av = 0.f; if (tid < 256) av = MLG[(size_t)(8 + (tid >> 7) * 4 + h) * MROWS + row0 + (tid & 127)];
          __builtin_amdgcn_sched_barrier(0);
#pragma unroll
          for (int i = 0; i < 4; ++i) { const int c = tid + 512 * i, r = c >> 4, cc = c & 15; *(u32x4*)(Ks + r * KP + cc * 8) = kt[i]; }
          if (tid < 256) As[tid] = av; }
        bf16x8 qf[4];
#pragma unroll
        for (int ks = 0; ks < 4; ++ks) qf[ks] = ldg8(z1 + (size_t)(row0 + t) * LDZ + ZQ + h * 128 + 32 * ks + 8 * q);
        __syncthreads();
        bf16x8 pf[2][4]; float inv2[2], wsc2[2];
#pragma unroll
        for (int dir = 0; dir < 2; ++dir) {
            const int chain = (b * 4 + h) * 2 + dir, ci = dir == 0 ? oc : (oc < 2 ? 1 - oc : 35 - oc);
            const float mc = MLM[chain * MLNC + ci];
            const float* Gp = MLG + (size_t)(dir * 4 + h) * MROWS + row0; const float* pp = Gp + (size_t)16 * MROWS;
            const float Gt = Gp[t], Mt = fmaxf(mc, pp[t]);
            f32x4 nq[4][2];
            { const float* np = MLN + ((size_t)chain * MLNC + ci) * 128 + 8 * q;
#pragma unroll
              for (int ks = 0; ks < 4; ++ks) { nq[ks][0] = *(const f32x4*)(np + 32 * ks); nq[ks][1] = *(const f32x4*)(np + 32 * ks + 4); } }
            __builtin_amdgcn_sched_barrier(0);
            const float winter = __expf(mc - Mt);
            float qn = 0.f;
#pragma unroll
            for (int ks = 0; ks < 4; ++ks) { float qv[8]; unpack8(qf[ks], qv);
#pragma unroll
                for (int e = 0; e < 4; ++e) qn += qv[e] * nq[ks][0][e] + qv[4 + e] * nq[ks][1][e]; }
            qn += __shfl_xor(qn, 16); qn += __shfl_xor(qn, 32);
            float rsum = 0.f;
#pragma unroll
            for (int i = 0; i < 4; ++i) {
                float pv[8];
#pragma unroll
                for (int hb = 0; hb < 2; ++hb) {
                    const int kb = 2 * i + hb;
                    const bool skip = dir == 0 ? (kb > rb) : (kb < rb);
                    f32x4 sacc = (f32x4){0.f, 0.f, 0.f, 0.f};
                    if (!(a.sub & 16))
#pragma unroll
                    for (int ks = 0; ks < 4; ++ks) sacc = mfma16(*(const bf16x8*)(Ks + (16 * kb + cidx) * KP + 32 * ks + 8 * q), qf[ks], sacc);
                    const f32x4 a4 = *(const f32x4*)(As + dir * 128 + 16 * kb + 4 * q);
#pragma unroll
                    for (int r = 0; r < 4; ++r) {
                        const int sidx = 16 * kb + 4 * q + r;
                        const bool valid = !skip && (dir == 0 ? (sidx <= t) : (sidx >= t));
                        const float e = __expf(fminf(a4[r] - Mt, 0.f));
                        const float val = valid ? sacc[r] * scale * e : 0.f;
                        pv[hb * 4 + r] = val; rsum += val;
                    }
                }
                pf[dir][i] = pack8(pv);
            }
            rsum += __shfl_xor(rsum, 16); rsum += __shfl_xor(rsum, 32);
            const float den = winter * qn * scale + rsum;
            inv2[dir] = 1.f / fmaxf(fabsf(den), __expf(-(Gt + Mt)));
            wsc2[dir] = winter * scale;
        }
        float ss = 0.f;
        bf16_t* dp = BRa + (size_t)(row0 + t) * 1024 + h * 256 + 4 * q;
        const int ci0 = oc, ci1 = oc < 2 ? 1 - oc : 35 - oc;
        constexpr int SP = 136, SBUF = 64 * SP;
        bf16_t* stg = (bf16_t*)(sm + 36864);
        const bf16_t* cg0 = Cst + ((size_t)((b * 4 + h) * 2 + 0) * MLNC + ci0) * 256 * 128;
        const bf16_t* cg1 = Cst + ((size_t)((b * 4 + h) * 2 + 1) * MLNC + ci1) * 256 * 128;
        const bf16_t* vg = KVt + (size_t)(512 + h * 256) * MROWS + row0;
        u32x4 sreg[6];
#define MLO_SLOAD(s_) do { _Pragma("unroll") for (int k = 0; k < 6; ++k) { const int c = tid + 512 * k, which = c >> 10, idx = c & 1023, r = idx >> 4, cc = idx & 15; \
            const bf16_t* src = which == 0 ? cg0 + (size_t)(64 * (s_) + r) * 128 + cc * 8 : (which == 1 ? cg1 + (size_t)(64 * (s_) + r) * 128 + cc * 8 : vg + (size_t)(64 * (s_) + r) * MROWS + cc * 8); \
            sreg[k] = *(const u32x4*)src; } } while (0)
#define MLO_SSTORE(buf_) do { _Pragma("unroll") for (int k = 0; k < 6; ++k) { const int c = tid + 512 * k, which = c >> 10, idx = c & 1023, r = idx >> 4, cc = idx & 15; \
            *(u32x4*)(stg + (buf_) * 3 * SBUF + which * SBUF + r * SP + cc * 8) = sreg[k]; } } while (0)
        MLO_SLOAD(0); __builtin_amdgcn_sched_barrier(0); MLO_SSTORE(0); __syncthreads();
#pragma unroll 1
        for (int st = 0; st < ((a.sub & 8) ? 0 : 4); ++st) {
            if (st + 1 < 4) MLO_SLOAD(st + 1);
            __builtin_amdgcn_sched_barrier(0);
            const bf16_t* sb = stg + (st & 1) * 3 * SBUF;
#pragma unroll
            for (int d4 = 0; d4 < 4; ++d4) {
                f32x4 hsum = (f32x4){0.f, 0.f, 0.f, 0.f};
                const bf16_t* vrow = sb + 2 * SBUF + (16 * d4 + cidx) * SP + 4 * q;
#pragma unroll
                for (int dir = 0; dir < 2; ++dir) {
                    const bf16_t* crow = sb + dir * SBUF + (16 * d4 + cidx) * SP + 8 * q;
                    f32x4 acc = (f32x4){0.f, 0.f, 0.f, 0.f};
#pragma unroll
                    for (int ks = 0; ks < 4; ++ks) acc = mfma16(*(const bf16x8*)(crow + 32 * ks), qf[ks], acc);
                    acc *= wsc2[dir];
#pragma unroll
                    for (int i = 0; i < 4; ++i) { const u32x2 lo = *(const u32x2*)(vrow + 32 * i), hi = *(const u32x2*)(vrow + 32 * i + 16);
                        const u32x4 av = (u32x4){lo.x, lo.y, hi.x, hi.y}; acc = mfma16(__builtin_bit_cast(bf16x8, av), pf[dir][i], acc); }
                    hsum += acc * inv2[dir];
                }
                ss += hsum[0] * hsum[0] + hsum[1] * hsum[1] + hsum[2] * hsum[2] + hsum[3] * hsum[3];
                u32x2 r_; r_.x = cvt_pk(hsum[0], hsum[1]); r_.y = cvt_pk(hsum[2], hsum[3]); *(u32x2*)(dp + 16 * (4 * st + d4)) = r_;
            }
            __builtin_amdgcn_sched_barrier(0);
            if (st + 1 < 4) MLO_SSTORE((st + 1) & 1);
            __syncthreads();
        }
#undef MLO_SLOAD
#undef MLO_SSTORE
        ss += __shfl_xor(ss, 16); ss += __shfl_xor(ss, 32);
        const float rs = rsqrtf(ss * (1.f / 256.f) + EPS);
        const float* ng = gin(a.in[lidx(I_MLNG)]) + (size_t)l * 1024 + h * 256 + 4 * q;
        const bf16_t* op = z1 + (size_t)(row0 + t) * LDZ + ZO + h * 256 + 4 * q;
#pragma unroll 1
        for (int i0 = 0; i0 < 16; i0 += 4) {
            u32x2 ov[4], hv[4]; f32x4 g4[4];
#pragma unroll
            for (int k = 0; k < 4; ++k) { ov[k] = *(const u32x2*)(op + 16 * (i0 + k)); g4[k] = *(const f32x4*)(ng + 16 * (i0 + k)); hv[k] = *(const u32x2*)(dp + 16 * (i0 + k)); }
            __builtin_amdgcn_sched_barrier(0);
#pragma unroll
            for (int k = 0; k < 4; ++k) {
                const float o0 = __uint_as_float(ov[k].x << 16), o1 = __uint_as_float(ov[k].x & 0xffff0000u), o2 = __uint_as_float(ov[k].y << 16), o3 = __uint_as_float(ov[k].y & 0xffff0000u);
                const float h0 = __uint_as_float(hv[k].x << 16), h1 = __uint_as_float(hv[k].x & 0xffff0000u), h2 = __uint_as_float(hv[k].y << 16), h3 = __uint_as_float(hv[k].y & 0xffff0000u);
                u32x2 r; r.x = cvt_pk(h0 * rs * g4[k][0] * sigmoidf_(o0), h1 * rs * g4[k][1] * sigmoidf_(o1)); r.y = cvt_pk(h2 * rs * g4[k][2] * sigmoidf_(o2), h3 * rs * g4[k][3] * sigmoidf_(o3));
                *(u32x2*)(dp + 16 * (i0 + k)) = r;
            }
        }
    }
    __syncthreads();
}

constexpr int VPITCH = 72, KTILE_B = 64 * 24 * 16, VTILE_B = 128 * VPITCH * 2;
__device__ __forceinline__ void attn_phase(unsigned char* ws, unsigned char* sm, bool with_ctx, int tid) {
    const int w = tid >> 6, lane = tid & 63, cidx = lane & 15, q = lane >> 4;
    const bf16_t* Q = (const bf16_t*)(ws + O_Q); const bf16_t* K = (const bf16_t*)(ws + O_K); const bf16_t* Vt = (const bf16_t*)(ws + O_VTA);
    bf16_t* out = (bf16_t*)(ws + O_BR + BRSZ);
    const float C = 0.07216878364870322f * 1.4426950408889634f;
    const int nunits = 512 + (with_ctx ? 32 : 0);
    for (int u = vbid(); u < nunits; u += lidx((int)gridDim.x)) {
        int b, h, qrow0, ntiles;
        if (u < 512) { b = u >> 7; h = (u >> 4) & 7; qrow0 = b * SEQ + (u & 15) * 256; ntiles = 68; }
        else { const int uu = u - 512; b = uu >> 3; h = uu & 7; qrow0 = NLAT + b * CTXL; ntiles = 4; }
        bf16x8 qf[2][6];
#pragma unroll
        for (int qq = 0; qq < 2; ++qq)
#pragma unroll
            for (int ks = 0; ks < 6; ++ks) qf[qq][ks] = ldg8(Q + (size_t)(qrow0 + 32 * w + 16 * qq + cidx) * 1536 + h * 192 + 32 * ks + 8 * q);
        f32x4 o[8][2];
#pragma unroll
        for (int i = 0; i < 8; ++i) { o[i][0] = (f32x4){0.f, 0.f, 0.f, 0.f}; o[i][1] = (f32x4){0.f, 0.f, 0.f, 0.f}; }
        float mrun[2] = {-1e30f, -1e30f}, lsum[2] = {0.f, 0.f};
        unsigned koff[4], voff[3];
#pragma unroll
        for (int i = 0; i < 3; ++i) { const int L = (w + 8 * i) * 64 + lane, r = L / 24, cl = L - r * 24, cc = cl ^ (r & 7); koff[i] = (unsigned)((r * 1536 + h * 192 + cc * 8) * 2); }
        koff[3] = 0u;
#pragma unroll
        for (int i = 0; i < 3; ++i) { const int c = (w + 8 * i) * 64 + lane, r = c / 9; int cc = c - r * 9; if (cc == 8) cc = 0; voff[i] = (unsigned)(((h * 128 + r) * MROWS + cc * 8) * 2); }
#define ATT_LOAD(j, buf) do { const int _kr = (j) < 4 ? NLAT + b * CTXL + 64 * (j) : b * SEQ + 64 * ((j) - 4); \
        const char* _kg = (const char*)(K + (size_t)_kr * 1536); const char* _vg = (const char*)(Vt + _kr); \
        LAS unsigned char* _kb = (LAS unsigned char*)sm + (buf) * (KTILE_B + VTILE_B); LAS unsigned char* _vb = _kb + KTILE_B; \
        _Pragma("unroll") for (int _i = 0; _i < 3; ++_i) __builtin_amdgcn_global_load_lds((const unsigned*)(_kg + koff[_i]), (LAS unsigned*)(_kb + (w + 8 * _i) * 1024), 16, 0, 0); \
        _Pragma("unroll") for (int _i = 0; _i < 3; ++_i) if (w + 8 * _i < 18) __builtin_amdgcn_global_load_lds((const unsigned*)(_vg + voff[_i]), (LAS unsigned*)(_vb + (w + 8 * _i) * 1024), 16, 0, 0); } while (0)
#define ATT_STORE(buf) do { } while (0)
        ATT_LOAD(0, 0); asm volatile("s_waitcnt vmcnt(0)" ::: "memory"); __syncthreads();
        for (int j = 0; j < ntiles; ++j) {
            if (j + 1 < ntiles) ATT_LOAD(j + 1, (j + 1) & 1);
            const unsigned char* kb_ = sm + (j & 1) * (KTILE_B + VTILE_B); const unsigned char* vb_ = kb_ + KTILE_B;
            f32x4 s[4][2];
#pragma unroll
            for (int kb = 0; kb < 4; ++kb) { s[kb][0] = (f32x4){0.f, 0.f, 0.f, 0.f}; s[kb][1] = (f32x4){0.f, 0.f, 0.f, 0.f};
#pragma unroll
                for (int ks = 0; ks < 6; ++ks) { const bf16x8 af = *(const bf16x8*)(kb_ + ((16 * kb + cidx) * 24 + ((4 * ks + q) ^ (cidx & 7))) * 16);
                    s[kb][0] = mfma16(af, qf[0][ks], s[kb][0]); s[kb][1] = mfma16(af, qf[1][ks], s[kb][1]); } }
            bf16x8 pf[2][2];
#pragma unroll
            for (int qq = 0; qq < 2; ++qq) {
                float mx = fmaxf(fmaxf(s[0][qq][0], s[0][qq][1]), fmaxf(s[0][qq][2], s[0][qq][3]));
#pragma unroll
                for (int kb = 1; kb < 4; ++kb) mx = fmaxf(mx, fmaxf(fmaxf(s[kb][qq][0], s[kb][qq][1]), fmaxf(s[kb][qq][2], s[kb][qq][3])));
                if (!__all(mx - mrun[qq] <= 110.851251684f)) {
                    mx = fmaxf(mx, __shfl_xor(mx, 16)); mx = fmaxf(mx, __shfl_xor(mx, 32));
                    const float mnew = fmaxf(mrun[qq], mx), alpha = __builtin_amdgcn_exp2f((mrun[qq] - mnew) * C);
                    mrun[qq] = mnew; lsum[qq] *= alpha;
#pragma unroll
                    for (int i = 0; i < 8; ++i) o[i][qq] *= alpha;
                }
                const float mc = mrun[qq] * C;
                float ps = 0.f; float pv[4][4];
#pragma unroll
                for (int kb = 0; kb < 4; ++kb)
#pragma unroll
                    for (int r = 0; r < 4; ++r) { pv[kb][r] = __builtin_amdgcn_exp2f(fmaf(s[kb][qq][r], C, -mc)); ps += pv[kb][r]; }
                lsum[qq] += ps;
#pragma unroll
                for (int i = 0; i < 2; ++i) { u32x4 pw; pw.x = cvt_pk(pv[2 * i][0], pv[2 * i][1]); pw.y = cvt_pk(pv[2 * i][2], pv[2 * i][3]); pw.z = cvt_pk(pv[2 * i + 1][0], pv[2 * i + 1][1]); pw.w = cvt_pk(pv[2 * i + 1][2], pv[2 * i + 1][3]);
                    pf[qq][i] = __builtin_bit_cast(bf16x8, pw); }
            }
#pragma unroll
            for (int dvb = 0; dvb < 8; ++dvb)
#pragma unroll
                for (int i = 0; i < 2; ++i) {
                    const unsigned char* vq = vb_ + ((16 * dvb + cidx) * VPITCH + 32 * i + 4 * q) * 2;
                    const u32x2 lo = *(const u32x2*)vq; asm volatile("" ::: "memory"); const u32x2 hi = *(const u32x2*)(vq + 32); asm volatile("" ::: "memory");
                    const bf16x8 af = __builtin_bit_cast(bf16x8, ((u32x4){lo.x, lo.y, hi.x, hi.y}));
                    o[dvb][0] = mfma16(af, pf[0][i], o[dvb][0]); o[dvb][1] = mfma16(af, pf[1][i], o[dvb][1]);
                }
            asm volatile("s_waitcnt vmcnt(0)" ::: "memory");
            __syncthreads();
        }
#pragma unroll
        for (int qq = 0; qq < 2; ++qq) {
            float lt = lsum[qq]; lt += __shfl_xor(lt, 16); lt += __shfl_xor(lt, 32);
            const float inv = 1.f / lt;
            bf16_t* dp = out + (size_t)(qrow0 + 32 * w + 16 * qq + cidx) * 1024 + h * 128 + 4 * q;
#pragma unroll
            for (int dvb = 0; dvb < 8; ++dvb) { u32x2 r; r.x = cvt_pk(o[dvb][qq][0] * inv, o[dvb][qq][1] * inv); r.y = cvt_pk(o[dvb][qq][2] * inv, o[dvb][qq][3] * inv); *(u32x2*)(dp + 16 * dvb) = r; }
        }
    }
#undef ATT_LOAD
#undef ATT_STORE
}


#define XB_TMO      128
#define XB_XCNT(j)  (256  + 64 * (j))
#define XB_XSUB(j)  (1280 + 64 * (j))
#define XB_XGEN(j)  (2304 + 64 * (j))
#define XB_TOP      3328
#define XB_TOPGEN   3392
#define XCD_BAR_WORDS 3456
#define XB_SPIN_CAP (1u << 18)
__device__ __forceinline__ unsigned xb_ld(unsigned* p)              { return __hip_atomic_load(p, __ATOMIC_RELAXED, __HIP_MEMORY_SCOPE_AGENT); }
__device__ __forceinline__ unsigned xb_add(unsigned* p, unsigned v) { return __hip_atomic_fetch_add(p, v, __ATOMIC_RELAXED, __HIP_MEMORY_SCOPE_AGENT); }
__device__ __forceinline__ unsigned xb_xcc_id() { return (unsigned)__builtin_amdgcn_s_getreg((3 << 11) | 20) & 0xFu; }
#define XB_SPIN(cond, bar) do { unsigned _sp = 0; while (cond) { __builtin_amdgcn_s_sleep(1); \
    if ((++_sp & 255u) == 0u) { if (xb_ld(&(bar)[XB_TMO])) break; if (_sp > XB_SPIN_CAP) { atomicAdd(&(bar)[XB_TMO], 1u); break; } } } } while (0)
struct XcdBarrier { unsigned* bar; unsigned x; volatile LAS unsigned* st; };
__device__ __forceinline__ XcdBarrier xcd_barrier_post(unsigned* bar, volatile LAS unsigned* st) {
    XcdBarrier b; b.bar = bar; b.x = xb_xcc_id(); b.st = st;
    if (threadIdx.x == 0) (void)xb_add(&bar[XB_XCNT(b.x)], 1u);
    return b;
}
__device__ __forceinline__ void xcd_barrier_complete(unsigned* bar, unsigned x, unsigned& nloc, unsigned& nx) {
    const unsigned G = gridDim.x * gridDim.y * gridDim.z;
    unsigned sum, cnt, mine, sp = 0u;
    for (;;) {
        sum = 0u; cnt = 0u; mine = 0u;
#pragma unroll
        for (unsigned j = 0; j < 16; ++j) { const unsigned c = xb_ld(&bar[XB_XCNT(j)]); sum += c; cnt += (c > 0u) ? 1u : 0u; mine = (j == x) ? c : mine; }
        if (sum == G) break;
        __builtin_amdgcn_s_sleep(1);
        if ((++sp & 255u) == 0u) { if (xb_ld(&bar[XB_TMO])) break; if (sp > XB_SPIN_CAP) { atomicAdd(&bar[XB_TMO], 1u); break; } }
    }
    nloc = mine > 0u ? mine : 1u; nx = cnt > 0u ? cnt : 1u;
}
__device__ __forceinline__ void xcd_barrier(const XcdBarrier& b) {
    asm volatile("s_waitcnt vmcnt(0)" ::: "memory");
    __syncthreads();
    if (threadIdx.x == 0) {
        unsigned* bar = b.bar;
        __builtin_amdgcn_s_waitcnt(0);
        unsigned nloc = b.st[0], nx = b.st[1];
        if (nloc == 0u) { xcd_barrier_complete(bar, b.x, nloc, nx); b.st[0] = nloc; b.st[1] = nx; }
        const unsigned old = xb_add(&bar[XB_XSUB(b.x)], 1u);
        const unsigned gen = old / nloc;
        if (old + 1u == (gen + 1u) * nloc) {
            __builtin_amdgcn_fence(__ATOMIC_RELEASE, "agent");
            asm volatile("s_waitcnt vmcnt(0)" ::: "memory");
            const unsigned og = xb_add(&bar[XB_TOP], 1u);
            const unsigned tg = og / nx;
            if (og + 1u == (tg + 1u) * nx) xb_add(&bar[XB_TOPGEN], 1u);
            else XB_SPIN(xb_ld(&bar[XB_TOPGEN]) == tg, bar);
            __builtin_amdgcn_fence(__ATOMIC_ACQUIRE, "agent");
            xb_add(&bar[XB_XGEN(b.x)], 1u);
            asm volatile("s_waitcnt vmcnt(0)" ::: "memory");
        } else {
            XB_SPIN(xb_ld(&bar[XB_XGEN(b.x)]) == gen, bar);
            __builtin_amdgcn_fence(__ATOMIC_ACQUIRE, "agent");
            asm volatile("s_waitcnt vmcnt(0)" ::: "memory");
        }
    }
    __syncthreads();
}

constexpr int LDS_BYTES = 147456;
constexpr int NPHASE = 25;
constexpr int PROBE_LO = -1, PROBE_HI = -1, PROBE_SUB = 7;
__global__ void __launch_bounds__(512, 2) mega(Args a) {
    extern __shared__ __attribute__((aligned(16))) unsigned char lds[];
    cg::grid_group grid = cg::this_grid();
    const int NGW = lidx((int)gridDim.x) * 8;
#define tid (ltid())
#define lane (ltid() & 63)
#define gw ((int)(lidx((int)blockIdx.x) * 8 + (ltid() >> 6)))
unsigned char* const wsraw_ = (unsigned char*)a.ws;
#define ws (lptr(a.ws))
    LAS unsigned char* ldsl = (LAS unsigned char*)lds;
    const int lo = a.ph_lo, hi = a.ph_hi;
#define IN(p) ((p) >= lo && (p) < hi)
    volatile LAS unsigned* xst = (volatile LAS unsigned*)(ldsl + LDS_BYTES - 64);
    if (threadIdx.x < 2) xst[threadIdx.x] = 0u;
    __syncthreads();
    const XcdBarrier xbar = xcd_barrier_post((unsigned*)(wsraw_ + O_BARW) + a.bar_region * 4096, xst);
#define SEAM(p) do { if ((p) + 1 < hi) { if ((p) == 0) grid.sync(); else xcd_barrier(xbar); } } while (0)
    if (IN(0)) { phase0(a, ws, (float*)lds, tid); SEAM(0); }
    const int G = lidx((int)gridDim.x), cb = lidx((int)blockIdx.x);
    float* outl = (float*)a.out; float* outc = (float*)(ws + O_CTXX);
#pragma unroll 1
    for (int l = 0; l < 2; ++l) {
        const int P = 1 + 12 * l;
        const bool wctx = (l == 0);
        const int Mlate = wctx ? MROWS : NLAT;
        const float* xl = l == 0 ? gin(a.in[lidx(I_X)]) : outl; const float* xc = l == 0 ? gin(a.in[lidx(I_CTX)]) : outc;
        const float* modl = (const float*)(ws + O_MOD) + (size_t)l * 5 * 12288;
        const bf16_t* HX = (const bf16_t*)(ws + O_HX); const bf16_t* Z1 = (const bf16_t*)(ws + O_Z1);
        if (IN(P + 0)) { phaseA(a, ws, lds, l, xl, xc, tid, (l == 0 || G <= 64) ? 0 : 2, 0, G); SEAM(P + 0); }
        if (IN(P + 1)) {
            { pg8::Gemm g{HX, (const bf16_t*)(ws + O_WZ1), DM, DM, DM, 0, 0}; pg8::Order<1> S; S.init(MROWS, NZ1, G, cb);
              pg8::Epi<FZ1> E{{(bf16_t*)(ws + O_Z1), (float*)(ws + O_MISC), (const float*)(ws + O_BIAS)}};
#ifndef NO_G0
            pg8::gemm_phase(ldsl, g, S, E);
#endif
 }
            { pg8::Gemm g{(const bf16_t*)(ws + O_WKV), HX, DM, DM, DM, 0, 0}; pg8::Order<1> S; S.init(1536, MROWS, G, cb);
              pg8::Epi<FRowBias> E{{(bf16_t*)(ws + O_KVT), MROWS, (const float*)(ws + O_BIAS) + 4352}};
#ifndef NO_G1
            pg8::gemm_phase(ldsl, g, S, E);
#endif
 }
            SEAM(P + 1);
        }
        if (IN(P + 2)) { if (a.sub & 1) mla_norm(a, ws, l, gw, NGW, lane); if (a.sub & 2) s5_pass1(ws, lds, tid); if (a.sub & 4) ml_state_pass(a, ws, (float*)lds, l, tid); SEAM(P + 2); }
        if (IN(P + 3)) {
            { pg8::Gemm g{Z1 + ZQA, (const bf16_t*)(ws + O_WUQ), LDZ, 512, 512, 0, 0}; pg8::Order<1> S; S.init(MROWS, 1536, G, cb);
              pg8::Epi<FPlain> E{{(bf16_t*)(ws + O_Q), 1536}};
#ifndef NO_G2
            pg8::gemm_phase(ldsl, g, S, E);
#endif
 }
            { pg8::Gemm g{Z1 + ZKVA, (const bf16_t*)(ws + O_WUKVK), LDZ, 512, 512, 0, 0}; pg8::Order<1> S; S.init(MROWS, 1024, G, cb);
              pg8::Epi<FKn> E{{(bf16_t*)(ws + O_K)}};
#ifndef NO_G3
            pg8::gemm_phase(ldsl, g, S, E);
#endif
 }
            { pg8::Gemm g{(const bf16_t*)(ws + O_WUKVV), Z1 + ZKVA, 512, LDZ, 512, 0, 0}; pg8::Order<1> S; S.init(1024, MROWS, G, cb);
              pg8::Epi<FRowBias> E{{(bf16_t*)(ws + O_VTA), MROWS, nullptr}};
#ifndef NO_G4
            pg8::gemm_phase(ldsl, g, S, E);
#endif
 }
            s5_scan(ws, l, tid);
            SEAM(P + 3);
        }
        if (IN(P + 4)) { if (a.sub & 1) qk_prep(a, ws, l, gw, NGW, lane); if (a.sub & 2) s5_pass2(ws, lds, tid); if (a.sub & 4) ml_out_pass(a, ws, lds, l, wctx, tid); SEAM(P + 4); }
        if (IN(P + 5)) {
            attn_phase(ws, lds, wctx, tid);
            { pg8::Gemm g{(const bf16_t*)(ws + O_GS), (const bf16_t*)(ws + O_WGLU), 1024, 1024, 1024, 0, 0}; pg8::Order<1> S; S.init(Mlate, 1024, G, cb);
              pg8::Epi<FGlu> E{{(bf16_t*)(ws + O_BR + 2 * BRSZ), (const bf16_t*)(ws + O_GS), gin(a.in[lidx(I_BGLU)]) + l * 1024}};
#ifndef NO_G5
            pg8::gemm_phase(ldsl, g, S, E);
#endif
 }
            SEAM(P + 5);
        }
        if (IN(P + 6)) {
            pg8::Gemm g{HX, (const bf16_t*)(ws + O_WG), DM, DM, DM, 0, 0}; pg8::Order<1> S; S.init(Mlate, 6144, G, cb);
            pg8::Epi<FGate> E{{(bf16_t*)(ws + O_GATES), (const float*)(ws + O_BIAS) + 4352 + 1536}};
#ifndef NO_G6
            pg8::gemm_phase(ldsl, g, S, E);
#endif

            SEAM(P + 6);
        }
        if (IN(P + 7)) {
            pg8::Gemm g{(const bf16_t*)(ws + O_BR), (const bf16_t*)(ws + O_WBR), 1024, 1024, 1024, (size_t)MROWS * 1024, (size_t)2048 * 1024}; pg8::Order<3> S; S.init(Mlate, DM, G, cb);
            pg8::Epi<FMerge> E{{(bf16_t*)(ws + O_HX), (const bf16_t*)(ws + O_GATES)}};
#ifndef NO_G7
            pg8::gemm_phase(ldsl, g, S, E);
#endif

            SEAM(P + 7);
        }
        if (IN(P + 8)) {
            pg8::Gemm g{HX, (const bf16_t*)(ws + O_WOUT), DM, DM, DM, 0, 0}; pg8::Order<1> S; S.init(Mlate, DM, G, cb);
            pg8::Epi<FResid> E{{xl, xc, outl, outc, modl, 2}};
#ifndef NO_G8
            pg8::gemm_phase(ldsl, g, S, E);
#endif

            SEAM(P + 8);
        }
        if (IN(P + 9)) { norm_mod_rows(outl, outc, gin(a.in[lidx(I_NORMG)]) + (size_t)(l * 2 + 1) * DM, modl, 3, (bf16_t*)(ws + O_HX), Mlate, gw, NGW, lane); SEAM(P + 9); }
        if (IN(P + 10)) {
            pg8::Gemm g{HX, (const bf16_t*)(ws + O_W1), DM, DM, DM, 0, 0}; pg8::Order<1> S; S.init(Mlate, DFF, G, cb);
            pg8::Epi<FFF1> E{{(bf16_t*)(ws + O_HID)}};
#ifndef NO_G9
            pg8::gemm_phase(ldsl, g, S, E);
#endif

            SEAM(P + 10);
        }
        if (IN(P + 11)) {
            pg8::Gemm g{(const bf16_t*)(ws + O_HID), (const bf16_t*)(ws + (l == 0 ? O_W2 : O_W2B)), DFF, DFF, DFF, 0, 0}; pg8::Order<1> S; S.init(Mlate, DM, G, cb);
            pg8::Epi<FResid> E{{outl, outc, outl, outc, modl, 5}};
#ifndef NO_G10
            pg8::gemm_phase(ldsl, g, S, E);
#endif
            if (wctx && cb >= 32 && G > 64) phaseA(a, ws, lds, 1, nullptr, nullptr, tid, 1, 32, G - 32);

            SEAM(P + 11);
        }
    }
#undef IN
#undef SEAM
#undef tid
#undef lane
#undef gw
#undef ws
}

extern "C" void kernel_launch(void* const* d_in, const int* in_sizes, int n_in, void* d_out, int out_size, void* d_ws, size_t ws_size, hipStream_t stream) {
    static int grid = 0;
    if (grid == 0) {
        int dev = 0, cus = 0, per_cu = 0;
        (void)hipGetDevice(&dev);
        (void)hipDeviceGetAttribute(&cus, hipDeviceAttributeMultiprocessorCount, dev);
        (void)hipFuncSetAttribute((const void*)mega, hipFuncAttributeMaxDynamicSharedMemorySize, LDS_BYTES);
        (void)hipOccupancyMaxActiveBlocksPerMultiprocessor(&per_cu, (const void*)mega, 512, LDS_BYTES);
        if (per_cu < 1) per_cu = 1;
        grid = cus * per_cu;
        if (ws_size < O_END2) fprintf(stderr, "kernel_launch: workspace too small: %zu < %zu\n", ws_size, (size_t)O_END2);
    }
    (void)hipMemsetAsync((unsigned char*)d_ws + O_BARW, 0, 2 * 16384, stream);
    Args a{};
    for (int i = 0; i < 31 && i < n_in; ++i) a.in[i] = (GAS const float*)d_in[i];
    a.out = (GAS float*)d_out; a.ws = (GAS unsigned char*)d_ws; a.ph_lo = 0; a.ph_hi = NPHASE; a.sub = 7;
    void* args[] = {&a};
    hipError_t e = hipLaunchCooperativeKernel((const void*)mega, dim3(grid), dim3(512), args, LDS_BYTES, stream);
    if (e != hipSuccess) fprintf(stderr, "cooperative launch failed: %s (grid %d)\n", hipGetErrorString(e), grid);
    if (PROBE_LO >= 0) { Args b2 = a; b2.ph_lo = PROBE_LO; b2.ph_hi = PROBE_HI; b2.sub = PROBE_SUB; b2.bar_region = 1; void* args2[] = {&b2};
        (void)hipLaunchCooperativeKernel((const void*)mega, dim3(grid), dim3(512), args2, LDS_BYTES, stream); }
}
```

```cpp
#include <hip/hip_runtime.h>
#include <hip/hip_cooperative_groups.h>
#include <cstdio>
#include <cstdint>
namespace cg = cooperative_groups;

typedef unsigned short bf16_t;
typedef short bf16x8 __attribute__((ext_vector_type(8)));
typedef float f32x4 __attribute__((ext_vector_type(4)));
typedef float f32x2 __attribute__((ext_vector_type(2)));
typedef unsigned u32x4 __attribute__((ext_vector_type(4)));
typedef unsigned u32x2 __attribute__((ext_vector_type(2)));
#define LAS __attribute__((address_space(3)))
#define GAS __attribute__((address_space(1)))

constexpr int DM = 2048, NB = 4, SEQ = 4096, CTXL = 256, NLAT = NB * SEQ, NCTX = NB * CTXL, MROWS = NLAT + NCTX;
constexpr int DIN = 11344, DFF = 8192;
constexpr int NZ1 = 4352;
constexpr int LDZ = 4096;
constexpr int ZQ = 0, ZK = 512, ZO = 1024, ZQA = 2048, ZKVA = 2560, ZU = 3072;
constexpr int NMISC = 80;
constexpr int MLCH = 128, MLNC = 34;
constexpr int S5NCH = 68, S5COLS = NB * S5NCH;
constexpr float EPS = 1e-6f;

constexpr size_t al256(size_t x) { return (x + 255) & ~(size_t)255; }
constexpr size_t O_WZ1 = 0;
constexpr size_t O_WKV = O_WZ1 + (size_t)NZ1 * DM * 2;
constexpr size_t O_WG = O_WKV + (size_t)1536 * DM * 2;
constexpr size_t O_WUQ = O_WG + (size_t)6144 * DM * 2;
constexpr size_t O_WUKVK = O_WUQ + (size_t)1536 * 512 * 2;
constexpr size_t O_WUKVV = O_WUKVK + (size_t)1024 * 512 * 2;
constexpr size_t O_WGLU = O_WUKVV + (size_t)1024 * 512 * 2;
constexpr size_t O_WBR = O_WGLU + (size_t)1024 * 1024 * 2;
constexpr size_t O_WOUT = O_WBR + (size_t)3 * 2048 * 1024 * 2;
constexpr size_t O_W1 = O_WOUT + (size_t)2048 * 2048 * 2;
constexpr size_t O_W2 = O_W1 + (size_t)8192 * 2048 * 2;
constexpr size_t O_BIAS = O_W2 + (size_t)8192 * 2048 * 2;
constexpr size_t O_T1 = al256(O_BIAS + (size_t)(4352 + 1536 + 6144) * 4);
constexpr size_t O_T2 = O_T1 + (size_t)64 * 256 * 1024 * 2;
constexpr size_t O_KC = O_T2 + (size_t)64 * 1024 * 256 * 2;
constexpr size_t O_LAMP = O_KC + (size_t)64 * 128 * 256 * 2;
constexpr size_t O_BBAR = O_LAMP + (size_t)2 * 64 * 2 * 65 * 64 * 8;
constexpr size_t O_MOD = O_BBAR + (size_t)2 * 64 * 2 * 64 * 16 * 8;
constexpr size_t O_CTXX = al256(O_MOD + (size_t)2 * 5 * 12288 * 4);
constexpr size_t O_MLG = O_CTXX + (size_t)NCTX * DM * 4;
constexpr size_t O_MLN = O_MLG + (size_t)3 * 8 * MROWS * 4;
constexpr size_t O_MLM = O_MLN + (size_t)32 * MLNC * 128 * 4;
constexpr size_t O_HX = al256(O_MLM + (size_t)32 * MLNC * 4);
constexpr size_t O_BR = O_HX + (size_t)MROWS * DM * 2;
constexpr size_t BRSZ = (size_t)MROWS * 1024 * 2;
constexpr size_t O_R1 = O_BR + 3 * BRSZ;
constexpr size_t O_Z1 = O_R1;
constexpr size_t O_MISC = O_Z1 + (size_t)MROWS * LDZ * 2;
constexpr size_t O_KVT = O_MISC + (size_t)MROWS * NMISC * 4;
constexpr size_t O_Q = O_KVT + (size_t)1536 * MROWS * 2;
constexpr size_t O_K = O_Q + (size_t)MROWS * 1536 * 2;
constexpr size_t O_VTA = O_K + (size_t)MROWS * 1536 * 2;
constexpr size_t O_E = O_VTA + (size_t)1024 * MROWS * 2;
constexpr size_t O_X = O_E + (size_t)64 * S5COLS * 256 * 4;
constexpr size_t O_GS = O_X + (size_t)64 * S5COLS * 256 * 2;
constexpr size_t O_END = O_GS + (size_t)MROWS * 1024 * 2;
constexpr size_t O_W2B = O_END;
constexpr size_t O_ROPE = O_W2B + (size_t)8192 * 2048 * 2;
constexpr size_t O_BARW = O_ROPE + 64 * 16 * 8;
constexpr size_t O_END2 = O_BARW + 2 * 16384;
constexpr size_t O_GATES = O_R1;
constexpr size_t O_HID = O_R1;
static_assert(O_GATES + (size_t)MROWS * 6144 * 2 <= O_GS, "gates alias");
static_assert(O_HID + (size_t)MROWS * 8192 * 2 <= O_END, "hidden alias");

__device__ __forceinline__ float bf2f(unsigned u) { return __uint_as_float(u << 16); }
__device__ __forceinline__ unsigned cvt_pk(float lo, float hi) { unsigned r; asm volatile("v_cvt_pk_bf16_f32 %0, %1, %2" : "=v"(r) : "v"(lo), "v"(hi)); return r; }
__device__ __forceinline__ float wave_sum(float v) {
#pragma unroll
    for (int o = 1; o < 64; o <<= 1) v += __shfl_xor(v, o);
    return v;
}
__device__ __forceinline__ float sigmoidf_(float x) { return 1.f / (1.f + __expf(-x)); }
__device__ __forceinline__ f32x4 mfma16(bf16x8 a, bf16x8 b, f32x4 c) { return __builtin_amdgcn_mfma_f32_16x16x32_bf16(a, b, c, 0, 0, 0); }
__device__ __forceinline__ bf16x8 ldg8(const bf16_t* p) { return *(const bf16x8*)p; }
__device__ __forceinline__ void unpack8(bf16x8 v, float* f) {
    const u32x4 w = __builtin_bit_cast(u32x4, v);
    f[0] = __uint_as_float(w.x << 16); f[1] = __uint_as_float(w.x & 0xffff0000u); f[2] = __uint_as_float(w.y << 16); f[3] = __uint_as_float(w.y & 0xffff0000u);
    f[4] = __uint_as_float(w.z << 16); f[5] = __uint_as_float(w.z & 0xffff0000u); f[6] = __uint_as_float(w.w << 16); f[7] = __uint_as_float(w.w & 0xffff0000u);
}
__device__ __forceinline__ bf16x8 pack8(const float* f) { u32x4 w; w.x = cvt_pk(f[0], f[1]); w.y = cvt_pk(f[2], f[3]); w.z = cvt_pk(f[4], f[5]); w.w = cvt_pk(f[6], f[7]); return __builtin_bit_cast(bf16x8, w); }

__device__ __forceinline__ int ltid() { int t = threadIdx.x; asm volatile("" : "+v"(t)); return t; }
__device__ __forceinline__ int lidx(int i) { asm volatile("" : "+s"(i)); return i; }
template <class T> __device__ __forceinline__ T* lptr(GAS T* p) { asm volatile("" : "+s"(p)); return (T*)p; }
__device__ __forceinline__ const float* gin(GAS const float* p) { return (const float*)p; }
__device__ __forceinline__ int vbid() { const int G = lidx((int)gridDim.x), b = lidx((int)blockIdx.x); return (G % 8 == 0) ? (b % 8) * (G / 8) + b / 8 : b; }
namespace pg8 {
constexpr int BM = 256, BK = 64, HALF = 128, HTB = HALF * BK * 2, STAGE_BYTES = 8 * HTB, NXCD = 8, WGM = 8;
__host__ __device__ __forceinline__ int lds_byte(int r, int c) { const int st = (r >> 4) * 2 + (c >> 5), rr = r & 15, cc = c & 31, ob = rr * 64 + cc * 2; return st * 1024 + (ob ^ (((ob >> 9) & 1) << 5)); }
__host__ __device__ __forceinline__ void stage_rc(int b, int& R, int& C) { const int st = b / 1024, sb = b % 1024, swz = sb ^ (((sb >> 9) & 1) << 5); R = (st >> 1) * 16 + swz / 64; C = (st & 1) * 32 + (swz % 64) / 2; }
__host__ __device__ __forceinline__ int perm32(int rho) { const int n = rho >> 4, i = rho & 15; return 8 * (i >> 2) + 4 * n + (i & 3); }
struct Unit { int pm, pn, r; };
struct Gemm { const bf16_t* A; const bf16_t* Bt; int lda, ldb, K; size_t rsA, rsB; };
template <int NR> struct Order {
    int nM, nN, nwg, G, c;
    __device__ void init(int M, int N, int G_, int c_) { nM = M / BM; nN = N / BM; nwg = nM * nN; G = G_; c = c_; }
    __device__ bool next(int i, Unit& u) const {
        const int ti = i / NR; u.r = i - ti * NR;
        const long L = (long)ti * G + c; if (L >= nwg) return false;
        int wgid = (int)L; { const int q = nwg / NXCD, r = nwg % NXCD, xcd = wgid % NXCD, off = wgid / NXCD; wgid = (xcd < r ? xcd * (q + 1) : r * (q + 1) + (xcd - r) * q) + off; }
        const int nig = WGM * nN, gid = wgid / nig, fm = gid * WGM, gsz = (nM - fm) < WGM ? (nM - fm) : WGM;
        u.pm = fm + ((wgid % nig) % gsz); u.pn = (wgid % nig) / gsz; return true;
    }
};
template <class F> struct Epi {
    F f;
    __device__ __forceinline__ void operator()(const f32x4 (&acc)[2][2][4][2], const Unit& u, int wr, int wc, int fr, int fq) const {
        typename F::Pre pre[2];
        const int row0 = u.pm * BM + wr * 64 + fr, col0 = u.pn * BM + wc * 32 + 8 * fq;
#pragma unroll
        for (int bj = 0; bj < 2; ++bj) f.pre(u.r, row0, col0 + bj * HALF, pre[bj]);
#pragma unroll
        for (int ai = 0; ai < 2; ++ai)
#pragma unroll
            for (int m2 = 0; m2 < 4; m2 += 2) {
                typename F::Aux ax[2][2];
#pragma unroll
                for (int mm = 0; mm < 2; ++mm)
#pragma unroll
                    for (int bj = 0; bj < 2; ++bj) f.ld(u.r, row0 + ai * HALF + (m2 + mm) * 16, col0 + bj * HALF, ax[mm][bj]);
                __builtin_amdgcn_sched_barrier(0);
#pragma unroll
                for (int mm = 0; mm < 2; ++mm)
#pragma unroll
                    for (int bj = 0; bj < 2; ++bj) f.st(u.r, row0 + ai * HALF + (m2 + mm) * 16, col0 + bj * HALF, acc[ai][bj][m2 + mm][0], acc[ai][bj][m2 + mm][1], pre[bj], ax[mm][bj]);
                __builtin_amdgcn_sched_barrier(0);
            }
    }
};

template <class EpiT, class Sched>
__device__ __forceinline__ void gemm_phase(LAS unsigned char* lds, const Gemm g, const Sched& S, const EpiT& E) {
    const int tid = ltid(), wid = __builtin_amdgcn_readfirstlane(tid >> 6), lane = tid & 63, wr = wid >> 2, wc = wid & 3, fr = lane & 15, fq = lane >> 4;
    const int K = g.K, nt = K / BK;
    unsigned voffA[2], voffB[2];
#pragma unroll
    for (int i = 0; i < 2; ++i) { int R, C; stage_rc(tid * 16 + i * 8192, R, C); const int Rb = (R & ~31) + perm32(R & 31);
        voffA[i] = (unsigned)(R * g.lda + C) * 2u; voffB[i] = (unsigned)(Rb * g.ldb + C) * 2u; }
    const size_t kstep = (size_t)(BK * 2);
    const size_t hstepA = (size_t)HALF * g.lda * 2, hstepB = (size_t)HALF * g.ldb * 2;
    const size_t tstepA = 2 * hstepA, tstepB = 2 * hstepB;
    const unsigned ldsw = (unsigned)wid * 1024u;
    const int aoff = lds_byte(wr * 64 + fr, fq * 8), boff = lds_byte(wc * 32 + fr, fq * 8);
#define PG8_SA(b, h) (((b) * 2 + (h)) * HTB)
#define PG8_SB(b, h) ((4 + (b) * 2 + (h)) * HTB)
#define PG8_STAGE(bufoff, gbase, voff) do { _Pragma("unroll") for (int _i = 0; _i < 2; ++_i) \
        __builtin_amdgcn_global_load_lds((const unsigned*)((const char*)(gbase) + (voff)[_i]), (LAS unsigned*)(lds + (bufoff) + ldsw + _i * 8192), 16, 0, 0); } while (0)
#define PG8_LDA(dst, b, h) do { _Pragma("unroll") for (int m = 0; m < 4; ++m) _Pragma("unroll") for (int k = 0; k < 2; ++k) dst[m][k] = *(const LAS bf16x8*)(lds + PG8_SA(b, h) + aoff + m * 2048 + k * 1024); } while (0)
#define PG8_LDB(dst, b, h) do { _Pragma("unroll") for (int n = 0; n < 2; ++n) _Pragma("unroll") for (int k = 0; k < 2; ++k) dst[n][k] = *(const LAS bf16x8*)(lds + PG8_SB(b, h) + boff + n * 2048 + k * 1024); } while (0)
#define PG8_MMA(ai, bj, At, Bt) do { __builtin_amdgcn_s_setprio(1); _Pragma("unroll") for (int m = 0; m < 4; ++m) _Pragma("unroll") for (int n = 0; n < 2; ++n) _Pragma("unroll") for (int k = 0; k < 2; ++k) \
        acc[ai][bj][m][n] = __builtin_amdgcn_mfma_f32_16x16x32_bf16(Bt[n][k], At[m][k], acc[ai][bj][m][n], 0, 0, 0); __builtin_amdgcn_s_setprio(0); } while (0)
#define PG8_WAIT_V(n) asm volatile("s_waitcnt vmcnt(" #n ")" ::: "memory")
#define PG8_WAIT_L(n) asm volatile("s_waitcnt lgkmcnt(" #n ")" ::: "memory")
#define PG8_BAR __builtin_amdgcn_s_barrier()
#define PG8_SCHED __builtin_amdgcn_sched_barrier(0)
    Unit cur, nxt; int ui = 0;
    if (!S.next(0, cur)) return;
    f32x4 acc[2][2][4][2];
#pragma unroll
    for (int a = 0; a < 2; ++a)
#pragma unroll
        for (int b = 0; b < 2; ++b)
#pragma unroll
            for (int m = 0; m < 4; ++m)
#pragma unroll
                for (int n = 0; n < 2; ++n) acc[a][b][m][n] = (f32x4){0.f, 0.f, 0.f, 0.f};
    bf16x8 At[4][2], B0[2][2], B1[2][2];
    const char* cA = (const char*)g.A + (size_t)cur.pm * tstepA + (size_t)cur.r * g.rsA * 2; const char* cB = (const char*)g.Bt + (size_t)cur.pn * tstepB + (size_t)cur.r * g.rsB * 2;
    PG8_STAGE(PG8_SB(0, 0), cB, voffB); PG8_STAGE(PG8_SB(0, 1), cB + hstepB, voffB); PG8_STAGE(PG8_SA(0, 0), cA, voffA); PG8_STAGE(PG8_SA(0, 1), cA + hstepA, voffA);
    if (wr == 1) PG8_BAR;
    PG8_WAIT_V(2); PG8_BAR;
    PG8_STAGE(PG8_SB(1, 0), cB + kstep, voffB); PG8_STAGE(PG8_SA(1, 0), cA + kstep, voffA); PG8_STAGE(PG8_SB(1, 1), cB + hstepB + kstep, voffB);
    PG8_WAIT_V(6); PG8_BAR;
    for (;;) {
        const bool has_next = S.next(ui + 1, nxt);
        const char* nA = has_next ? (const char*)g.A + (size_t)nxt.pm * tstepA + (size_t)nxt.r * g.rsA * 2 : cA; const char* nB = has_next ? (const char*)g.Bt + (size_t)nxt.pn * tstepB + (size_t)nxt.r * g.rsB * 2 : cB;
        for (int t = 0; t < nt; t += 2) {
            const bool last = (t == nt - 2);
            const char* a1 = cA + (size_t)(t + 1) * kstep;
            const char* a2 = last ? nA : cA + (size_t)(t + 2) * kstep; const char* b2 = last ? nB : cB + (size_t)(t + 2) * kstep;
            const char* a3 = a2 + kstep; const char* b3 = b2 + kstep;
            PG8_LDB(B0, 0, 0); PG8_LDB(B1, 0, 1); PG8_SCHED; PG8_LDA(At, 0, 0); PG8_STAGE(PG8_SA(1, 1), a1 + hstepA, voffA);
            PG8_WAIT_V(8); PG8_WAIT_L(0); PG8_BAR; PG8_MMA(0, 0, At, B0); PG8_MMA(0, 1, At, B1); PG8_BAR; PG8_SCHED;
            PG8_LDA(At, 0, 1); PG8_STAGE(PG8_SB(0, 0), b2, voffB); PG8_STAGE(PG8_SB(0, 1), b2 + hstepB, voffB); PG8_STAGE(PG8_SA(0, 0), a2, voffA);
            PG8_WAIT_V(8); PG8_WAIT_L(0); PG8_BAR; PG8_MMA(1, 0, At, B0); PG8_MMA(1, 1, At, B1); PG8_BAR; PG8_SCHED;
            PG8_LDB(B0, 1, 0); PG8_LDB(B1, 1, 1); PG8_SCHED; PG8_LDA(At, 1, 0); PG8_STAGE(PG8_SA(0, 1), a2 + hstepA, voffA);
            PG8_WAIT_V(8); PG8_WAIT_L(0); PG8_BAR; PG8_MMA(0, 0, At, B0); PG8_MMA(0, 1, At, B1); PG8_BAR; PG8_SCHED;
            PG8_LDA(At, 1, 1); PG8_STAGE(PG8_SB(1, 0), b3, voffB); PG8_STAGE(PG8_SB(1, 1), b3 + hstepB, voffB); PG8_STAGE(PG8_SA(1, 0), a3, voffA);
            PG8_WAIT_V(8); PG8_WAIT_L(0); PG8_BAR; PG8_MMA(1, 0, At, B0); PG8_MMA(1, 1, At, B1); PG8_BAR; PG8_SCHED;
        }
        if (wr == 0) PG8_BAR;
        E(acc, cur, wr, wc, fr, fq);
        if (!has_next) break;
#pragma unroll
        for (int a = 0; a < 2; ++a)
#pragma unroll
            for (int b = 0; b < 2; ++b)
#pragma unroll
                for (int m = 0; m < 4; ++m)
#pragma unroll
                    for (int n = 0; n < 2; ++n) acc[a][b][m][n] = (f32x4){0.f, 0.f, 0.f, 0.f};
        cur = nxt; cA = nA; cB = nB; ++ui;
        if (wr == 1) PG8_BAR;
    }
    PG8_WAIT_V(0);
    PG8_BAR;
#undef PG8_SA
#undef PG8_SB
#undef PG8_STAGE
#undef PG8_LDA
#undef PG8_LDB
#undef PG8_MMA
#undef PG8_WAIT_V
#undef PG8_WAIT_L
#undef PG8_BAR
#undef PG8_SCHED
}
}
__device__ __forceinline__ void st_bf16x8(bf16_t* p, f32x4 v0, f32x4 v1) { u32x4 w; w.x = cvt_pk(v0[0], v0[1]); w.y = cvt_pk(v0[2], v0[3]); w.z = cvt_pk(v1[0], v1[1]); w.w = cvt_pk(v1[2], v1[3]); *(u32x4*)p = w; }
struct NoAux {};
struct ColBias { f32x4 b0, b1; };
struct FZ1 { bf16_t* z1; float* misc; const float* b1; typedef ColBias Pre; typedef NoAux Aux;
    __device__ __forceinline__ void pre(int, int, int col, Pre& p) const { p.b0 = *(const f32x4*)(b1 + col); p.b1 = *(const f32x4*)(b1 + col + 4); }
    __device__ __forceinline__ void ld(int, int, int, Aux&) const {}
    __device__ __forceinline__ void st(int, int row, int col, f32x4 v0, f32x4 v1, const Pre& p, const Aux&) const {
        v0 += p.b0; v1 += p.b1;
        if (col < LDZ) st_bf16x8(z1 + (size_t)row * LDZ + col, v0, v1);
        else { const int c = col - LDZ; if (c < NMISC) { float* q = misc + (size_t)row * NMISC + c; *(f32x4*)q = v0; *(f32x4*)(q + 4) = v1; } }
    } };
struct RowB { float b; };
struct FRowBias { bf16_t* o; int ld_; const float* bias; typedef NoAux Pre; typedef RowB Aux;
    __device__ __forceinline__ void pre(int, int, int, Pre&) const {}
    __device__ __forceinline__ void ld(int, int row, int, Aux& x) const { x.b = bias ? bias[row] : 0.f; }
    __device__ __forceinline__ void st(int, int row, int col, f32x4 v0, f32x4 v1, const Pre&, const Aux& x) const { v0 += x.b; v1 += x.b; st_bf16x8(o + (size_t)row * ld_ + col, v0, v1); } };
struct FGate { bf16_t* o; const float* bg; typedef ColBias Pre; typedef NoAux Aux;
    __device__ __forceinline__ void pre(int, int, int col, Pre& p) const { p.b0 = *(const f32x4*)(bg + col); p.b1 = *(const f32x4*)(bg + col + 4); }
    __device__ __forceinline__ void ld(int, int, int, Aux&) const {}
    __device__ __forceinline__ void st(int, int row, int col, f32x4 v0, f32x4 v1, const Pre& p, const Aux&) const {
        v0 += p.b0; v1 += p.b1;
#pragma unroll
        for (int i = 0; i < 4; ++i) { v0[i] = sigmoidf_(v0[i]); v1[i] = sigmoidf_(v1[i]); }
        st_bf16x8(o + (size_t)row * 6144 + col, v0, v1);
    } };
struct FPlain { bf16_t* o; int ld_; typedef NoAux Pre; typedef NoAux Aux;
    __device__ __forceinline__ void pre(int, int, int, Pre&) const {}
    __device__ __forceinline__ void ld(int, int, int, Aux&) const {}
    __device__ __forceinline__ void st(int, int row, int col, f32x4 v0, f32x4 v1, const Pre&, const Aux&) const { st_bf16x8(o + (size_t)row * ld_ + col, v0, v1); } };
struct FKn { bf16_t* o; typedef NoAux Pre; typedef NoAux Aux;
    __device__ __forceinline__ void pre(int, int, int, Pre&) const {}
    __device__ __forceinline__ void ld(int, int, int, Aux&) const {}
    __device__ __forceinline__ void st(int, int row, int col, f32x4 v0, f32x4 v1, const Pre&, const Aux&) const { const int h = col >> 7, d = col & 127; st_bf16x8(o + (size_t)row * 1536 + h * 192 + d, v0, v1); } };
struct Vec8 { bf16x8 v; };
struct FGlu { bf16_t* o; const bf16_t* g; const float* bias; typedef ColBias Pre; typedef Vec8 Aux;
    __device__ __forceinline__ void pre(int, int, int col, Pre& p) const { p.b0 = *(const f32x4*)(bias + col); p.b1 = *(const f32x4*)(bias + col + 4); }
    __device__ __forceinline__ void ld(int, int row, int col, Aux& x) const { x.v = ldg8(g + (size_t)row * 1024 + col); }
    __device__ __forceinline__ void st(int, int row, int col, f32x4 v0, f32x4 v1, const Pre& p, const Aux& x) const {
        float gv[8]; unpack8(x.v, gv);
        v0 += p.b0; v1 += p.b1;
#pragma unroll
        for (int i = 0; i < 4; ++i) { v0[i] = gv[i] * sigmoidf_(v0[i]); v1[i] = gv[4 + i] * sigmoidf_(v1[i]); }
        st_bf16x8(o + (size_t)row * 1024 + col, v0, v1);
    } };
struct Vec8x2 { bf16x8 g, p; };
struct FMerge { bf16_t* o; const bf16_t* gates; typedef NoAux Pre; typedef Vec8x2 Aux;
    __device__ __forceinline__ void pre(int, int, int, Pre&) const {}
    __device__ __forceinline__ void ld(int r, int row, int col, Aux& x) const { x.g = ldg8(gates + (size_t)row * 6144 + r * 2048 + col); if (r > 0) x.p = ldg8(o + (size_t)row * DM + col); }
    __device__ __forceinline__ void st(int r, int row, int col, f32x4 v0, f32x4 v1, const Pre&, const Aux& x) const {
        float gv[8]; unpack8(x.g, gv);
#pragma unroll
        for (int i = 0; i < 4; ++i) { v0[i] *= gv[i]; v1[i] *= gv[4 + i]; }
        if (r > 0) { float pv[8]; unpack8(x.p, pv);
#pragma unroll
            for (int i = 0; i < 4; ++i) { v0[i] += pv[i]; v1[i] += pv[4 + i]; } }
        st_bf16x8(o + (size_t)row * DM + col, v0, v1);
    } };
struct X8 { f32x4 x0, x1; };
struct FResid { const float* xin_l; const float* xin_c; float* xout_l; float* xout_c; const float* modl; int gi; typedef ColBias Pre; typedef X8 Aux;
    __device__ __forceinline__ void pre(int, int row0, int col, Pre& p) const { const int mr = row0 < NLAT ? (row0 >> 12) : 4; const float* gp = modl + (size_t)mr * 12288 + gi * DM + col; p.b0 = *(const f32x4*)gp; p.b1 = *(const f32x4*)(gp + 4); }
    __device__ __forceinline__ void ld(int, int row, int col, Aux& x) const { const float* xi = row < NLAT ? xin_l + (size_t)row * DM : xin_c + (size_t)(row - NLAT) * DM; x.x0 = *(const f32x4*)(xi + col); x.x1 = *(const f32x4*)(xi + col + 4); }
    __device__ __forceinline__ void st(int, int row, int col, f32x4 v0, f32x4 v1, const Pre& p, const Aux& x) const {
        float* xo = row < NLAT ? xout_l + (size_t)row * DM : xout_c + (size_t)(row - NLAT) * DM;
        *(f32x4*)(xo + col) = x.x0 + p.b0 * v0; *(f32x4*)(xo + col + 4) = x.x1 + p.b1 * v1;
    } };
struct FFF1 { bf16_t* o; typedef NoAux Pre; typedef NoAux Aux;
    __device__ __forceinline__ void pre(int, int, int, Pre&) const {}
    __device__ __forceinline__ void ld(int, int, int, Aux&) const {}
    __device__ __forceinline__ void st(int, int row, int col, f32x4 v0, f32x4 v1, const Pre&, const Aux&) const {
#pragma unroll
        for (int i = 0; i < 4; ++i) { const float a = fmaxf(v0[i], 0.f), b = fmaxf(v1[i], 0.f); v0[i] = a * a; v1[i] = b * b; }
        st_bf16x8(o + (size_t)row * DFF + col, v0, v1);
    } };

struct Args { GAS const float* in[31]; GAS float* out; GAS unsigned char* ws; int ph_lo, ph_hi, sub, bar_region; };
enum { I_X = 0, I_C, I_CTX, I_CCTX, I_WMOD, I_BMOD, I_NORMG, I_WIN, I_BIN, I_MLGB, I_MLNG, I_QAG, I_KVAG, I_WUQ, I_WUKV, I_QNG, I_KNG,
       I_ARE, I_AIM, I_LOGDT, I_BRE, I_BIM, I_CRE, I_CIM, I_S5D, I_WGLU, I_BGLU, I_WBR, I_WOUT, I_FF1, I_FF2 };

__device__ __forceinline__ int seq_row(int b, int pos) { return pos < CTXL ? NLAT + b * CTXL + pos : b * SEQ + (pos - CTXL); }

__device__ __forceinline__ void tr_item(const float* W, int ld, int K, int nblk, bf16_t* WT, int mode, float* scr, int item, int lane) {
    const int kb = item / nblk, nb = item % nblk, k0 = 64 * kb, n0 = 32 * nb;
    float tv[32];
#pragma unroll
    for (int i = 0; i < 32; ++i) { const int kk = 2 * i + (lane >> 5); tv[i] = W[(size_t)(k0 + kk) * ld + n0 + (lane & 31)]; }
    __builtin_amdgcn_sched_barrier(0);
#pragma unroll
    for (int i = 0; i < 32; ++i) { const int kk = 2 * i + (lane >> 5); scr[kk * 33 + (lane & 31)] = tv[i]; }
    asm volatile("s_waitcnt lgkmcnt(0)" ::: "memory");
    const int c = lane & 7;
    int drow0 = n0;
    if (mode == 1) { const int h = n0 >> 8, w = n0 & 255; drow0 = (w < 128) ? (h * 128 + w) : (1024 + h * 128 + (w - 128)); }
#pragma unroll
    for (int j = 0; j < 4; ++j) { const int n = (lane >> 3) + 8 * j; const float* s = scr + (8 * c) * 33 + n;
        u32x4 o; o.x = cvt_pk(s[0 * 33], s[1 * 33]); o.y = cvt_pk(s[2 * 33], s[3 * 33]); o.z = cvt_pk(s[4 * 33], s[5 * 33]); o.w = cvt_pk(s[6 * 33], s[7 * 33]);
        *(u32x4*)(WT + (size_t)(drow0 + n) * K + k0 + 8 * c) = o; }
    asm volatile("s_waitcnt lgkmcnt(0)" ::: "memory");
}
#define TR_JOB(Wp, ld, K, ncols, WTp, mode) do { const int _nblk = (ncols) / 32, _nit = ((K) / 64) * _nblk; \
    for (int it = gw; it < _nit; it += NGW) tr_item((Wp), (ld), (K), _nblk, (WTp), (mode), scr, it, lane); } while (0)

__device__ __forceinline__ void norm_mod_rows(const float* xl, const float* xc, const float* ng, const float* modl, int si, bf16_t* out, int nrows, int gw, int NGW, int lane) {
    for (int row = gw; row < nrows; row += NGW) {
        const float* xr; int mr;
        if (row < NLAT) { xr = xl + (size_t)row * DM; mr = row >> 12; } else { xr = xc + (size_t)(row - NLAT) * DM; mr = 4; }
        f32x4 v[8]; float s = 0.f;
#pragma unroll
        for (int j = 0; j < 8; ++j) { v[j] = *(const f32x4*)(xr + 256 * j + 4 * lane); s += v[j][0] * v[j][0] + v[j][1] * v[j][1] + v[j][2] * v[j][2] + v[j][3] * v[j][3]; }
        const float rs = rsqrtf(wave_sum(s) * (1.f / DM) + EPS);
        const float* sh = modl + (size_t)mr * 12288 + si * DM; const float* sc = sh + DM;
#pragma unroll
        for (int jh = 0; jh < 8; jh += 4) {
            f32x4 g4[4], a4[4], b4[4];
#pragma unroll
            for (int j = 0; j < 4; ++j) { const int c = 256 * (jh + j) + 4 * lane; g4[j] = *(const f32x4*)(ng + c); a4[j] = *(const f32x4*)(sh + c); b4[j] = *(const f32x4*)(sc + c); }
            __builtin_amdgcn_sched_barrier(0);
#pragma unroll
            for (int j = 0; j < 4; ++j) { const int c = 256 * (jh + j) + 4 * lane; f32x4 y;
#pragma unroll
                for (int e = 0; e < 4; ++e) y[e] = v[jh + j][e] * rs * g4[j][e] * (1.f + b4[j][e]) + a4[j][e];
                u32x2 w; w.x = cvt_pk(y[0], y[1]); w.y = cvt_pk(y[2], y[3]); *(u32x2*)(out + (size_t)row * DM + c) = w; }
        }
    }
}
__device__ __forceinline__ void phase0(const Args& a, unsigned char* ws, float* sm, int tid) {
    const int w = tid >> 6, lane = tid & 63;
    float* sl = sm;
    float* red = sm + 5 * 2048;
    for (int i = tid; i < 5 * 2048; i += 512) { const float c = i < 4 * 2048 ? gin(a.in[lidx(I_C)])[i] : gin(a.in[lidx(I_CCTX)])[i - 4 * 2048]; sl[i] = c * sigmoidf_(c); }
    __syncthreads();
    float* mod = (float*)(ws + O_MOD);
    for (int u = vbid(); u < 384; u += lidx((int)gridDim.x)) {
        const int l = u / 192, j = (u % 192) * 64 + lane;
        const float* W = gin(a.in[lidx(I_WMOD)]) + (size_t)l * DM * 12288 + j;
        float acc[5] = {0.f, 0.f, 0.f, 0.f, 0.f};
#pragma unroll 1
        for (int k0 = w * 256; k0 < w * 256 + 256; k0 += 16) { float wv[16];
#pragma unroll
            for (int i = 0; i < 16; ++i) wv[i] = W[(size_t)(k0 + i) * 12288];
            __builtin_amdgcn_sched_barrier(0);
#pragma unroll
            for (int i = 0; i < 16; ++i)
#pragma unroll
                for (int r = 0; r < 5; ++r) acc[r] += sl[r * 2048 + k0 + i] * wv[i]; }
#pragma unroll
        for (int r = 0; r < 5; ++r) red[(w * 5 + r) * 64 + lane] = acc[r];
        __syncthreads();
        if (tid < 320) { const int r = tid >> 6; float s = 0.f;
#pragma unroll
            for (int ww = 0; ww < 8; ++ww) s += red[(ww * 5 + r) * 64 + lane];
            mod[(size_t)(l * 5 + r) * 12288 + j] = s + gin(a.in[lidx(I_BMOD)])[l * 12288 + j]; }
        __syncthreads();
    }
    { f32x2* rope = (f32x2*)(ws + O_ROPE); const int gt0 = lidx((int)blockIdx.x) * 512 + tid;
      if (gt0 < 1024) { const int f = gt0 & 15, pos = gt0 >> 4; float sn, cs; sincosf((float)pos * exp2f(-(float)f * (13.287712379549449f / 16.f)), &sn, &cs); rope[gt0] = (f32x2){cs, sn}; } }
    f32x2* lamp = (f32x2*)(ws + O_LAMP); f32x2* bbar = (f32x2*)(ws + O_BBAR);
    const int gt = lidx((int)blockIdx.x) * 512 + tid, gs = lidx((int)gridDim.x) * 512;
    for (int idx = gt; idx < 2 * 64 * 2 * 65 * 64; idx += gs) {
        const int n = idx & 63, p = (idx >> 6) % 65, rest = idx / (64 * 65), dir = rest & 1, g = (rest >> 1) & 63, l = rest >> 7;
        const int si = ((l * 2 + dir) * 64 + g) * 64 + n;
        const float re = fminf(gin(a.in[lidx(I_ARE)])[si], -1e-4f), im = gin(a.in[lidx(I_AIM)])[si], dt = expf(gin(a.in[lidx(I_LOGDT)])[(l * 2 + dir) * 64 + g]);
        const float mag = expf((float)p * (re * dt)); float s, c; sincosf((float)p * (im * dt), &s, &c);
        lamp[idx] = (f32x2){mag * c, mag * s};
    }
    for (int idx = gt; idx < 2 * 64 * 2 * 64 * 16; idx += gs) {
        const int ci = idx & 15, n = (idx >> 4) & 63, dir = (idx >> 10) & 1, g = (idx >> 11) & 63, l = idx >> 17;
        const int si = ((l * 2 + dir) * 64 + g) * 64 + n;
        const float re = fminf(gin(a.in[lidx(I_ARE)])[si], -1e-4f), im = gin(a.in[lidx(I_AIM)])[si], dt = expf(gin(a.in[lidx(I_LOGDT)])[(l * 2 + dir) * 64 + g]);
        const float mag = expf(re * dt); float s, c; sincosf(im * dt, &s, &c);
        const float nr = mag * c - 1.f, ni = mag * s, d = re * re + im * im;
        const float qr = (nr * re + ni * im) / d, qi = (ni * re - nr * im) / d;
        const float br = gin(a.in[lidx(I_BRE)])[(size_t)si * 16 + ci], bi = gin(a.in[lidx(I_BIM)])[(size_t)si * 16 + ci];
        bbar[idx] = (f32x2){qr * br - qi * bi, qr * bi + qi * br};
    }
}

__device__ __forceinline__ void phaseA(const Args& a, unsigned char* ws, unsigned char* smraw, int l, const float* xl, const float* xc, int tid, int mode, int boff, int nb) {
    const int wave = tid >> 6, lane = tid & 63;
    const int vb_ = lidx((int)blockIdx.x) - boff;
    const int gw = vb_ * 8 + wave, NGW = nb * 8;
    float* scr = (float*)(smraw + wave * 16384);
    const float* win = gin(a.in[lidx(I_WIN)]) + (size_t)l * DM * DIN;
    bf16_t* Wz1 = (bf16_t*)(ws + O_WZ1); bf16_t* Wkv = (bf16_t*)(ws + O_WKV);
    {
        constexpr int NJ = 17;
        constexpr int cum[NJ + 1] = {0, 512, 1024, 2048, 3072, 4096, 4160, 5696, 11840, 12224, 12736, 13248, 14272, 15296, 16320, 18368, 26560, 34752};
        const int it_lo = 0, it_hi = mode == 2 ? 0 : cum[NJ];
        for (int it = it_lo + gw; it < it_hi; it += NGW) {
            int j = 0;
#pragma unroll
            for (int k = 1; k < NJ; ++k) j += (it >= cum[k]) ? 1 : 0;
            int base = 0;
#pragma unroll
            for (int k = 1; k < NJ; ++k) base = (j == k) ? cum[k] : base;
            const float* W; int ld, K, ncols, mode = 0; bf16_t* WT;
            if (j < 8) { ld = DIN; K = DM;
                const int so[8] = {0, 512, 2048, 3088, 4176, 4112, 512, 5200}; const int nc[8] = {512, 512, 1024, 1024, 1024, 64, 1536, 6144}; const int dr[6] = {0, 512, 1024, 2048, 3072, 4096};
                int sof = 0, ncl = 0, dro = 0;
#pragma unroll
                for (int k = 0; k < 8; ++k) { sof = (j == k) ? so[k] : sof; ncl = (j == k) ? nc[k] : ncl; }
#pragma unroll
                for (int k = 0; k < 6; ++k) dro = (j == k) ? dr[k] : dro;
                W = win + sof; ncols = ncl; WT = j < 6 ? Wz1 + (size_t)dro * DM : (j == 6 ? Wkv : (bf16_t*)(ws + O_WG)); }
            else if (j == 8) { W = gin(a.in[lidx(I_WUQ)]) + (size_t)l * 512 * 1536; ld = 1536; K = 512; ncols = 1536; WT = (bf16_t*)(ws + O_WUQ); }
            else if (j == 9) { W = gin(a.in[lidx(I_WUKV)]) + (size_t)l * 512 * 2048; ld = 2048; K = 512; ncols = 2048; WT = (bf16_t*)(ws + O_WUKVK); mode = 1; }
            else if (j == 10) { W = gin(a.in[lidx(I_WGLU)]) + (size_t)l * 1024 * 1024; ld = 1024; K = 1024; ncols = 1024; WT = (bf16_t*)(ws + O_WGLU); }
            else if (j < 14) { const int r = j - 11; W = gin(a.in[lidx(I_WBR)]) + ((size_t)l * 3 + r) * 1024 * 2048; ld = 2048; K = 1024; ncols = 2048; WT = (bf16_t*)(ws + O_WBR) + (size_t)r * 2048 * 1024; }
            else if (j == 14) { W = gin(a.in[lidx(I_WOUT)]) + (size_t)l * DM * DM; ld = DM; K = DM; ncols = DM; WT = (bf16_t*)(ws + O_WOUT); }
            else if (j == 15) { W = gin(a.in[lidx(I_FF1)]) + (size_t)l * DM * DFF; ld = DFF; K = DM; ncols = DFF; WT = (bf16_t*)(ws + O_W1); }
            else { W = gin(a.in[lidx(I_FF2)]) + (size_t)l * DFF * DM; ld = DM; K = DFF; ncols = DM; WT = (bf16_t*)(ws + (l == 0 ? O_W2 : O_W2B)); }
            tr_item(W, ld, K, ncols / 32, WT, mode, scr, it - base, lane);
        }
    }
    const int gt = vb_ * 512 + tid, gs = nb * 512;
    if (mode != 2) {
    for (int idx = gt; idx < 192 * DM; idx += gs) { const int r = idx / DM, k = idx % DM;
        const float v = r < 16 ? win[(size_t)k * DIN + 3072 + r] : 0.f; Wz1[(size_t)(4160 + r) * DM + k] = (bf16_t)(cvt_pk(v, 0.f) & 0xffffu); }
    { float* b1 = (float*)(ws + O_BIAS); float* bkv = b1 + 4352; float* bg = bkv + 1536; const float* bin = gin(a.in[lidx(I_BIN)]) + (size_t)l * DIN;
      for (int i = gt; i < 4352; i += gs) { int src = -1;
          if (i < 1024) src = i; else if (i < 2048) src = 2048 + (i - 1024); else if (i < 3072) src = 3088 + (i - 2048); else if (i < 4096) src = 4176 + (i - 3072);
          else if (i < 4160) src = 4112 + (i - 4096); else if (i < 4176) src = 3072 + (i - 4160);
          b1[i] = src >= 0 ? bin[src] : 0.f; }
      for (int i = gt; i < 1536; i += gs) bkv[i] = bin[512 + i];
      for (int i = gt; i < 6144; i += gs) bg[i] = bin[5200 + i]; }
    const f32x2* lamp = (const f32x2*)(ws + O_LAMP) + (size_t)l * 64 * 2 * 65 * 64; const f32x2* bbar = (const f32x2*)(ws + O_BBAR) + (size_t)l * 64 * 2 * 64 * 16;
    bf16_t* T1 = (bf16_t*)(ws + O_T1); bf16_t* T2 = (bf16_t*)(ws + O_T2); bf16_t* KC = (bf16_t*)(ws + O_KC);
    for (int idx = gt; idx < 64 * 16 * 32 * 64; idx += gs) {
        const int ln = idx & 63, ks = (idx >> 6) & 31, rbk = (idx >> 11) & 15, g = idx >> 15;
        const int row = rbk * 16 + (ln & 15), k0 = 32 * ks + 8 * (ln >> 4);
        const int dir = row >> 7, n = (row >> 1) & 63, reim = row & 1, j = k0 >> 4, ci0 = k0 & 15;
        const int p = dir ? j : 63 - j;
        const f32x2 lp = lamp[((g * 2 + dir) * 65 + p) * 64 + n];
        const f32x2* bb = bbar + ((size_t)(g * 2 + dir) * 64 + n) * 16 + ci0;
        float v[8];
#pragma unroll
        for (int e = 0; e < 8; ++e) { const f32x2 b = bb[e]; v[e] = reim ? (lp.x * b.y + lp.y * b.x) : (lp.x * b.x - lp.y * b.y); }
        *(bf16x8*)(T1 + (size_t)g * 256 * 1024 + (size_t)idx % (16 * 32 * 64) * 8) = pack8(v);
    }
    for (int idx = gt; idx < 64 * 64 * 16 * 2 * 16; idx += gs) {
        const int co = idx & 15, q_ = (idx >> 4) & 3, ksl = (idx >> 6) & 3, dir = (idx >> 8) & 1, t = (idx >> 9) & 63, g = idx >> 15, nq = ksl * 4 + q_;
        const int p = dir ? 64 - t : t + 1, n0 = 4 * nq;
        const f32x4 cr = *(const f32x4*)(gin(a.in[lidx(I_CRE)]) + ((size_t)((l * 2 + dir) * 64 + g) * 16 + co) * 64 + n0), ci4 = *(const f32x4*)(gin(a.in[lidx(I_CIM)]) + ((size_t)((l * 2 + dir) * 64 + g) * 16 + co) * 64 + n0);
        const f32x2* lpp = lamp + ((g * 2 + dir) * 65 + p) * 64 + n0;
        float v[8];
#pragma unroll
        for (int e = 0; e < 4; ++e) { const f32x2 lp = lpp[e]; v[2 * e] = cr[e] * lp.x - ci4[e] * lp.y; v[2 * e + 1] = -(cr[e] * lp.y + ci4[e] * lp.x); }
        *(bf16x8*)(T2 + (size_t)g * 1024 * 256 + (size_t)((t * 8 + dir * 4 + (nq >> 2)) * 64 + (nq & 3) * 16 + co) * 8) = pack8(v);
    }
    { f32x2* lps = (f32x2*)smraw; float* ex = (float*)(smraw + 2 * 32 * 64 * 8);
      for (int u = vb_; u < 128; u += nb) {
        const int g = u >> 1, ph = u & 1;
        __syncthreads();
        for (int i = tid; i < 2 * 32 * 64; i += 512) { const int n = i & 63, pp = (i >> 6) & 31, dir = i >> 11; lps[i] = lamp[((g * 2 + dir) * 65 + 32 * ph + pp) * 64 + n]; }
        __syncthreads();
        const int pair = tid & 255, co = pair >> 4, ci = pair & 15, dir = tid >> 8;
        const float* cre = gin(a.in[lidx(I_CRE)]) + ((size_t)((l * 2 + dir) * 64 + g) * 16 + co) * 64; const float* cim = gin(a.in[lidx(I_CIM)]) + ((size_t)((l * 2 + dir) * 64 + g) * 16 + co) * 64;
        const f32x2* bb = bbar + ((size_t)(g * 2 + dir) * 64) * 16 + ci;
        float acc[32];
#pragma unroll
        for (int pp = 0; pp < 32; ++pp) acc[pp] = 0.f;
        for (int n = 0; n < 64; ++n) {
            const f32x2 b = bb[n * 16]; const float cr = cre[n], cm = cim[n];
            const float xr = cr * b.x - cm * b.y, xi = cr * b.y + cm * b.x;
            const f32x2* lq = lps + dir * 2048 + n;
#pragma unroll
            for (int pp = 0; pp < 32; ++pp) { const f32x2 lp = lq[pp * 64]; acc[pp] += xr * lp.x - xi * lp.y; }
        }
        if (ph == 0 && dir == 1) ex[pair] = acc[0];
        __syncthreads();
        bf16_t* kc = KC + (size_t)g * 128 * 256 + pair;
#pragma unroll
        for (int pp = 0; pp < 32; ++pp) {
            const int p = 32 * ph + pp;
            if (p == 0) { if (dir == 0) { const float v = acc[0] + ex[pair] + (co == ci ? gin(a.in[lidx(I_S5D)])[l * 1024 + g * 16 + co] : 0.f); kc[63 * 256] = (bf16_t)(cvt_pk(v, 0.f) & 0xffffu); kc[127 * 256] = 0; } }
            else kc[(dir == 0 ? 63 + p : 63 - p) * 256] = (bf16_t)(cvt_pk(acc[pp], 0.f) & 0xffffu);
        }
      }
      __syncthreads(); }
    }
    if (mode != 1) {
    norm_mod_rows(xl, xc, gin(a.in[lidx(I_NORMG)]) + (size_t)(l * 2 + 0) * DM, (const float*)(ws + O_MOD) + (size_t)l * 5 * 12288, 0, (bf16_t*)(ws + O_HX), MROWS, gw, NGW, lane);
    }
}

__device__ __forceinline__ void mla_norm(const Args& a, unsigned char* ws, int l, int gw, int NGW, int lane) {
    bf16_t* z1 = (bf16_t*)(ws + O_Z1);
    for (int it = gw; it < MROWS * 2; it += NGW) {
        const int row = it >> 1, which = it & 1;
        bf16_t* p = z1 + (size_t)row * LDZ + (which ? ZKVA : ZQA) + lane * 8;
        float v[8]; unpack8(*(const bf16x8*)p, v);
        float s = 0.f;
#pragma unroll
        for (int e = 0; e < 8; ++e) s += v[e] * v[e];
        const float rs = rsqrtf(wave_sum(s) * (1.f / 512.f) + EPS);
        const float* g = (which ? gin(a.in[lidx(I_KVAG)]) : gin(a.in[lidx(I_QAG)])) + l * 512 + lane * 8;
#pragma unroll
        for (int e = 0; e < 8; ++e) v[e] = v[e] * rs * g[e];
        *(bf16x8*)p = pack8(v);
    }
}
__device__ __forceinline__ float logsigmoidf_(float x) { return fminf(x, 0.f) - log1pf(__expf(-fabsf(x))); }
__device__ __forceinline__ float scan_add_incl(float v, int lane) {
#pragma unroll
    for (int o = 1; o < 64; o <<= 1) { const float t = __shfl_up(v, o); if (lane >= o) v += t; }
    return v;
}
__device__ __forceinline__ float scan_max_incl(float v, int lane) {
#pragma unroll
    for (int o = 1; o < 64; o <<= 1) { const float t = __shfl_up(v, o); if (lane >= o) v = fmaxf(v, t); }
    return v;
}
__device__ __forceinline__ void ml_state_pass(const Args& a, unsigned char* ws, float* sm, int l, int tid) {
    const int w = tid >> 6, lane = tid & 63, cidx = lane & 15, q = lane >> 4;
    const float* misc = (const float*)(ws + O_MISC); const bf16_t* KVt = (const bf16_t*)(ws + O_KVT);
    bf16_t* Cst = (bf16_t*)(ws + O_BR + BRSZ); float* MLG = (float*)(ws + O_MLG); float* MLN = (float*)(ws + O_MLN); float* MLM = (float*)(ws + O_MLM);
    float* wsh = sm + w * 128;
    constexpr int SP = 136, BUFB = (128 + 32) * SP * 2 + 1024;
    unsigned char* sbase = (unsigned char*)sm + 4096;
#define MLS_ROW0(ci_) ({ const int _oc = dir == 0 ? (ci_) : ((ci_) < 2 ? 1 - (ci_) : 35 - (ci_)); _oc < 2 ? NLAT + b * CTXL + _oc * MLCH : b * SEQ + (_oc - 2) * MLCH; })
#define MLS_LOAD(ci_) do { const int _r0 = MLS_ROW0(ci_); \
        _Pragma("unroll") for (int k = 0; k < 4; ++k) { const int c = tid + 512 * k, r = c >> 4, cc = c & 15; kreg[k] = *(const u32x4*)(KVt + (size_t)(h * 128 + r) * MROWS + _r0 + cc * 8); } \
        { const int r = tid >> 4, cc = tid & 15; vreg = *(const u32x4*)(KVt + (size_t)(512 + h * 256 + slice * 32 + r) * MROWS + _r0 + cc * 8); } \
        greg = 0.f; if (tid < 256) greg = misc[(size_t)(_r0 + (tid & 127)) * NMISC + 64 + (dir * 2 + (tid >> 7)) * 4 + h]; } while (0)
#define MLS_STORE(buf_) do { unsigned char* _b = sbase + (buf_) * BUFB; \
        _Pragma("unroll") for (int k = 0; k < 4; ++k) { const int c = tid + 512 * k, r = c >> 4, cc = c & 15; *(u32x4*)(_b + (r * SP + cc * 8) * 2) = kreg[k]; } \
        { const int r = tid >> 4, cc = tid & 15; *(u32x4*)(_b + ((128 + r) * SP + cc * 8) * 2) = vreg; } \
        if (tid < 256) ((float*)(_b + 160 * SP * 2))[tid] = greg; } while (0)
    for (int u = vbid(); u < 256; u += lidx((int)gridDim.x)) {
        const int chain = u >> 3, slice = u & 7, dir = chain & 1, h = (chain >> 1) & 3, b = chain >> 3;
        const float bi = gin(a.in[lidx(I_MLGB)])[l * 16 + (dir * 2 + 0) * 4 + h], bf = gin(a.in[lidx(I_MLGB)])[l * 16 + (dir * 2 + 1) * 4 + h];
        const int i0 = 2 * lane, j0 = dir ? 127 - i0 : i0, j1 = dir ? 126 - i0 : i0 + 1;
        f32x4 acc[2] = {(f32x4){0.f, 0.f, 0.f, 0.f}, (f32x4){0.f, 0.f, 0.f, 0.f}};
        float nv = 0.f, m = 0.f;
        u32x4 kreg[4], vreg; float greg;
        __syncthreads();
        MLS_LOAD(0); __builtin_amdgcn_sched_barrier(0); MLS_STORE(0); __syncthreads();
#pragma unroll 1
        for (int ci = 0; ci < MLNC; ++ci) {
            const int row0 = MLS_ROW0(ci);
            if (ci + 1 < MLNC) MLS_LOAD(ci + 1);
            __builtin_amdgcn_sched_barrier(0);
            const unsigned char* cb_ = sbase + (ci & 1) * BUFB;
            const bf16_t* Ksh = (const bf16_t*)cb_; const bf16_t* Vsh = Ksh + 128 * SP; const float* gs = (const float*)(cb_ + 160 * SP * 2);
            const float li0 = gs[j0] + bi, li1 = gs[j1] + bi;
            const float lf0 = logsigmoidf_(gs[128 + j0] + bf), lf1 = logsigmoidf_(gs[128 + j1] + bf);
            const float S = scan_add_incl(lf0 + lf1, lane);
            const float G1 = S, G0 = S - lf1, a0 = li0 - G0, a1 = li1 - G1;
            const float pmx = scan_max_incl(fmaxf(a0, a1), lane);
            float prev = __shfl_up(pmx, 1); if (lane == 0) prev = -1e30f;
            const float pm0 = fmaxf(prev, a0), pm1 = pmx;
            const float Ftot = __shfl(S, 63), Ac = __shfl(pmx, 63);
            const float Mx = fmaxf(m, Ac), decay = __expf(m - Mx);
            asm volatile("s_waitcnt lgkmcnt(0)" ::: "memory");
            wsh[j0] = __expf(a0 - Mx); wsh[j1] = __expf(a1 - Mx);
            if (slice == 0 && w == 0) { const size_t o = (size_t)(dir * 4 + h) * MROWS + row0;
                MLG[o + j0] = G0; MLG[o + j1] = G1; MLG[(size_t)8 * MROWS + o + j0] = a0; MLG[(size_t)8 * MROWS + o + j1] = a1; MLG[(size_t)16 * MROWS + o + j0] = pm0; MLG[(size_t)16 * MROWS + o + j1] = pm1;
                if (lane == 0) MLM[chain * MLNC + ci] = m; }
            if (slice == 0 && q == 0) MLN[((size_t)chain * MLNC + ci) * 128 + 16 * w + cidx] = nv;
#pragma unroll
            for (int i = 0; i < 2; ++i)
#pragma unroll
                for (int r = 0; r < 4; ++r) Cst[(((size_t)chain * MLNC + ci) * 256 + slice * 32 + 16 * i + 4 * q + r) * 128 + 16 * w + cidx] = (bf16_t)(cvt_pk(acc[i][r], 0.f) & 0xffffu);
            asm volatile("s_waitcnt lgkmcnt(0)" ::: "memory");
            acc[0] *= decay; acc[1] *= decay;
            float nsum = 0.f;
#pragma unroll
            for (int ks = 0; ks < 4; ++ks) {
                const f32x4 w0 = *(const f32x4*)(wsh + 32 * ks + 8 * q), w1 = *(const f32x4*)(wsh + 32 * ks + 8 * q + 4);
                float kf[8]; unpack8(*(const bf16x8*)(Ksh + (16 * w + cidx) * SP + 32 * ks + 8 * q), kf);
#pragma unroll
                for (int e = 0; e < 4; ++e) { kf[e] *= w0[e]; kf[4 + e] *= w1[e]; nsum += kf[e] + kf[4 + e]; }
                const bf16x8 kb = pack8(kf);
#pragma unroll
                for (int i = 0; i < 2; ++i) acc[i] = mfma16(*(const bf16x8*)(Vsh + (16 * i + cidx) * SP + 32 * ks + 8 * q), kb, acc[i]);
            }
            nsum += __shfl_xor(nsum, 16); nsum += __shfl_xor(nsum, 32);
            nv = decay * nv + nsum;
            m = Ftot + Mx;
            __builtin_amdgcn_sched_barrier(0);
            if (ci + 1 < MLNC) MLS_STORE((ci + 1) & 1);
            __syncthreads();
        }
    }
#undef MLS_LOAD
#undef MLS_STORE
#undef MLS_ROW0
    __syncthreads();
}
__device__ __forceinline__ int s5_rowbase(int cc) { const int b = cc / S5NCH, ch = cc - b * S5NCH; const int r1 = NLAT + b * CTXL + ch * 64, r2 = b * SEQ + (ch - 4) * 64; return __builtin_amdgcn_readfirstlane(0) + ((ch < 4) ? r1 : r2); }
constexpr int UPITCH = 1032, XPITCH = 264;
__device__ __forceinline__ void s5_stage_u(const bf16_t* z1, bf16_t* Us, int g, int cb, int tid) {
    u32x4 tmp[4];
#pragma unroll
    for (int i = 0; i < 4; ++i) { const int c = tid + 512 * i, cc = c >> 7, j = (c >> 1) & 63, hf = c & 1;
        const int rowb = s5_rowbase(cb * 16 + cc);
        tmp[i] = *(const u32x4*)(z1 + (size_t)(rowb + j) * LDZ + ZU + g * 16 + 8 * hf); }
    __builtin_amdgcn_sched_barrier(0);
#pragma unroll
    for (int i = 0; i < 4; ++i) { const int c = tid + 512 * i, cc = c >> 7, j = (c >> 1) & 63, hf = c & 1;
        *(u32x4*)(Us + cc * UPITCH + j * 16 + 8 * hf) = tmp[i]; }
}
__device__ __forceinline__ void s5_pass1(unsigned char* ws, unsigned char* sm, int tid) {
    const int w = tid >> 6, lane = tid & 63, cidx = lane & 15, q = lane >> 4;
    const bf16_t* z1 = (const bf16_t*)(ws + O_Z1); const bf16_t* T1 = (const bf16_t*)(ws + O_T1); float* E = (float*)(ws + O_E);
    bf16_t* Us = (bf16_t*)sm;
    for (int u = vbid(); u < 64 * 17; u += lidx((int)gridDim.x)) {
        const int cb = u % 17, g = u / 17;
        __syncthreads();
        s5_stage_u(z1, Us, g, cb, tid);
        __syncthreads();
        f32x4 acc[2] = {(f32x4){0.f, 0.f, 0.f, 0.f}, (f32x4){0.f, 0.f, 0.f, 0.f}};
        const bf16_t* tp = T1 + (size_t)g * 256 * 1024 + (size_t)(2 * w) * 32 * 512 + lane * 8;
        const bf16_t* up = Us + cidx * UPITCH + 8 * q;
#pragma unroll 1
        for (int ks0 = 0; ks0 < 32; ks0 += 8) {
            bf16x8 af[8][2];
#pragma unroll
            for (int i = 0; i < 8; ++i) { af[i][0] = ldg8(tp + 512 * (ks0 + i)); af[i][1] = ldg8(tp + 32 * 512 + 512 * (ks0 + i)); }
            __builtin_amdgcn_sched_barrier(0);
#pragma unroll
            for (int i = 0; i < 8; ++i) { const bf16x8 bfr = *(const bf16x8*)(up + 32 * (ks0 + i)); acc[0] = mfma16(af[i][0], bfr, acc[0]); acc[1] = mfma16(af[i][1], bfr, acc[1]); }
            __builtin_amdgcn_sched_barrier(0);
        }
        const int cc = cb * 16 + cidx;
        *(f32x4*)(E + ((size_t)g * S5COLS + cc) * 256 + (w * 2) * 16 + 4 * q) = acc[0];
        *(f32x4*)(E + ((size_t)g * S5COLS + cc) * 256 + (w * 2 + 1) * 16 + 4 * q) = acc[1];
    }
    __syncthreads();
}
__device__ __forceinline__ void s5_scan(unsigned char* ws, int l, int tid) {
    const f32x2* lamp = (const f32x2*)(ws + O_LAMP) + (size_t)l * 64 * 2 * 65 * 64; const float* E = (const float*)(ws + O_E); bf16_t* X = (bf16_t*)(ws + O_X);
    for (int idx = lidx((int)blockIdx.x) * 512 + tid; idx < 64 * 4 * 2 * 64; idx += lidx((int)gridDim.x) * 512) {
        const int n = idx & 63, dir = (idx >> 6) & 1, b = (idx >> 7) & 3, g = idx >> 9;
        const f32x2 l64 = lamp[((g * 2 + dir) * 65 + 64) * 64 + n];
        float xr = 0.f, xi = 0.f;
#pragma unroll 1
        for (int s0 = 0; s0 < S5NCH; s0 += 17) {
            f32x2 ev[17];
#pragma unroll
            for (int k = 0; k < 17; ++k) { const int step = s0 + k, ch = dir == 0 ? step : (step < 4 ? 3 - step : 71 - step);
                ev[k] = *(const f32x2*)(E + ((size_t)g * S5COLS + b * S5NCH + ch) * 256 + dir * 128 + 2 * n); }
            __builtin_amdgcn_sched_barrier(0);
#pragma unroll
            for (int k = 0; k < 17; ++k) { const int step = s0 + k, ch = dir == 0 ? step : (step < 4 ? 3 - step : 71 - step);
                const size_t o = ((size_t)g * S5COLS + b * S5NCH + ch) * 256 + dir * 128 + 2 * n;
                *(unsigned*)(X + o) = cvt_pk(xr, xi);
                const float nr = l64.x * xr - l64.y * xi + ev[k].x, ni = l64.x * xi + l64.y * xr + ev[k].y; xr = nr; xi = ni; }
        }
    }
}
__device__ __forceinline__ float gelu_tanh(float x) { const float u = 0.7978845608028654f * (x + 0.044715f * x * x * x); return 0.5f * x * (1.f + tanhf(u)); }
__device__ __forceinline__ void s5_pass2(unsigned char* ws, unsigned char* sm, int tid) {
    const int w = tid >> 6, lane = tid & 63, cidx = lane & 15, q = lane >> 4;
    const bf16_t* z1 = (const bf16_t*)(ws + O_Z1); const bf16_t* T2 = (const bf16_t*)(ws + O_T2); const bf16_t* KC = (const bf16_t*)(ws + O_KC); const bf16_t* X = (const bf16_t*)(ws + O_X);
    bf16_t* Gs = (bf16_t*)(ws + O_GS);
    bf16_t* Us = (bf16_t*)sm; bf16_t* Xs = Us + 16 * UPITCH; bf16_t* KCs = Xs + 16 * XPITCH;
    for (int u = vbid(); u < 64 * 17; u += lidx((int)gridDim.x)) {
        const int cb = u % 17, g = u / 17;
        __syncthreads();
        s5_stage_u(z1, Us, g, cb, tid);
        { u32x4 kt[8]; const int cc = tid >> 5, part = tid & 31; const u32x4 xt = *(const u32x4*)(X + ((size_t)g * S5COLS + cb * 16 + cc) * 256 + part * 8);
#pragma unroll
          for (int i = 0; i < 8; ++i) { const int c = tid + 512 * i; kt[i] = *(const u32x4*)(KC + (size_t)g * 128 * 256 + c * 8); }
          __builtin_amdgcn_sched_barrier(0);
          *(u32x4*)(Xs + cc * XPITCH + part * 8) = xt;
#pragma unroll
          for (int i = 0; i < 8; ++i) { const int c = tid + 512 * i; *(u32x4*)(KCs + c * 8) = kt[i]; } }
        __syncthreads();
        f32x4 acc[8];
#pragma unroll
        for (int i = 0; i < 8; ++i) acc[i] = (f32x4){0.f, 0.f, 0.f, 0.f};
        const bf16_t* kp = KCs + (63 - (q >> 1) + 8 * w) * 256 + cidx * 16 + 8 * (q & 1);
        const bf16_t* up = Us + cidx * UPITCH + 8 * q;
#pragma unroll 8
        for (int ks = 0; ks < 32; ++ks) {
            const bf16x8 bfr = *(const bf16x8*)(up + 32 * ks);
#pragma unroll
            for (int tb = 0; tb < 8; ++tb) acc[tb] = mfma16(*(const bf16x8*)(kp + (tb - 2 * ks) * 256), bfr, acc[tb]);
        }
        const bf16_t* xp = Xs + cidx * XPITCH + 8 * q;
        const bf16_t* tp = T2 + (size_t)g * 1024 * 256 + (size_t)(8 * w) * 8 * 512 + lane * 8;
#pragma unroll 1
        for (int ks0 = 0; ks0 < 8; ks0 += 2) {
            bf16x8 af[2][8];
#pragma unroll
            for (int i = 0; i < 2; ++i)
#pragma unroll
                for (int tb = 0; tb < 8; ++tb) af[i][tb] = ldg8(tp + (size_t)tb * 8 * 512 + 512 * (ks0 + i));
            __builtin_amdgcn_sched_barrier(0);
#pragma unroll
            for (int i = 0; i < 2; ++i) { const bf16x8 bfr = *(const bf16x8*)(xp + 32 * (ks0 + i));
#pragma unroll
                for (int tb = 0; tb < 8; ++tb) acc[tb] = mfma16(af[i][tb], bfr, acc[tb]); }
            __builtin_amdgcn_sched_barrier(0);
        }
        const int rowb = s5_rowbase(cb * 16 + cidx);
#pragma unroll
        for (int tb = 0; tb < 8; ++tb) { u32x2 o; o.x = cvt_pk(gelu_tanh(acc[tb][0]), gelu_tanh(acc[tb][1])); o.y = cvt_pk(gelu_tanh(acc[tb][2]), gelu_tanh(acc[tb][3]));
            *(u32x2*)(Gs + (size_t)(rowb + 8 * w + tb) * 1024 + g * 16 + 4 * q) = o; }
    }
    __syncthreads();
}
__device__ __forceinline__ void qk_prep(const Args& a, unsigned char* ws, int l, int gw, int NGW, int lane) {
    const int h = lane >> 3, sub = lane & 7;
    const float* misc = (const float*)(ws + O_MISC);
    for (int it = gw; it < MROWS * 2; it += NGW) {
        const int row = it >> 1, which = it & 1;
        bf16_t* p = (bf16_t*)(ws + (which ? O_K : O_Q)) + (size_t)row * 1536 + h * 192 + 8 * sub;
        const float* gn = (which ? gin(a.in[lidx(I_KNG)]) : gin(a.in[lidx(I_QNG)])) + l * 192 + 8 * sub;
        float v[3][8];
        unpack8(*(const bf16x8*)p, v[0]); unpack8(*(const bf16x8*)(p + 64), v[1]);
        if (which) { const f32x4 k0 = *(const f32x4*)(misc + (size_t)row * NMISC + 8 * sub), k1 = *(const f32x4*)(misc + (size_t)row * NMISC + 8 * sub + 4);
#pragma unroll
            for (int e = 0; e < 4; ++e) { v[2][e] = k0[e]; v[2][4 + e] = k1[e]; } }
        else unpack8(*(const bf16x8*)(p + 128), v[2]);
        float s = 0.f;
#pragma unroll
        for (int j = 0; j < 3; ++j)
#pragma unroll
            for (int e = 0; e < 8; ++e) s += v[j][e] * v[j][e];
        s += __shfl_xor(s, 1); s += __shfl_xor(s, 2); s += __shfl_xor(s, 4);
        const float rs = rsqrtf(s * (1.f / 192.f) + EPS);
#pragma unroll
        for (int j = 0; j < 3; ++j)
#pragma unroll
            for (int e = 0; e < 8; ++e) v[j][e] = v[j][e] * rs * gn[64 * j + e];
        if (row < NLAT) {
            const int t = row & (SEQ - 1);
            const int pos = (sub >> 2) ? (t & 63) : (t >> 6);
            const f32x2* rp = (const f32x2*)(ws + O_ROPE) + pos * 16 + 8 * (sub & 1);
            f32x2 cs8[8];
#pragma unroll
            for (int e = 0; e < 8; ++e) cs8[e] = rp[e];
#pragma unroll
            for (int e = 0; e < 8; ++e) {
                const float partner = __shfl_xor(v[2][e], 2);
                v[2][e] = (sub & 2) ? (v[2][e] * cs8[e].x + partner * cs8[e].y) : (v[2][e] * cs8[e].x - partner * cs8[e].y);
            }
        }
        *(bf16x8*)p = pack8(v[0]); *(bf16x8*)(p + 64) = pack8(v[1]); *(bf16x8*)(p + 128) = pack8(v[2]);
    }
}

__device__ __forceinline__ void ml_out_pass(const Args& a, unsigned char* ws, unsigned char* sm, int l, bool with_ctx, int tid) {
    const int w = tid >> 6, lane = tid & 63, cidx = lane & 15, q = lane >> 4;
    const bf16_t* z1 = (const bf16_t*)(ws + O_Z1); const bf16_t* KVt = (const bf16_t*)(ws + O_KVT); const bf16_t* Cst = (const bf16_t*)(ws + O_BR + BRSZ);
    const float* MLG = (const float*)(ws + O_MLG); const float* MLN = (const float*)(ws + O_MLN); const float* MLM = (const float*)(ws + O_MLM);
    bf16_t* BRa = (bf16_t*)(ws + O_BR);
    constexpr int KP = 136;
    bf16_t* Ks = (bf16_t*)sm; float* As = (float*)(sm + 128 * KP * 2);
    const float scale = 0.08838834764831845f;
    for (int u = vbid(); u < 4 * 4 * MLNC; u += lidx((int)gridDim.x)) {
        const int oc = u % MLNC, h = (u / MLNC) & 3, b = u / (4 * MLNC);
        if (!with_ctx && oc < 2) continue;
        const int row0 = oc < 2 ? NLAT + b * CTXL + oc * MLCH : b * SEQ + (oc - 2) * MLCH;
        const int rb = w, t = 16 * rb + cidx;
        __syncthreads();
        { u32x4 kt[4];
#pragma unroll
          for (int i = 0; i < 4; ++i) { const int c = tid + 512 * i, r = c >> 4, cc = c & 15; kt[i] = *(const u32x4*)(z1 + (size_t)(row0 + r) * LDZ + ZK + h * 128 + cc * 8); }
          float av = 0.f; if (tid < 256) av = MLG[(size_t)(8 + (tid >> 7) * 4 + h) * MROWS + row0 + (tid & 127)];
          __builtin_amdgcn_sched_barrier(0);
#pragma unroll
          for (int i = 0; i < 4; ++i) { const int c = tid + 512 * i, r = c >> 4, cc = c & 15; *(u32x4*)(Ks + r * KP + cc * 8) = kt[i]; }
          if (tid < 256) As[tid] = av; }
        bf16x8 qf[4];
#pragma unroll
        for (int ks = 0; ks < 4; ++ks) qf[ks] = ldg8(z1 + (size_t)(row0 + t) * LDZ + ZQ + h * 128 + 32 * ks + 8 * q);
        __syncthreads();
        bf16x8 pf[2][4]; float inv2[2], wsc2[2];
#pragma unroll
        for (int dir = 0; dir < 2; ++dir) {
            const int chain = (b * 4 + h) * 2 + dir, ci = dir == 0 ? oc : (oc < 2 ? 1 - oc : 35 - oc);
            const float mc = MLM[chain * MLNC + ci];
            const float* Gp = MLG + (size_t)(dir * 4 + h) * MROWS + row0; const float* pp = Gp + (size_t)16 * MROWS;
            const float Gt = Gp[t], Mt = fmaxf(mc, pp[t]);
            f32x4 nq[4][2];
            { const float* np = MLN + ((size_t)chain * MLNC + ci) * 128 + 8 * q;
#pragma unroll
              for (int ks = 0; ks < 4; ++ks) { nq[ks][0] = *(const f32x4*)(np + 32 * ks); nq[ks][1] = *(const f32x4*)(np + 32 * ks + 4); } }
            __builtin_amdgcn_sched_barrier(0);
            const float winter = __expf(mc - Mt);
            float qn = 0.f;
#pragma unroll
            for (int ks = 0; ks < 4; ++ks) { float qv[8]; unpack8(qf[ks], qv);
#pragma unroll
                for (int e = 0; e < 4; ++e) qn += qv[e] * nq[ks][0][e] + qv[4 + e] * nq[ks][1][e]; }
            qn += __shfl_xor(qn, 16); qn += __shfl_xor(qn, 32);
            float rsum = 0.f;
#pragma unroll
            for (int i = 0; i < 4; ++i) {
                float pv[8];
#pragma unroll
                for (int hb = 0; hb < 2; ++hb) {
                    const int kb = 2 * i + hb;
                    const bool skip = dir == 0 ? (kb > rb) : (kb < rb);
                    f32x4 sacc = (f32x4){0.f, 0.f, 0.f, 0.f};
                    if (!(a.sub & 16))
#pragma unroll
                    for (int ks = 0; ks < 4; ++ks) sacc = mfma16(*(const bf16x8*)(Ks + (16 * kb + cidx) * KP + 32 * ks + 8 * q), qf[ks], sacc);
                    const f32x4 a4 = *(const f32x4*)(As + dir * 128 + 16 * kb + 4 * q);
#pragma unroll
                    for (int r = 0; r < 4; ++r) {
                        const int sidx = 16 * kb + 4 * q + r;
                        const bool valid = !skip && (dir == 0 ? (sidx <= t) : (sidx >= t));
                        const float e = __expf(fminf(a4[r] - Mt, 0.f));
                        const float val = valid ? sacc[r] * scale * e : 0.f;
                        pv[hb * 4 + r] = val; rsum += val;
                    }
                }
                pf[dir][i] = pack8(pv);
            }
            rsum += __shfl_xor(rsum, 16); rsum += __shfl_xor(rsum, 32);
            const float den = winter * qn * scale + rsum;
            inv2[dir] = 1.f / fmaxf(fabsf(den), __expf(-(Gt + Mt)));
            wsc2[dir] = winter * scale;
        }
        float ss = 0.f;
        bf16_t* dp = BRa + (size_t)(row0 + t) * 1024 + h * 256 + 4 * q;
        const int ci0 = oc, ci1 = oc < 2 ? 1 - oc : 35 - oc;
        constexpr int SP = 136, SBUF = 64 * SP;
        bf16_t* stg = (bf16_t*)(sm + 36864);
        const bf16_t* cg0 = Cst + ((size_t)((b * 4 + h) * 2 + 0) * MLNC + ci0) * 256 * 128;
        const bf16_t* cg1 = Cst + ((size_t)((b * 4 + h) * 2 + 1) * MLNC + ci1) * 256 * 128;
        const bf16_t* vg = KVt + (size_t)(512 + h * 256) * MROWS + row0;
        u32x4 sreg[6];
#define MLO_SLOAD(s_) do { _Pragma("unroll") for (int k = 0; k < 6; ++k) { const int c = tid + 512 * k, which = c >> 10, idx = c & 1023, r = idx >> 4, cc = idx & 15; \
            const bf16_t* src = which == 0 ? cg0 + (size_t)(64 * (s_) + r) * 128 + cc * 8 : (which == 1 ? cg1 + (size_t)(64 * (s_) + r) * 128 + cc * 8 : vg + (size_t)(64 * (s_) + r) * MROWS + cc * 8); \
            sreg[k] = *(const u32x4*)src; } } while (0)
#define MLO_SSTORE(buf_) do { _Pragma("unroll") for (int k = 0; k < 6; ++k) { const int c = tid + 512 * k, which = c >> 10, idx = c & 1023, r = idx >> 4, cc = idx & 15; \
            *(u32x4*)(stg + (buf_) * 3 * SBUF + which * SBUF + r * SP + cc * 8) = sreg[k]; } } while (0)
        MLO_SLOAD(0); __builtin_amdgcn_sched_barrier(0); MLO_SSTORE(0); __syncthreads();
#pragma unroll 1
        for (int st = 0; st < ((a.sub & 8) ? 0 : 4); ++st) {
            if (st + 1 < 4) MLO_SLOAD(st + 1);
            __builtin_amdgcn_sched_barrier(0);
            const bf16_t* sb = stg + (st & 1) * 3 * SBUF;
#pragma unroll
            for (int d4 = 0; d4 < 4; ++d4) {
                f32x4 hsum = (f32x4){0.f, 0.f, 0.f, 0.f};
                const bf16_t* vrow = sb + 2 * SBUF + (16 * d4 + cidx) * SP + 4 * q;
#pragma unroll
                for (int dir = 0; dir < 2; ++dir) {
                    const bf16_t* crow = sb + dir * SBUF + (16 * d4 + cidx) * SP + 8 * q;
                    f32x4 acc = (f32x4){0.f, 0.f, 0.f, 0.f};
#pragma unroll
                    for (int ks = 0; ks < 4; ++ks) acc = mfma16(*(const bf16x8*)(crow + 32 * ks), qf[ks], acc);
                    acc *= wsc2[dir];
#pragma unroll
                    for (int i = 0; i < 4; ++i) { const u32x2 lo = *(const u32x2*)(vrow + 32 * i); asm volatile("" ::: "memory"); const u32x2 hi = *(const u32x2*)(vrow + 32 * i + 16); asm volatile("" ::: "memory");
                        const u32x4 av = (u32x4){lo.x, lo.y, hi.x, hi.y}; acc = mfma16(__builtin_bit_cast(bf16x8, av), pf[dir][i], acc); }
                    hsum += acc * inv2[dir];
                }
                ss += hsum[0] * hsum[0] + hsum[1] * hsum[1] + hsum[2] * hsum[2] + hsum[3] * hsum[3];
                u32x2 r_; r_.x = cvt_pk(hsum[0], hsum[1]); r_.y = cvt_pk(hsum[2], hsum[3]); *(u32x2*)(dp + 16 * (4 * st + d4)) = r_;
            }
            __builtin_amdgcn_sched_barrier(0);
            if (st + 1 < 4) MLO_SSTORE((st + 1) & 1);
            __syncthreads();
        }
#undef MLO_SLOAD
#undef MLO_SSTORE
        ss += __shfl_xor(ss, 16); ss += __shfl_xor(ss, 32);
        const float rs = rsqrtf(ss * (1.f / 256.f) + EPS);
        const float* ng = gin(a.in[lidx(I_MLNG)]) + (size_t)l * 1024 + h * 256 + 4 * q;
        const bf16_t* op = z1 + (size_t)(row0 + t) * LDZ + ZO + h * 256 + 4 * q;
#pragma unroll 1
        for (int i0 = 0; i0 < 16; i0 += 4) {
            u32x2 ov[4], hv[4]; f32x4 g4[4];
#pragma unroll
            for (int k = 0; k < 4; ++k) { ov[k] = *(const u32x2*)(op + 16 * (i0 + k)); g4[k] = *(const f32x4*)(ng + 16 * (i0 + k)); hv[k] = *(const u32x2*)(dp + 16 * (i0 + k)); }
            __builtin_amdgcn_sched_barrier(0);
#pragma unroll
            for (int k = 0; k < 4; ++k) {
                const float o0 = __uint_as_float(ov[k].x << 16), o1 = __uint_as_float(ov[k].x & 0xffff0000u), o2 = __uint_as_float(ov[k].y << 16), o3 = __uint_as_float(ov[k].y & 0xffff0000u);
                const float h0 = __uint_as_float(hv[k].x << 16), h1 = __uint_as_float(hv[k].x & 0xffff0000u), h2 = __uint_as_float(hv[k].y << 16), h3 = __uint_as_float(hv[k].y & 0xffff0000u);
                u32x2 r; r.x = cvt_pk(h0 * rs * g4[k][0] * sigmoidf_(o0), h1 * rs * g4[k][1] * sigmoidf_(o1)); r.y = cvt_pk(h2 * rs * g4[k][2] * sigmoidf_(o2), h3 * rs * g4[k][3] * sigmoidf_(o3));
                *(u32x2*)(dp + 16 * (i0 + k)) = r;
            }
        }
    }
    __syncthreads();
}

constexpr int VPITCH = 72, KTILE_B = 64 * 24 * 16, VTILE_B = 128 * VPITCH * 2;
__device__ __forceinline__ void attn_phase(unsigned char* ws, unsigned char* sm, bool with_ctx, int tid) {
    const int w = tid >> 6, lane = tid & 63, cidx = lane & 15, q = lane >> 4;
    const bf16_t* Q = (const bf16_t*)(ws + O_Q); const bf16_t* K = (const bf16_t*)(ws + O_K); const bf16_t* Vt = (const bf16_t*)(ws + O_VTA);
    bf16_t* out = (bf16_t*)(ws + O_BR + BRSZ);
    const float C = 0.07216878364870322f * 1.4426950408889634f;
    const int nunits = 512 + (with_ctx ? 32 : 0);
    for (int u = vbid(); u < nunits; u += lidx((int)gridDim.x)) {
        int b, h, qrow0, ntiles;
        if (u < 512) { b = u >> 7; h = (u >> 4) & 7; qrow0 = b * SEQ + (u & 15) * 256; ntiles = 68; }
        else { const int uu = u - 512; b = uu >> 3; h = uu & 7; qrow0 = NLAT + b * CTXL; ntiles = 4; }
        bf16x8 qf[2][6];
#pragma unroll
        for (int qq = 0; qq < 2; ++qq)
#pragma unroll
            for (int ks = 0; ks < 6; ++ks) qf[qq][ks] = ldg8(Q + (size_t)(qrow0 + 32 * w + 16 * qq + cidx) * 1536 + h * 192 + 32 * ks + 8 * q);
        f32x4 o[8][2];
#pragma unroll
        for (int i = 0; i < 8; ++i) { o[i][0] = (f32x4){0.f, 0.f, 0.f, 0.f}; o[i][1] = (f32x4){0.f, 0.f, 0.f, 0.f}; }
        float mrun[2] = {-1e30f, -1e30f}, lsum[2] = {0.f, 0.f};
        unsigned koff[4], voff[3];
#pragma unroll
        for (int i = 0; i < 3; ++i) { const int L = (w + 8 * i) * 64 + lane, r = L / 24, cl = L - r * 24, cc = cl ^ (r & 7); koff[i] = (unsigned)((r * 1536 + h * 192 + cc * 8) * 2); }
        koff[3] = 0u;
#pragma unroll
        for (int i = 0; i < 3; ++i) { const int c = (w + 8 * i) * 64 + lane, r = c / 9; int cc = c - r * 9; if (cc == 8) cc = 0; voff[i] = (unsigned)(((h * 128 + r) * MROWS + cc * 8) * 2); }
#define ATT_LOAD(j, buf) do { const int _kr = (j) < 4 ? NLAT + b * CTXL + 64 * (j) : b * SEQ + 64 * ((j) - 4); \
        const char* _kg = (const char*)(K + (size_t)_kr * 1536); const char* _vg = (const char*)(Vt + _kr); \
        LAS unsigned char* _kb = (LAS unsigned char*)sm + (buf) * (KTILE_B + VTILE_B); LAS unsigned char* _vb = _kb + KTILE_B; \
        _Pragma("unroll") for (int _i = 0; _i < 3; ++_i) __builtin_amdgcn_global_load_lds((const unsigned*)(_kg + koff[_i]), (LAS unsigned*)(_kb + (w + 8 * _i) * 1024), 16, 0, 0); \
        _Pragma("unroll") for (int _i = 0; _i < 3; ++_i) if (w + 8 * _i < 18) __builtin_amdgcn_global_load_lds((const unsigned*)(_vg + voff[_i]), (LAS unsigned*)(_vb + (w + 8 * _i) * 1024), 16, 0, 0); } while (0)
#define ATT_STORE(buf) do { } while (0)
        ATT_LOAD(0, 0); asm volatile("s_waitcnt vmcnt(0)" ::: "memory"); __syncthreads();
        for (int j = 0; j < ntiles; ++j) {
            if (j + 1 < ntiles) ATT_LOAD(j + 1, (j + 1) & 1);
            const unsigned char* kb_ = sm + (j & 1) * (KTILE_B + VTILE_B); const unsigned char* vb_ = kb_ + KTILE_B;
            f32x4 s[4][2];
#pragma unroll
            for (int kb = 0; kb < 4; ++kb) { s[kb][0] = (f32x4){0.f, 0.f, 0.f, 0.f}; s[kb][1] = (f32x4){0.f, 0.f, 0.f, 0.f};
#pragma unroll
                for (int ks = 0; ks < 6; ++ks) { const bf16x8 af = *(const bf16x8*)(kb_ + ((16 * kb + cidx) * 24 + ((4 * ks + q) ^ (cidx & 7))) * 16);
                    s[kb][0] = mfma16(af, qf[0][ks], s[kb][0]); s[kb][1] = mfma16(af, qf[1][ks], s[kb][1]); } }
            bf16x8 pf[2][2];
#pragma unroll
            for (int qq = 0; qq < 2; ++qq) {
                float mx = fmaxf(fmaxf(s[0][qq][0], s[0][qq][1]), fmaxf(s[0][qq][2], s[0][qq][3]));
#pragma unroll
                for (int kb = 1; kb < 4; ++kb) mx = fmaxf(mx, fmaxf(fmaxf(s[kb][qq][0], s[kb][qq][1]), fmaxf(s[kb][qq][2], s[kb][qq][3])));
                if (!__all(mx - mrun[qq] <= 110.851251684f)) {
                    mx = fmaxf(mx, __shfl_xor(mx, 16)); mx = fmaxf(mx, __shfl_xor(mx, 32));
                    const float mnew = fmaxf(mrun[qq], mx), alpha = __builtin_amdgcn_exp2f((mrun[qq] - mnew) * C);
                    mrun[qq] = mnew; lsum[qq] *= alpha;
#pragma unroll
                    for (int i = 0; i < 8; ++i) o[i][qq] *= alpha;
                }
                const float mc = mrun[qq] * C;
                float ps = 0.f; float pv[4][4];
#pragma unroll
                for (int kb = 0; kb < 4; ++kb)
#pragma unroll
                    for (int r = 0; r < 4; ++r) { pv[kb][r] = __builtin_amdgcn_exp2f(fmaf(s[kb][qq][r], C, -mc)); ps += pv[kb][r]; }
                lsum[qq] += ps;
#pragma unroll
                for (int i = 0; i < 2; ++i) { u32x4 pw; pw.x = cvt_pk(pv[2 * i][0], pv[2 * i][1]); pw.y = cvt_pk(pv[2 * i][2], pv[2 * i][3]); pw.z = cvt_pk(pv[2 * i + 1][0], pv[2 * i + 1][1]); pw.w = cvt_pk(pv[2 * i + 1][2], pv[2 * i + 1][3]);
                    pf[qq][i] = __builtin_bit_cast(bf16x8, pw); }
            }
#pragma unroll
            for (int dvb = 0; dvb < 8; ++dvb)
#pragma unroll
                for (int i = 0; i < 2; ++i) {
                    const unsigned char* vq = vb_ + ((16 * dvb + cidx) * VPITCH + 32 * i + 4 * q) * 2;
                    const u32x2 lo = *(const u32x2*)vq; asm volatile("" ::: "memory"); const u32x2 hi = *(const u32x2*)(vq + 32); asm volatile("" ::: "memory");
                    const bf16x8 af = __builtin_bit_cast(bf16x8, ((u32x4){lo.x, lo.y, hi.x, hi.y}));
                    o[dvb][0] = mfma16(af, pf[0][i], o[dvb][0]); o[dvb][1] = mfma16(af, pf[1][i], o[dvb][1]);
                }
            asm volatile("s_waitcnt vmcnt(0)" ::: "memory");
            __syncthreads();
        }
#pragma unroll
        for (int qq = 0; qq < 2; ++qq) {
            float lt = lsum[qq]; lt += __shfl_xor(lt, 16); lt += __shfl_xor(lt, 32);
            const float inv = 1.f / lt;
            bf16_t* dp = out + (size_t)(qrow0 + 32 * w + 16 * qq + cidx) * 1024 + h * 128 + 4 * q;
#pragma unroll
            for (int dvb = 0; dvb < 8; ++dvb) { u32x2 r; r.x = cvt_pk(o[dvb][qq][0] * inv, o[dvb][qq][1] * inv); r.y = cvt_pk(o[dvb][qq][2] * inv, o[dvb][qq][3] * inv); *(u32x2*)(dp + 16 * dvb) = r; }
        }
    }
#undef ATT_LOAD
#undef ATT_STORE
}


#define XB_TMO      128
#define XB_XCNT(j)  (256  + 64 * (j))
#define XB_XSUB(j)  (1280 + 64 * (j))
#define XB_XGEN(j)  (2304 + 64 * (j))
#define XB_TOP      3328
#define XB_TOPGEN   3392
#define XCD_BAR_WORDS 3456
#define XB_SPIN_CAP (1u << 18)
__device__ __forceinline__ unsigned xb_ld(unsigned* p)              { return __hip_atomic_load(p, __ATOMIC_RELAXED, __HIP_MEMORY_SCOPE_AGENT); }
__device__ __forceinline__ unsigned xb_add(unsigned* p, unsigned v) { return __hip_atomic_fetch_add(p, v, __ATOMIC_RELAXED, __HIP_MEMORY_SCOPE_AGENT); }
__device__ __forceinline__ unsigned xb_xcc_id() { return (unsigned)__builtin_amdgcn_s_getreg((3 << 11) | 20) & 0xFu; }
#define XB_SPIN(cond, bar) do { unsigned _sp = 0; while (cond) { __builtin_amdgcn_s_sleep(1); \
    if ((++_sp & 255u) == 0u) { if (xb_ld(&(bar)[XB_TMO])) break; if (_sp > XB_SPIN_CAP) { atomicAdd(&(bar)[XB_TMO], 1u); break; } } } } while (0)
struct XcdBarrier { unsigned* bar; unsigned x; volatile LAS unsigned* st; };
__device__ __forceinline__ XcdBarrier xcd_barrier_post(unsigned* bar, volatile LAS unsigned* st) {
    XcdBarrier b; b.bar = bar; b.x = xb_xcc_id(); b.st = st;
    if (threadIdx.x == 0) (void)xb_add(&bar[XB_XCNT(b.x)], 1u);
    return b;
}
__device__ __forceinline__ void xcd_barrier_complete(unsigned* bar, unsigned x, unsigned& nloc, unsigned& nx) {
    const unsigned G = gridDim.x * gridDim.y * gridDim.z;
    unsigned sum, cnt, mine, sp = 0u;
    for (;;) {
        sum = 0u; cnt = 0u; mine = 0u;
#pragma unroll
        for (unsigned j = 0; j < 16; ++j) { const unsigned c = xb_ld(&bar[XB_XCNT(j)]); sum += c; cnt += (c > 0u) ? 1u : 0u; mine = (j == x) ? c : mine; }
        if (sum == G) break;
        __builtin_amdgcn_s_sleep(1);
        if ((++sp & 255u) == 0u) { if (xb_ld(&bar[XB_TMO])) break; if (sp > XB_SPIN_CAP) { atomicAdd(&bar[XB_TMO], 1u); break; } }
    }
    nloc = mine > 0u ? mine : 1u; nx = cnt > 0u ? cnt : 1u;
}
__device__ __forceinline__ void xcd_barrier(const XcdBarrier& b) {
    asm volatile("s_waitcnt vmcnt(0)" ::: "memory");
    __syncthreads();
    if (threadIdx.x == 0) {
        unsigned* bar = b.bar;
        __builtin_amdgcn_s_waitcnt(0);
        unsigned nloc = b.st[0], nx = b.st[1];
        if (nloc == 0u) { xcd_barrier_complete(bar, b.x, nloc, nx); b.st[0] = nloc; b.st[1] = nx; }
        const unsigned old = xb_add(&bar[XB_XSUB(b.x)], 1u);
        const unsigned gen = old / nloc;
        if (old + 1u == (gen + 1u) * nloc) {
            __builtin_amdgcn_fence(__ATOMIC_RELEASE, "agent");
            asm volatile("s_waitcnt vmcnt(0)" ::: "memory");
            const unsigned og = xb_add(&bar[XB_TOP], 1u);
            const unsigned tg = og / nx;
            if (og + 1u == (tg + 1u) * nx) xb_add(&bar[XB_TOPGEN], 1u);
            else XB_SPIN(xb_ld(&bar[XB_TOPGEN]) == tg, bar);
            __builtin_amdgcn_fence(__ATOMIC_ACQUIRE, "agent");
            xb_add(&bar[XB_XGEN(b.x)], 1u);
            asm volatile("s_waitcnt vmcnt(0)" ::: "memory");
        } else {
            XB_SPIN(xb_ld(&bar[XB_XGEN(b.x)]) == gen, bar);
            __builtin_amdgcn_fence(__ATOMIC_ACQUIRE, "agent");
            asm volatile("s_waitcnt vmcnt(0)" ::: "memory");
        }
    }
    __syncthreads();
}

constexpr int LDS_BYTES = 147456;
constexpr int NPHASE = 25;
constexpr int PROBE_LO = -1, PROBE_HI = -1, PROBE_SUB = 7;
__global__ void __launch_bounds__(512, 2) mega(Args a) {
    extern __shared__ __attribute__((aligned(16))) unsigned char lds[];
    cg::grid_group grid = cg::this_grid();
    const int NGW = lidx((int)gridDim.x) * 8;
#define tid (ltid())
#define lane (ltid() & 63)
#define gw ((int)(lidx((int)blockIdx.x) * 8 + (ltid() >> 6)))
unsigned char* const wsraw_ = (unsigned char*)a.ws;
#define ws (lptr(a.ws))
    LAS unsigned char* ldsl = (LAS unsigned char*)lds;
    const int lo = a.ph_lo, hi = a.ph_hi;
#define IN(p) ((p) >= lo && (p) < hi)
    volatile LAS unsigned* xst = (volatile LAS unsigned*)(ldsl + LDS_BYTES - 64);
    if (threadIdx.x < 2) xst[threadIdx.x] = 0u;
    __syncthreads();
    const XcdBarrier xbar = xcd_barrier_post((unsigned*)(wsraw_ + O_BARW) + a.bar_region * 4096, xst);
#define SEAM(p) do { if ((p) + 1 < hi) { if ((p) == 0) grid.sync(); else xcd_barrier(xbar); } } while (0)
    if (IN(0)) { phase0(a, ws, (float*)lds, tid); SEAM(0); }
    const int G = lidx((int)gridDim.x), cb = lidx((int)blockIdx.x);
    float* outl = (float*)a.out; float* outc = (float*)(ws + O_CTXX);
#pragma unroll 1
    for (int l = 0; l < 2; ++l) {
        const int P = 1 + 12 * l;
        const bool wctx = (l == 0);
        const int Mlate = wctx ? MROWS : NLAT;
        const float* xl = l == 0 ? gin(a.in[lidx(I_X)]) : outl; const float* xc = l == 0 ? gin(a.in[lidx(I_CTX)]) : outc;
        const float* modl = (const float*)(ws + O_MOD) + (size_t)l * 5 * 12288;
        const bf16_t* HX = (const bf16_t*)(ws + O_HX); const bf16_t* Z1 = (const bf16_t*)(ws + O_Z1);
        if (IN(P + 0)) { phaseA(a, ws, lds, l, xl, xc, tid, (l == 0 || G <= 64) ? 0 : 2, 0, G); SEAM(P + 0); }
        if (IN(P + 1)) {
            { pg8::Gemm g{HX, (const bf16_t*)(ws + O_WZ1), DM, DM, DM, 0, 0}; pg8::Order<1> S; S.init(MROWS, NZ1, G, cb);
              pg8::Epi<FZ1> E{{(bf16_t*)(ws + O_Z1), (float*)(ws + O_MISC), (const float*)(ws + O_BIAS)}};
#ifndef NO_G0
            pg8::gemm_phase(ldsl, g, S, E);
#endif
 }
            { pg8::Gemm g{(const bf16_t*)(ws + O_WKV), HX, DM, DM, DM, 0, 0}; pg8::Order<1> S; S.init(1536, MROWS, G, cb);
              pg8::Epi<FRowBias> E{{(bf16_t*)(ws + O_KVT), MROWS, (const float*)(ws + O_BIAS) + 4352}};
#ifndef NO_G1
            pg8::gemm_phase(ldsl, g, S, E);
#endif
 }
            SEAM(P + 1);
        }
        if (IN(P + 2)) { if (a.sub & 1) mla_norm(a, ws, l, gw, NGW, lane); if (a.sub & 2) s5_pass1(ws, lds, tid); if (a.sub & 4) ml_state_pass(a, ws, (float*)lds, l, tid); SEAM(P + 2); }
        if (IN(P + 3)) {
            { pg8::Gemm g{Z1 + ZQA, (const bf16_t*)(ws + O_WUQ), LDZ, 512, 512, 0, 0}; pg8::Order<1> S; S.init(MROWS, 1536, G, cb);
              pg8::Epi<FPlain> E{{(bf16_t*)(ws + O_Q), 1536}};
#ifndef NO_G2
            pg8::gemm_phase(ldsl, g, S, E);
#endif
 }
            { pg8::Gemm g{Z1 + ZKVA, (const bf16_t*)(ws + O_WUKVK), LDZ, 512, 512, 0, 0}; pg8::Order<1> S; S.init(MROWS, 1024, G, cb);
              pg8::Epi<FKn> E{{(bf16_t*)(ws + O_K)}};
#ifndef NO_G3
            pg8::gemm_phase(ldsl, g, S, E);
#endif
 }
            { pg8::Gemm g{(const bf16_t*)(ws + O_WUKVV), Z1 + ZKVA, 512, LDZ, 512, 0, 0}; pg8::Order<1> S; S.init(1024, MROWS, G, cb);
              pg8::Epi<FRowBias> E{{(bf16_t*)(ws + O_VTA), MROWS, nullptr}};
#ifndef NO_G4
            pg8::gemm_phase(ldsl, g, S, E);
#endif
 }
            s5_scan(ws, l, tid);
            SEAM(P + 3);
        }
        if (IN(P + 4)) { if (a.sub & 1) qk_prep(a, ws, l, gw, NGW, lane); if (a.sub & 2) s5_pass2(ws, lds, tid); if (a.sub & 4) ml_out_pass(a, ws, lds, l, wctx, tid); SEAM(P + 4); }
        if (IN(P + 5)) {
            attn_phase(ws, lds, wctx, tid);
            { pg8::Gemm g{(const bf16_t*)(ws + O_GS), (const bf16_t*)(ws + O_WGLU), 1024, 1024, 1024, 0, 0}; pg8::Order<1> S; S.init(Mlate, 1024, G, cb);
              pg8::Epi<FGlu> E{{(bf16_t*)(ws + O_BR + 2 * BRSZ), (const bf16_t*)(ws + O_GS), gin(a.in[lidx(I_BGLU)]) + l * 1024}};
#ifndef NO_G5
            pg8::gemm_phase(ldsl, g, S, E);
#endif
 }
            SEAM(P + 5);
        }
        if (IN(P + 6)) {
            pg8::Gemm g{HX, (const bf16_t*)(ws + O_WG), DM, DM, DM, 0, 0}; pg8::Order<1> S; S.init(Mlate, 6144, G, cb);
            pg8::Epi<FGate> E{{(bf16_t*)(ws + O_GATES), (const float*)(ws + O_BIAS) + 4352 + 1536}};
#ifndef NO_G6
            pg8::gemm_phase(ldsl, g, S, E);
#endif

            SEAM(P + 6);
        }
        if (IN(P + 7)) {
            pg8::Gemm g{(const bf16_t*)(ws + O_BR), (const bf16_t*)(ws + O_WBR), 1024, 1024, 1024, (size_t)MROWS * 1024, (size_t)2048 * 1024}; pg8::Order<3> S; S.init(Mlate, DM, G, cb);
            pg8::Epi<FMerge> E{{(bf16_t*)(ws + O_HX), (const bf16_t*)(ws + O_GATES)}};
#ifndef NO_G7
            pg8::gemm_phase(ldsl, g, S, E);
#endif

            SEAM(P + 7);
        }
        if (IN(P + 8)) {
            pg8::Gemm g{HX, (const bf16_t*)(ws + O_WOUT), DM, DM, DM, 0, 0}; pg8::Order<1> S; S.init(Mlate, DM, G, cb);
            pg8::Epi<FResid> E{{xl, xc, outl, outc, modl, 2}};
#ifndef NO_G8
            pg8::gemm_phase(ldsl, g, S, E);
#endif

            SEAM(P + 8);
        }
        if (IN(P + 9)) { norm_mod_rows(outl, outc, gin(a.in[lidx(I_NORMG)]) + (size_t)(l * 2 + 1) * DM, modl, 3, (bf16_t*)(ws + O_HX), Mlate, gw, NGW, lane); SEAM(P + 9); }
        if (IN(P + 10)) {
            pg8::Gemm g{HX, (const bf16_t*)(ws + O_W1), DM, DM, DM, 0, 0}; pg8::Order<1> S; S.init(Mlate, DFF, G, cb);
            pg8::Epi<FFF1> E{{(bf16_t*)(ws + O_HID)}};
#ifndef NO_G9
            pg8::gemm_phase(ldsl, g, S, E);
#endif

            SEAM(P + 10);
        }
        if (IN(P + 11)) {
            pg8::Gemm g{(const bf16_t*)(ws + O_HID), (const bf16_t*)(ws + (l == 0 ? O_W2 : O_W2B)), DFF, DFF, DFF, 0, 0}; pg8::Order<1> S; S.init(Mlate, DM, G, cb);
            pg8::Epi<FResid> E{{outl, outc, outl, outc, modl, 5}};
#ifndef NO_G10
            pg8::gemm_phase(ldsl, g, S, E);
#endif
            if (wctx && cb >= 32 && G > 64) phaseA(a, ws, lds, 1, nullptr, nullptr, tid, 1, 32, G - 32);

            SEAM(P + 11);
        }
    }
#undef IN
#undef SEAM
#undef tid
#undef lane
#undef gw
#undef ws
}

extern "C" void kernel_launch(void* const* d_in, const int* in_sizes, int n_in, void* d_out, int out_size, void* d_ws, size_t ws_size, hipStream_t stream) {
    static int grid = 0;
    if (grid == 0) {
        int dev = 0, cus = 0, per_cu = 0;
        (void)hipGetDevice(&dev);
        (void)hipDeviceGetAttribute(&cus, hipDeviceAttributeMultiprocessorCount, dev);
        (void)hipFuncSetAttribute((const void*)mega, hipFuncAttributeMaxDynamicSharedMemorySize, LDS_BYTES);
        (void)hipOccupancyMaxActiveBlocksPerMultiprocessor(&per_cu, (const void*)mega, 512, LDS_BYTES);
        if (per_cu < 1) per_cu = 1;
        grid = cus * per_cu;
        if (ws_size < O_END2) fprintf(stderr, "kernel_launch: workspace too small: %zu < %zu\n", ws_size, (size_t)O_END2);
    }
    (void)hipMemsetAsync((unsigned char*)d_ws + O_BARW, 0, 2 * 16384, stream);
    Args a{};
    for (int i = 0; i < 31 && i < n_in; ++i) a.in[i] = (GAS const float*)d_in[i];
    a.out = (GAS float*)d_out; a.ws = (GAS unsigned char*)d_ws; a.ph_lo = 0; a.ph_hi = NPHASE; a.sub = 7;
    void* args[] = {&a};
    hipError_t e = hipLaunchCooperativeKernel((const void*)mega, dim3(grid), dim3(512), args, LDS_BYTES, stream);
    if (e != hipSuccess) fprintf(stderr, "cooperative launch failed: %s (grid %d)\n", hipGetErrorString(e), grid);
    if (PROBE_LO >= 0) { Args b2 = a; b2.ph_lo = PROBE_LO; b2.ph_hi = PROBE_HI; b2.sub = PROBE_SUB; b2.bar_region = 1; void* args2[] = {&b2};
        (void)hipLaunchCooperativeKernel((const void*)mega, dim3(grid), dim3(512), args2, LDS_BYTES, stream); }
}
```

```cpp
#include <hip/hip_runtime.h>
#include <hip/hip_cooperative_groups.h>
#include <cstdio>
#include <cstdint>
namespace cg = cooperative_groups;

typedef unsigned short bf16_t;
typedef short bf16x8 __attribute__((ext_vector_type(8)));
typedef float f32x4 __attribute__((ext_vector_type(4)));
typedef float f32x2 __attribute__((ext_vector_type(2)));
typedef unsigned u32x4 __attribute__((ext_vector_type(4)));
typedef unsigned u32x2 __attribute__((ext_vector_type(2)));
#define LAS __attribute__((address_space(3)))
#define GAS __attribute__((address_space(1)))

constexpr int DM = 2048, NB = 4, SEQ = 4096, CTXL = 256, NLAT = NB * SEQ, NCTX = NB * CTXL, MROWS = NLAT + NCTX;
constexpr int DIN = 11344, DFF = 8192;
constexpr int NZ1 = 4352;
constexpr int LDZ = 4096;
constexpr int ZQ = 0, ZK = 512, ZO = 1024, ZQA = 2048, ZKVA = 2560, ZU = 3072;
constexpr int NMISC = 80;
constexpr int MLCH = 128, MLNC = 34;
constexpr int S5NCH = 68, S5COLS = NB * S5NCH;
constexpr float EPS = 1e-6f;

constexpr size_t al256(size_t x) { return (x + 255) & ~(size_t)255; }
constexpr size_t O_WZ1 = 0;
constexpr size_t O_WKV = O_WZ1 + (size_t)NZ1 * DM * 2;
constexpr size_t O_WG = O_WKV + (size_t)1536 * DM * 2;
constexpr size_t O_WUQ = O_WG + (size_t)6144 * DM * 2;
constexpr size_t O_WUKVK = O_WUQ + (size_t)1536 * 512 * 2;
constexpr size_t O_WUKVV = O_WUKVK + (size_t)1024 * 512 * 2;
constexpr size_t O_WGLU = O_WUKVV + (size_t)1024 * 512 * 2;
constexpr size_t O_WBR = O_WGLU + (size_t)1024 * 1024 * 2;
constexpr size_t O_WOUT = O_WBR + (size_t)3 * 2048 * 1024 * 2;
constexpr size_t O_W1 = O_WOUT + (size_t)2048 * 2048 * 2;
constexpr size_t O_W2 = O_W1 + (size_t)8192 * 2048 * 2;
constexpr size_t O_BIAS = O_W2 + (size_t)8192 * 2048 * 2;
constexpr size_t O_T1 = al256(O_BIAS + (size_t)(4352 + 1536 + 6144) * 4);
constexpr size_t O_T2 = O_T1 + (size_t)64 * 256 * 1024 * 2;
constexpr size_t O_KC = O_T2 + (size_t)64 * 1024 * 256 * 2;
constexpr size_t O_LAMP = O_KC + (size_t)64 * 128 * 256 * 2;
constexpr size_t O_BBAR = O_LAMP + (size_t)2 * 64 * 2 * 65 * 64 * 8;
constexpr size_t O_MOD = O_BBAR + (size_t)2 * 64 * 2 * 64 * 16 * 8;
constexpr size_t O_CTXX = al256(O_MOD + (size_t)2 * 5 * 12288 * 4);
constexpr size_t O_MLG = O_CTXX + (size_t)NCTX * DM * 4;
constexpr size_t O_MLN = O_MLG + (size_t)3 * 8 * MROWS * 4;
constexpr size_t O_MLM = O_MLN + (size_t)32 * MLNC * 128 * 4;
constexpr size_t O_HX = al256(O_MLM + (size_t)32 * MLNC * 4);
constexpr size_t O_BR = O_HX + (size_t)MROWS * DM * 2;
constexpr size_t BRSZ = (size_t)MROWS * 1024 * 2;
constexpr size_t O_R1 = O_BR + 3 * BRSZ;
constexpr size_t O_Z1 = O_R1;
constexpr size_t O_MISC = O_Z1 + (size_t)MROWS * LDZ * 2;
constexpr size_t O_KVT = O_MISC + (size_t)MROWS * NMISC * 4;
constexpr size_t O_Q = O_KVT + (size_t)1536 * MROWS * 2;
constexpr size_t O_K = O_Q + (size_t)MROWS * 1536 * 2;
constexpr size_t O_VTA = O_K + (size_t)MROWS * 1536 * 2;
constexpr size_t O_E = O_VTA + (size_t)1024 * MROWS * 2;
constexpr size_t O_X = O_E + (size_t)64 * S5COLS * 256 * 4;
constexpr size_t O_GS = O_X + (size_t)64 * S5COLS * 256 * 2;
constexpr size_t O_END = O_GS + (size_t)MROWS * 1024 * 2;
constexpr size_t O_W2B = O_END;
constexpr size_t O_ROPE = O_W2B + (size_t)8192 * 2048 * 2;
constexpr size_t O_BARW = O_ROPE + 64 * 16 * 8;
constexpr size_t O_END2 = O_BARW + 2 * 16384;
constexpr size_t O_GATES = O_R1;
constexpr size_t O_HID = O_R1;
static_assert(O_GATES + (size_t)MROWS * 6144 * 2 <= O_GS, "gates alias");
static_assert(O_HID + (size_t)MROWS * 8192 * 2 <= O_END, "hidden alias");

__device__ __forceinline__ float bf2f(unsigned u) { return __uint_as_float(u << 16); }
__device__ __forceinline__ unsigned cvt_pk(float lo, float hi) { unsigned r; asm volatile("v_cvt_pk_bf16_f32 %0, %1, %2" : "=v"(r) : "v"(lo), "v"(hi)); return r; }
__device__ __forceinline__ float wave_sum(float v) {
#pragma unroll
    for (int o = 1; o < 64; o <<= 1) v += __shfl_xor(v, o);
    return v;
}
__device__ __forceinline__ float sigmoidf_(float x) { return 1.f / (1.f + __expf(-x)); }
__device__ __forceinline__ f32x4 mfma16(bf16x8 a, bf16x8 b, f32x4 c) { return __builtin_amdgcn_mfma_f32_16x16x32_bf16(a, b, c, 0, 0, 0); }
__device__ __forceinline__ bf16x8 ldg8(const bf16_t* p) { return *(const bf16x8*)p; }
__device__ __forceinline__ void unpack8(bf16x8 v, float* f) {
    const u32x4 w = __builtin_bit_cast(u32x4, v);
    f[0] = __uint_as_float(w.x << 16); f[1] = __uint_as_float(w.x & 0xffff0000u); f[2] = __uint_as_float(w.y << 16); f[3] = __uint_as_float(w.y & 0xffff0000u);
    f[4] = __uint_as_float(w.z << 16); f[5] = __uint_as_float(w.z & 0xffff0000u); f[6] = __uint_as_float(w.w << 16); f[7] = __uint_as_float(w.w & 0xffff0000u);
}
__device__ __forceinline__ bf16x8 pack8(const float* f) { u32x4 w; w.x = cvt_pk(f[0], f[1]); w.y = cvt_pk(f[2], f[3]); w.z = cvt_pk(f[4], f[5]); w.w = cvt_pk(f[6], f[7]); return __builtin_bit_cast(bf16x8, w); }

__device__ __forceinline__ int ltid() { int t = threadIdx.x; asm volatile("" : "+v"(t)); return t; }
__device__ __forceinline__ int lidx(int i) { asm volatile("" : "+s"(i)); return i; }
template <class T> __device__ __forceinline__ T* lptr(GAS T* p) { asm volatile("" : "+s"(p)); return (T*)p; }
__device__ __forceinline__ const float* gin(GAS const float* p) { return (const float*)p; }
__device__ __forceinline__ int vbid() { const int G = lidx((int)gridDim.x), b = lidx((int)blockIdx.x); return (G % 8 == 0) ? (b % 8) * (G / 8) + b / 8 : b; }
namespace pg8 {
constexpr int BM = 256, BK = 64, HALF = 128, HTB = HALF * BK * 2, STAGE_BYTES = 8 * HTB, NXCD = 8, WGM = 8;
__host__ __device__ __forceinline__ int lds_byte(int r, int c) { const int st = (r >> 4) * 2 + (c >> 5), rr = r & 15, cc = c & 31, ob = rr * 64 + cc * 2; return st * 1024 + (ob ^ (((ob >> 9) & 1) << 5)); }
__host__ __device__ __forceinline__ void stage_rc(int b, int& R, int& C) { const int st = b / 1024, sb = b % 1024, swz = sb ^ (((sb >> 9) & 1) << 5); R = (st >> 1) * 16 + swz / 64; C = (st & 1) * 32 + (swz % 64) / 2; }
__host__ __device__ __forceinline__ int perm32(int rho) { const int n = rho >> 4, i = rho & 15; return 8 * (i >> 2) + 4 * n + (i & 3); }
struct Unit { int pm, pn, r; };
struct Gemm { const bf16_t* A; const bf16_t* Bt; int lda, ldb, K; size_t rsA, rsB; };
template <int NR> struct Order {
    int nM, nN, nwg, G, c;
    __device__ void init(int M, int N, int G_, int c_) { nM = M / BM; nN = N / BM; nwg = nM * nN; G = G_; c = c_; }
    __device__ bool next(int i, Unit& u) const {
        const int ti = i / NR; u.r = i - ti * NR;
        const long L = (long)ti * G + c; if (L >= nwg) return false;
        int wgid = (int)L; { const int q = nwg / NXCD, r = nwg % NXCD, xcd = wgid % NXCD, off = wgid / NXCD; wgid = (xcd < r ? xcd * (q + 1) : r * (q + 1) + (xcd - r) * q) + off; }
        const int nig = WGM * nN, gid = wgid / nig, fm = gid * WGM, gsz = (nM - fm) < WGM ? (nM - fm) : WGM;
        u.pm = fm + ((wgid % nig) % gsz); u.pn = (wgid % nig) / gsz; return true;
    }
};
template <class F> struct Epi {
    F f;
    __device__ __forceinline__ void operator()(const f32x4 (&acc)[2][2][4][2], const Unit& u, int wr, int wc, int fr, int fq) const {
        typename F::Pre pre[2];
        const int row0 = u.pm * BM + wr * 64 + fr, col0 = u.pn * BM + wc * 32 + 8 * fq;
#pragma unroll
        for (int bj = 0; bj < 2; ++bj) f.pre(u.r, row0, col0 + bj * HALF, pre[bj]);
#pragma unroll
        for (int ai = 0; ai < 2; ++ai)
#pragma unroll
            for (int m2 = 0; m2 < 4; m2 += 2) {
                typename F::Aux ax[2][2];
#pragma unroll
                for (int mm = 0; mm < 2; ++mm)
#pragma unroll
                    for (int bj = 0; bj < 2; ++bj) f.ld(u.r, row0 + ai * HALF + (m2 + mm) * 16, col0 + bj * HALF, ax[mm][bj]);
                __builtin_amdgcn_sched_barrier(0);
#pragma unroll
                for (int mm = 0; mm < 2; ++mm)
#pragma unroll
                    for (int bj = 0; bj < 2; ++bj) f.st(u.r, row0 + ai * HALF + (m2 + mm) * 16, col0 + bj * HALF, acc[ai][bj][m2 + mm][0], acc[ai][bj][m2 + mm][1], pre[bj], ax[mm][bj]);
                __builtin_amdgcn_sched_barrier(0);
            }
    }
};

template <class EpiT, class Sched>
__device__ __forceinline__ void gemm_phase(LAS unsigned char* lds, const Gemm g, const Sched& S, const EpiT& E) {
    const int tid = ltid(), wid = __builtin_amdgcn_readfirstlane(tid >> 6), lane = tid & 63, wr = wid >> 2, wc = wid & 3, fr = lane & 15, fq = lane >> 4;
    const int K = g.K, nt = K / BK;
    unsigned voffA[2], voffB[2];
#pragma unroll
    for (int i = 0; i < 2; ++i) { int R, C; stage_rc(tid * 16 + i * 8192, R, C); const int Rb = (R & ~31) + perm32(R & 31);
        voffA[i] = (unsigned)(R * g.lda + C) * 2u; voffB[i] = (unsigned)(Rb * g.ldb + C) * 2u; }
    const size_t kstep = (size_t)(BK * 2);
    const size_t hstepA = (size_t)HALF * g.lda * 2, hstepB = (size_t)HALF * g.ldb * 2;
    const size_t tstepA = 2 * hstepA, tstepB = 2 * hstepB;
    const unsigned ldsw = (unsigned)wid * 1024u;
    const int aoff = lds_byte(wr * 64 + fr, fq * 8), boff = lds_byte(wc * 32 + fr, fq * 8);
#define PG8_SA(b, h) (((b) * 2 + (h)) * HTB)
#define PG8_SB(b, h) ((4 + (b) * 2 + (h)) * HTB)
#define PG8_STAGE(bufoff, gbase, voff) do { _Pragma("unroll") for (int _i = 0; _i < 2; ++_i) \
        __builtin_amdgcn_global_load_lds((const unsigned*)((const char*)(gbase) + (voff)[_i]), (LAS unsigned*)(lds + (bufoff) + ldsw + _i * 8192), 16, 0, 0); } while (0)
#define PG8_LDA(dst, b, h) do { _Pragma("unroll") for (int m = 0; m < 4; ++m) _Pragma("unroll") for (int k = 0; k < 2; ++k) dst[m][k] = *(const LAS bf16x8*)(lds + PG8_SA(b, h) + aoff + m * 2048 + k * 1024); } while (0)
#define PG8_LDB(dst, b, h) do { _Pragma("unroll") for (int n = 0; n < 2; ++n) _Pragma("unroll") for (int k = 0; k < 2; ++k) dst[n][k] = *(const LAS bf16x8*)(lds + PG8_SB(b, h) + boff + n * 2048 + k * 1024); } while (0)
#define PG8_MMA(ai, bj, At, Bt) do { __builtin_amdgcn_s_setprio(1); _Pragma("unroll") for (int m = 0; m < 4; ++m) _Pragma("unroll") for (int n = 0; n < 2; ++n) _Pragma("unroll") for (int k = 0; k < 2; ++k) \
        acc[ai][bj][m][n] = __builtin_amdgcn_mfma_f32_16x16x32_bf16(Bt[n][k], At[m][k], acc[ai][bj][m][n], 0, 0, 0); __builtin_amdgcn_s_setprio(0); } while (0)
#define PG8_WAIT_V(n) asm volatile("s_waitcnt vmcnt(" #n ")" ::: "memory")
#define PG8_WAIT_L(n) asm volatile("s_waitcnt lgkmcnt(" #n ")" ::: "memory")
#define PG8_BAR __builtin_amdgcn_s_barrier()
#define PG8_SCHED __builtin_amdgcn_sched_barrier(0)
    Unit cur, nxt; int ui = 0;
    if (!S.next(0, cur)) return;
    f32x4 acc[2][2][4][2];
#pragma unroll
    for (int a = 0; a < 2; ++a)
#pragma unroll
        for (int b = 0; b < 2; ++b)
#pragma unroll
            for (int m = 0; m < 4; ++m)
#pragma unroll
                for (int n = 0; n < 2; ++n) acc[a][b][m][n] = (f32x4){0.f, 0.f, 0.f, 0.f};
    bf16x8 At[4][2], B0[2][2], B1[2][2];
    const char* cA = (const char*)g.A + (size_t)cur.pm * tstepA + (size_t)cur.r * g.rsA * 2; const char* cB = (const char*)g.Bt + (size_t)cur.pn * tstepB + (size_t)cur.r * g.rsB * 2;
    PG8_STAGE(PG8_SB(0, 0), cB, voffB); PG8_STAGE(PG8_SB(0, 1), cB + hstepB, voffB); PG8_STAGE(PG8_SA(0, 0), cA, voffA); PG8_STAGE(PG8_SA(0, 1), cA + hstepA, voffA);
    if (wr == 1) PG8_BAR;
    PG8_WAIT_V(2); PG8_BAR;
    PG8_STAGE(PG8_SB(1, 0), cB + kstep, voffB); PG8_STAGE(PG8_SA(1, 0), cA + kstep, voffA); PG8_STAGE(PG8_SB(1, 1), cB + hstepB + kstep, voffB);
    PG8_WAIT_V(6); PG8_BAR;
    for (;;) {
        const bool has_next = S.next(ui + 1, nxt);
        const char* nA = has_next ? (const char*)g.A + (size_t)nxt.pm * tstepA + (size_t)nxt.r * g.rsA * 2 : cA; const char* nB = has_next ? (const char*)g.Bt + (size_t)nxt.pn * tstepB + (size_t)nxt.r * g.rsB * 2 : cB;
        for (int t = 0; t < nt; t += 2) {
            const bool last = (t == nt - 2);
            const char* a1 = cA + (size_t)(t + 1) * kstep;
            const char* a2 = last ? nA : cA + (size_t)(t + 2) * kstep; const char* b2 = last ? nB : cB + (size_t)(t + 2) * kstep;
            const char* a3 = a2 + kstep; const char* b3 = b2 + kstep;
            PG8_LDB(B0, 0, 0); PG8_LDB(B1, 0, 1); PG8_SCHED; PG8_LDA(At, 0, 0); PG8_STAGE(PG8_SA(1, 1), a1 + hstepA, voffA);
            PG8_WAIT_V(8); PG8_WAIT_L(0); PG8_BAR; PG8_MMA(0, 0, At, B0); PG8_MMA(0, 1, At, B1); PG8_BAR; PG8_SCHED;
            PG8_LDA(At, 0, 1); PG8_STAGE(PG8_SB(0, 0), b2, voffB); PG8_STAGE(PG8_SB(0, 1), b2 + hstepB, voffB); PG8_STAGE(PG8_SA(0, 0), a2, voffA);
            PG8_WAIT_V(8); PG8_WAIT_L(0); PG8_BAR; PG8_MMA(1, 0, At, B0); PG8_MMA(1, 1, At, B1); PG8_BAR; PG8_SCHED;
            PG8_LDB(B0, 1, 0); PG8_LDB(B1, 1, 1); PG8_SCHED; PG8_LDA(At, 1, 0); PG8_STAGE(PG8_SA(0, 1), a2 + hstepA, voffA);
            PG8_WAIT_V(8); PG8_WAIT_L(0); PG8_BAR; PG8_MMA(0, 0, At, B0); PG8_MMA(0, 1, At, B1); PG8_BAR; PG8_SCHED;
            PG8_LDA(At, 1, 1); PG8_STAGE(PG8_SB(1, 0), b3, voffB); PG8_STAGE(PG8_SB(1, 1), b3 + hstepB, voffB); PG8_STAGE(PG8_SA(1, 0), a3, voffA);
            PG8_WAIT_V(8); PG8_WAIT_L(0); PG8_BAR; PG8_MMA(1, 0, At, B0); PG8_MMA(1, 1, At, B1); PG8_BAR; PG8_SCHED;
        }
        if (wr == 0) PG8_BAR;
        E(acc, cur, wr, wc, fr, fq);
        if (!has_next) break;
#pragma unroll
        for (int a = 0; a < 2; ++a)
#pragma unroll
            for (int b = 0; b < 2; ++b)
#pragma unroll
                for (int m = 0; m < 4; ++m)
#pragma unroll
                    for (int n = 0; n < 2; ++n) acc[a][b][m][n] = (f32x4){0.f, 0.f, 0.f, 0.f};
        cur = nxt; cA = nA; cB = nB; ++ui;
        if (wr == 1) PG8_BAR;
    }
    PG8_WAIT_V(0);
    PG8_BAR;
#undef PG8_SA
#undef PG8_SB
#undef PG8_STAGE
#undef PG8_LDA
#undef PG8_LDB
#undef PG8_MMA
#undef PG8_WAIT_V
#undef PG8_WAIT_L
#undef PG8_BAR
#undef PG8_SCHED
}
}
__device__ __forceinline__ void st_bf16x8(bf16_t* p, f32x4 v0, f32x4 v1) { u32x4 w; w.x = cvt_pk(v0[0], v0[1]); w.y = cvt_pk(v0[2], v0[3]); w.z = cvt_pk(v1[0], v1[1]); w.w = cvt_pk(v1[2], v1[3]); *(u32x4*)p = w; }
struct NoAux {};
struct ColBias { f32x4 b0, b1; };
struct FZ1 { bf16_t* z1; float* misc; const float* b1; typedef ColBias Pre; typedef NoAux Aux;
    __device__ __forceinline__ void pre(int, int, int col, Pre& p) const { p.b0 = *(const f32x4*)(b1 + col); p.b1 = *(const f32x4*)(b1 + col + 4); }
    __device__ __forceinline__ void ld(int, int, int, Aux&) const {}
    __device__ __forceinline__ void st(int, int row, int col, f32x4 v0, f32x4 v1, const Pre& p, const Aux&) const {
        v0 += p.b0; v1 += p.b1;
        if (col < LDZ) st_bf16x8(z1 + (size_t)row * LDZ + col, v0, v1);
        else { const int c = col - LDZ; if (c < NMISC) { float* q = misc + (size_t)row * NMISC + c; *(f32x4*)q = v0; *(f32x4*)(q + 4) = v1; } }
    } };
struct RowB { float b; };
struct FRowBias { bf16_t* o; int ld_; const float* bias; typedef NoAux Pre; typedef RowB Aux;
    __device__ __forceinline__ void pre(int, int, int, Pre&) const {}
    __device__ __forceinline__ void ld(int, int row, int, Aux& x) const { x.b = bias ? bias[row] : 0.f; }
    __device__ __forceinline__ void st(int, int row, int col, f32x4 v0, f32x4 v1, const Pre&, const Aux& x) const { v0 += x.b; v1 += x.b; st_bf16x8(o + (size_t)row * ld_ + col, v0, v1); } };
struct FGate { bf16_t* o; const float* bg; typedef ColBias Pre; typedef NoAux Aux;
    __device__ __forceinline__ void pre(int, int, int col, Pre& p) const { p.b0 = *(const f32x4*)(bg + col); p.b1 = *(const f32x4*)(bg + col + 4); }
    __device__ __forceinline__ void ld(int, int, int, Aux&) const {}
    __device__ __forceinline__ void st(int, int row, int col, f32x4 v0, f32x4 v1, const Pre& p, const Aux&) const {
        v0 += p.b0; v1 += p.b1;
#pragma unroll
        for (int i = 0; i < 4; ++i) { v0[i] = sigmoidf_(v0[i]); v1[i] = sigmoidf_(v1[i]); }
        st_bf16x8(o + (size_t)row * 6144 + col, v0, v1);
    } };
struct FPlain { bf16_t* o; int ld_; typedef NoAux Pre; typedef NoAux Aux;
    __device__ __forceinline__ void pre(int, int, int, Pre&) const {}
    __device__ __forceinline__ void ld(int, int, int, Aux&) const {}
    __device__ __forceinline__ void st(int, int row, int col, f32x4 v0, f32x4 v1, const Pre&, const Aux&) const { st_bf16x8(o + (size_t)row * ld_ + col, v0, v1); } };
struct FKn { bf16_t* o; typedef NoAux Pre; typedef NoAux Aux;
    __device__ __forceinline__ void pre(int, int, int, Pre&) const {}
    __device__ __forceinline__ void ld(int, int, int, Aux&) const {}
    __device__ __forceinline__ void st(int, int row, int col, f32x4 v0, f32x4 v1, const Pre&, const Aux&) const { const int h = col >> 7, d = col & 127; st_bf16x8(o + (size_t)row * 1536 + h * 192 + d, v0, v1); } };
struct Vec8 { bf16x8 v; };
struct FGlu { bf16_t* o; const bf16_t* g; const float* bias; typedef ColBias Pre; typedef Vec8 Aux;
    __device__ __forceinline__ void pre(int, int, int col, Pre& p) const { p.b0 = *(const f32x4*)(bias + col); p.b1 = *(const f32x4*)(bias + col + 4); }
    __device__ __forceinline__ void ld(int, int row, int col, Aux& x) const { x.v = ldg8(g + (size_t)row * 1024 + col); }
    __device__ __forceinline__ void st(int, int row, int col, f32x4 v0, f32x4 v1, const Pre& p, const Aux& x) const {
        float gv[8]; unpack8(x.v, gv);
        v0 += p.b0; v1 += p.b1;
#pragma unroll
        for (int i = 0; i < 4; ++i) { v0[i] = gv[i] * sigmoidf_(v0[i]); v1[i] = gv[4 + i] * sigmoidf_(v1[i]); }
        st_bf16x8(o + (size_t)row * 1024 + col, v0, v1);
    } };
struct Vec8x2 { bf16x8 g, p; };
struct FMerge { bf16_t* o; const bf16_t* gates; typedef NoAux Pre; typedef Vec8x2 Aux;
    __device__ __forceinline__ void pre(int, int, int, Pre&) const {}
    __device__ __forceinline__ void ld(int r, int row, int col, Aux& x) const { x.g = ldg8(gates + (size_t)row * 6144 + r * 2048 + col); if (r > 0) x.p = ldg8(o + (size_t)row * DM + col); }
    __device__ __forceinline__ void st(int r, int row, int col, f32x4 v0, f32x4 v1, const Pre&, const Aux& x) const {
        float gv[8]; unpack8(x.g, gv);
#pragma unroll
        for (int i = 0; i < 4; ++i) { v0[i] *= gv[i]; v1[i] *= gv[4 + i]; }
        if (r > 0) { float pv[8]; unpack8(x.p, pv);
#pragma unroll
            for (int i = 0; i < 4; ++i) { v0[i] += pv[i]; v1[i] += pv[4 + i]; } }
        st_bf16x8(o + (size_t)row * DM + col, v0, v1);
    } };
struct X8 { f32x4 x0, x1; };
struct FResid { const float* xin_l; const float* xin_c; float* xout_l; float* xout_c; const float* modl; int gi; typedef ColBias Pre; typedef X8 Aux;
    __device__ __forceinline__ void pre(int, int row0, int col, Pre& p) const { const int mr = row0 < NLAT ? (row0 >> 12) : 4; const float* gp = modl + (size_t)mr * 12288 + gi * DM + col; p.b0 = *(const f32x4*)gp; p.b1 = *(const f32x4*)(gp + 4); }
    __device__ __forceinline__ void ld(int, int row, int col, Aux& x) const { const float* xi = row < NLAT ? xin_l + (size_t)row * DM : xin_c + (size_t)(row - NLAT) * DM; x.x0 = *(const f32x4*)(xi + col); x.x1 = *(const f32x4*)(xi + col + 4); }
    __device__ __forceinline__ void st(int, int row, int col, f32x4 v0, f32x4 v1, const Pre& p, const Aux& x) const {
        float* xo = row < NLAT ? xout_l + (size_t)row * DM : xout_c + (size_t)(row - NLAT) * DM;
        *(f32x4*)(xo + col) = x.x0 + p.b0 * v0; *(f32x4*)(xo + col + 4) = x.x1 + p.b1 * v1;
    } };
struct FFF1 { bf16_t* o; typedef NoAux Pre; typedef NoAux Aux;
    __device__ __forceinline__ void pre(int, int, int, Pre&) const {}
    __device__ __forceinline__ void ld(int, int, int, Aux&) const {}
    __device__ __forceinline__ void st(int, int row, int col, f32x4 v0, f32x4 v1, const Pre&, const Aux&) const {
#pragma unroll
        for (int i = 0; i < 4; ++i) { const float a = fmaxf(v0[i], 0.f), b = fmaxf(v1[i], 0.f); v0[i] = a * a; v1[i] = b * b; }
        st_bf16x8(o + (size_t)row * DFF + col, v0, v1);
    } };

struct Args { GAS const float* in[31]; GAS float* out; GAS unsigned char* ws; int ph_lo, ph_hi, sub, bar_region; };
enum { I_X = 0, I_C, I_CTX, I_CCTX, I_WMOD, I_BMOD, I_NORMG, I_WIN, I_BIN, I_MLGB, I_MLNG, I_QAG, I_KVAG, I_WUQ, I_WUKV, I_QNG, I_KNG,
       I_ARE, I_AIM, I_LOGDT, I_BRE, I_BIM, I_CRE, I_CIM, I_S5D, I_WGLU, I_BGLU, I_WBR, I_WOUT, I_FF1, I_FF2 };

__device__ __forceinline__ int seq_row(int b, int pos) { return pos < CTXL ? NLAT + b * CTXL + pos : b * SEQ + (pos - CTXL); }

__device__ __forceinline__ void tr_item(const float* W, int ld, int K, int nblk, bf16_t* WT, int mode, float* scr, int item, int lane) {
    const int kb = item / nblk, nb = item % nblk, k0 = 64 * kb, n0 = 32 * nb;
    float tv[32];
#pragma unroll
    for (int i = 0; i < 32; ++i) { const int kk = 2 * i + (lane >> 5); tv[i] = W[(size_t)(k0 + kk) * ld + n0 + (lane & 31)]; }
    __builtin_amdgcn_sched_barrier(0);
#pragma unroll
    for (int i = 0; i < 32; ++i) { const int kk = 2 * i + (lane >> 5); scr[kk * 33 + (lane & 31)] = tv[i]; }
    asm volatile("s_waitcnt lgkmcnt(0)" ::: "memory");
    const int c = lane & 7;
    int drow0 = n0;
    if (mode == 1) { const int h = n0 >> 8, w = n0 & 255; drow0 = (w < 128) ? (h * 128 + w) : (1024 + h * 128 + (w - 128)); }
    float tt[4][8];
#pragma unroll
    for (int j = 0; j < 4; ++j) { const int n = (lane >> 3) + 8 * j; const float* s = scr + (8 * c) * 33 + n;
#pragma unroll
        for (int e = 0; e < 8; ++e) tt[j][e] = s[e * 33]; }
    __builtin_amdgcn_sched_barrier(0);
#pragma unroll
    for (int j = 0; j < 4; ++j) { const int n = (lane >> 3) + 8 * j;
        u32x4 o; o.x = cvt_pk(tt[j][0], tt[j][1]); o.y = cvt_pk(tt[j][2], tt[j][3]); o.z = cvt_pk(tt[j][4], tt[j][5]); o.w = cvt_pk(tt[j][6], tt[j][7]);
        *(u32x4*)(WT + (size_t)(drow0 + n) * K + k0 + 8 * c) = o; }
    asm volatile("s_waitcnt lgkmcnt(0)" ::: "memory");
}
#define TR_JOB(Wp, ld, K, ncols, WTp, mode) do { const int _nblk = (ncols) / 32, _nit = ((K) / 64) * _nblk; \
    for (int it = gw; it < _nit; it += NGW) tr_item((Wp), (ld), (K), _nblk, (WTp), (mode), scr, it, lane); } while (0)

__device__ __forceinline__ void norm_mod_rows(const float* xl, const float* xc, const float* ng, const float* modl, int si, bf16_t* out, int nrows, int gw, int NGW, int lane) {
    for (int row = gw; row < nrows; row += NGW) {
        const float* xr; int mr;
        if (row < NLAT) { xr = xl + (size_t)row * DM; mr = row >> 12; } else { xr = xc + (size_t)(row - NLAT) * DM; mr = 4; }
        f32x4 v[8]; float s = 0.f;
#pragma unroll
        for (int j = 0; j < 8; ++j) { v[j] = *(const f32x4*)(xr + 256 * j + 4 * lane); s += v[j][0] * v[j][0] + v[j][1] * v[j][1] + v[j][2] * v[j][2] + v[j][3] * v[j][3]; }
        const float rs = rsqrtf(wave_sum(s) * (1.f / DM) + EPS);
        const float* sh = modl + (size_t)mr * 12288 + si * DM; const float* sc = sh + DM;
#pragma unroll
        for (int jh = 0; jh < 8; jh += 4) {
            f32x4 g4[4], a4[4], b4[4];
#pragma unroll
            for (int j = 0; j < 4; ++j) { const int c = 256 * (jh + j) + 4 * lane; g4[j] = *(const f32x4*)(ng + c); a4[j] = *(const f32x4*)(sh + c); b4[j] = *(const f32x4*)(sc + c); }
            __builtin_amdgcn_sched_barrier(0);
#pragma unroll
            for (int j = 0; j < 4; ++j) { const int c = 256 * (jh + j) + 4 * lane; f32x4 y;
#pragma unroll
                for (int e = 0; e < 4; ++e) y[e] = v[jh + j][e] * rs * g4[j][e] * (1.f + b4[j][e]) + a4[j][e];
                u32x2 w; w.x = cvt_pk(y[0], y[1]); w.y = cvt_pk(y[2], y[3]); *(u32x2*)(out + (size_t)row * DM + c) = w; }
        }
    }
}
__device__ __forceinline__ void phase0(const Args& a, unsigned char* ws, float* sm, int tid) {
    const int w = tid >> 6, lane = tid & 63;
    float* sl = sm;
    float* red = sm + 5 * 2048;
    for (int i = tid; i < 5 * 2048; i += 512) { const float c = i < 4 * 2048 ? gin(a.in[lidx(I_C)])[i] : gin(a.in[lidx(I_CCTX)])[i - 4 * 2048]; sl[i] = c * sigmoidf_(c); }
    __syncthreads();
    float* mod = (float*)(ws + O_MOD);
    for (int u = vbid(); u < 384; u += lidx((int)gridDim.x)) {
        const int l = u / 192, j = (u % 192) * 64 + lane;
        const float* W = gin(a.in[lidx(I_WMOD)]) + (size_t)l * DM * 12288 + j;
        float acc[5] = {0.f, 0.f, 0.f, 0.f, 0.f};
#pragma unroll 1
        for (int k0 = w * 256; k0 < w * 256 + 256; k0 += 16) { float wv[16];
#pragma unroll
            for (int i = 0; i < 16; ++i) wv[i] = W[(size_t)(k0 + i) * 12288];
            __builtin_amdgcn_sched_barrier(0);
#pragma unroll
            for (int i = 0; i < 16; ++i)
#pragma unroll
                for (int r = 0; r < 5; ++r) acc[r] += sl[r * 2048 + k0 + i] * wv[i]; }
#pragma unroll
        for (int r = 0; r < 5; ++r) red[(w * 5 + r) * 64 + lane] = acc[r];
        __syncthreads();
        if (tid < 320) { const int r = tid >> 6; float s = 0.f;
#pragma unroll
            for (int ww = 0; ww < 8; ++ww) s += red[(ww * 5 + r) * 64 + lane];
            mod[(size_t)(l * 5 + r) * 12288 + j] = s + gin(a.in[lidx(I_BMOD)])[l * 12288 + j]; }
        __syncthreads();
    }
    { f32x2* rope = (f32x2*)(ws + O_ROPE); const int gt0 = lidx((int)blockIdx.x) * 512 + tid;
      if (gt0 < 1024) { const int f = gt0 & 15, pos = gt0 >> 4; float sn, cs; sincosf((float)pos * exp2f(-(float)f * (13.287712379549449f / 16.f)), &sn, &cs); rope[gt0] = (f32x2){cs, sn}; } }
    f32x2* lamp = (f32x2*)(ws + O_LAMP); f32x2* bbar = (f32x2*)(ws + O_BBAR);
    const int gt = lidx((int)blockIdx.x) * 512 + tid, gs = lidx((int)gridDim.x) * 512;
    for (int idx = gt; idx < 2 * 64 * 2 * 65 * 64; idx += gs) {
        const int n = idx & 63, p = (idx >> 6) % 65, rest = idx / (64 * 65), dir = rest & 1, g = (rest >> 1) & 63, l = rest >> 7;
        const int si = ((l * 2 + dir) * 64 + g) * 64 + n;
        const float re = fminf(gin(a.in[lidx(I_ARE)])[si], -1e-4f), im = gin(a.in[lidx(I_AIM)])[si], dt = expf(gin(a.in[lidx(I_LOGDT)])[(l * 2 + dir) * 64 + g]);
        const float mag = expf((float)p * (re * dt)); float s, c; sincosf((float)p * (im * dt), &s, &c);
        lamp[idx] = (f32x2){mag * c, mag * s};
    }
    for (int idx = gt; idx < 2 * 64 * 2 * 64 * 16; idx += gs) {
        const int ci = idx & 15, n = (idx >> 4) & 63, dir = (idx >> 10) & 1, g = (idx >> 11) & 63, l = idx >> 17;
        const int si = ((l * 2 + dir) * 64 + g) * 64 + n;
        const float re = fminf(gin(a.in[lidx(I_ARE)])[si], -1e-4f), im = gin(a.in[lidx(I_AIM)])[si], dt = expf(gin(a.in[lidx(I_LOGDT)])[(l * 2 + dir) * 64 + g]);
        const float mag = expf(re * dt); float s, c; sincosf(im * dt, &s, &c);
        const float nr = mag * c - 1.f, ni = mag * s, d = re * re + im * im;
        const float qr = (nr * re + ni * im) / d, qi = (ni * re - nr * im) / d;
        const float br = gin(a.in[lidx(I_BRE)])[(size_t)si * 16 + ci], bi = gin(a.in[lidx(I_BIM)])[(size_t)si * 16 + ci];
        bbar[idx] = (f32x2){qr * br - qi * bi, qr * bi + qi * br};
    }
}

__device__ __forceinline__ void phaseA(const Args& a, unsigned char* ws, unsigned char* smraw, int l, const float* xl, const float* xc, int tid, int mode, int boff, int nb) {
    const int wave = tid >> 6, lane = tid & 63;
    const int vb_ = lidx((int)blockIdx.x) - boff;
    const int gw = vb_ * 8 + wave, NGW = nb * 8;
    float* scr = (float*)(smraw + wave * 16384);
    const float* win = gin(a.in[lidx(I_WIN)]) + (size_t)l * DM * DIN;
    bf16_t* Wz1 = (bf16_t*)(ws + O_WZ1); bf16_t* Wkv = (bf16_t*)(ws + O_WKV);
    {
        constexpr int NJ = 17;
        constexpr int cum[NJ + 1] = {0, 512, 1024, 2048, 3072, 4096, 4160, 5696, 11840, 12224, 12736, 13248, 14272, 15296, 16320, 18368, 26560, 34752};
        const int it_lo = 0, it_hi = mode == 2 ? 0 : cum[NJ];
        for (int it = it_lo + gw; it < it_hi; it += NGW) {
            int j = 0;
#pragma unroll
            for (int k = 1; k < NJ; ++k) j += (it >= cum[k]) ? 1 : 0;
            int base = 0;
#pragma unroll
            for (int k = 1; k < NJ; ++k) base = (j == k) ? cum[k] : base;
            const float* W; int ld, K, ncols, mode = 0; bf16_t* WT;
            if (j < 8) { ld = DIN; K = DM;
                const int so[8] = {0, 512, 2048, 3088, 4176, 4112, 512, 5200}; const int nc[8] = {512, 512, 1024, 1024, 1024, 64, 1536, 6144}; const int dr[6] = {0, 512, 1024, 2048, 3072, 4096};
                int sof = 0, ncl = 0, dro = 0;
#pragma unroll
                for (int k = 0; k < 8; ++k) { sof = (j == k) ? so[k] : sof; ncl = (j == k) ? nc[k] : ncl; }
#pragma unroll
                for (int k = 0; k < 6; ++k) dro = (j == k) ? dr[k] : dro;
                W = win + sof; ncols = ncl; WT = j < 6 ? Wz1 + (size_t)dro * DM : (j == 6 ? Wkv : (bf16_t*)(ws + O_WG)); }
            else if (j == 8) { W = gin(a.in[lidx(I_WUQ)]) + (size_t)l * 512 * 1536; ld = 1536; K = 512; ncols = 1536; WT = (bf16_t*)(ws + O_WUQ); }
            else if (j == 9) { W = gin(a.in[lidx(I_WUKV)]) + (size_t)l * 512 * 2048; ld = 2048; K = 512; ncols = 2048; WT = (bf16_t*)(ws + O_WUKVK); mode = 1; }
            else if (j == 10) { W = gin(a.in[lidx(I_WGLU)]) + (size_t)l * 1024 * 1024; ld = 1024; K = 1024; ncols = 1024; WT = (bf16_t*)(ws + O_WGLU); }
            else if (j < 14) { const int r = j - 11; W = gin(a.in[lidx(I_WBR)]) + ((size_t)l * 3 + r) * 1024 * 2048; ld = 2048; K = 1024; ncols = 2048; WT = (bf16_t*)(ws + O_WBR) + (size_t)r * 2048 * 1024; }
            else if (j == 14) { W = gin(a.in[lidx(I_WOUT)]) + (size_t)l * DM * DM; ld = DM; K = DM; ncols = DM; WT = (bf16_t*)(ws + O_WOUT); }
            else if (j == 15) { W = gin(a.in[lidx(I_FF1)]) + (size_t)l * DM * DFF; ld = DFF; K = DM; ncols = DFF; WT = (bf16_t*)(ws + O_W1); }
            else { W = gin(a.in[lidx(I_FF2)]) + (size_t)l * DFF * DM; ld = DM; K = DFF; ncols = DM; WT = (bf16_t*)(ws + (l == 0 ? O_W2 : O_W2B)); }
            tr_item(W, ld, K, ncols / 32, WT, mode, scr, it - base, lane);
        }
    }
    const int gt = vb_ * 512 + tid, gs = nb * 512;
    if (mode != 2) {
    for (int idx = gt; idx < 192 * DM; idx += gs) { const int r = idx / DM, k = idx % DM;
        const float v = r < 16 ? win[(size_t)k * DIN + 3072 + r] : 0.f; Wz1[(size_t)(4160 + r) * DM + k] = (bf16_t)(cvt_pk(v, 0.f) & 0xffffu); }
    { float* b1 = (float*)(ws + O_BIAS); float* bkv = b1 + 4352; float* bg = bkv + 1536; const float* bin = gin(a.in[lidx(I_BIN)]) + (size_t)l * DIN;
      for (int i = gt; i < 4352; i += gs) { int src = -1;
          if (i < 1024) src = i; else if (i < 2048) src = 2048 + (i - 1024); else if (i < 3072) src = 3088 + (i - 2048); else if (i < 4096) src = 4176 + (i - 3072);
          else if (i < 4160) src = 4112 + (i - 4096); else if (i < 4176) src = 3072 + (i - 4160);
          b1[i] = src >= 0 ? bin[src] : 0.f; }
      for (int i = gt; i < 1536; i += gs) bkv[i] = bin[512 + i];
      for (int i = gt; i < 6144; i += gs) bg[i] = bin[5200 + i]; }
    const f32x2* lamp = (const f32x2*)(ws + O_LAMP) + (size_t)l * 64 * 2 * 65 * 64; const f32x2* bbar = (const f32x2*)(ws + O_BBAR) + (size_t)l * 64 * 2 * 64 * 16;
    bf16_t* T1 = (bf16_t*)(ws + O_T1); bf16_t* T2 = (bf16_t*)(ws + O_T2); bf16_t* KC = (bf16_t*)(ws + O_KC);
    for (int idx = gt; idx < 64 * 16 * 32 * 64; idx += gs) {
        const int ln = idx & 63, ks = (idx >> 6) & 31, rbk = (idx >> 11) & 15, g = idx >> 15;
        const int row = rbk * 16 + (ln & 15), k0 = 32 * ks + 8 * (ln >> 4);
        const int dir = row >> 7, n = (row >> 1) & 63, reim = row & 1, j = k0 >> 4, ci0 = k0 & 15;
        const int p = dir ? j : 63 - j;
        const f32x2 lp = lamp[((g * 2 + dir) * 65 + p) * 64 + n];
        const f32x2* bb = bbar + ((size_t)(g * 2 + dir) * 64 + n) * 16 + ci0;
        float v[8];
#pragma unroll
        for (int e = 0; e < 8; ++e) { const f32x2 b = bb[e]; v[e] = reim ? (lp.x * b.y + lp.y * b.x) : (lp.x * b.x - lp.y * b.y); }
        *(bf16x8*)(T1 + (size_t)g * 256 * 1024 + (size_t)idx % (16 * 32 * 64) * 8) = pack8(v);
    }
    for (int idx = gt; idx < 64 * 64 * 16 * 2 * 16; idx += gs) {
        const int co = idx & 15, q_ = (idx >> 4) & 3, ksl = (idx >> 6) & 3, dir = (idx >> 8) & 1, t = (idx >> 9) & 63, g = idx >> 15, nq = ksl * 4 + q_;
        const int p = dir ? 64 - t : t + 1, n0 = 4 * nq;
        const f32x4 cr = *(const f32x4*)(gin(a.in[lidx(I_CRE)]) + ((size_t)((l * 2 + dir) * 64 + g) * 16 + co) * 64 + n0), ci4 = *(const f32x4*)(gin(a.in[lidx(I_CIM)]) + ((size_t)((l * 2 + dir) * 64 + g) * 16 + co) * 64 + n0);
        const f32x2* lpp = lamp + ((g * 2 + dir) * 65 + p) * 64 + n0;
        float v[8];
#pragma unroll
        for (int e = 0; e < 4; ++e) { const f32x2 lp = lpp[e]; v[2 * e] = cr[e] * lp.x - ci4[e] * lp.y; v[2 * e + 1] = -(cr[e] * lp.y + ci4[e] * lp.x); }
        *(bf16x8*)(T2 + (size_t)g * 1024 * 256 + (size_t)((t * 8 + dir * 4 + (nq >> 2)) * 64 + (nq & 3) * 16 + co) * 8) = pack8(v);
    }
    { f32x2* lps = (f32x2*)smraw; float* ex = (float*)(smraw + 2 * 32 * 64 * 8);
      for (int u = vb_; u < 128; u += nb) {
        const int g = u >> 1, ph = u & 1;
        __syncthreads();
        for (int i = tid; i < 2 * 32 * 64; i += 512) { const int n = i & 63, pp = (i >> 6) & 31, dir = i >> 11; lps[i] = lamp[((g * 2 + dir) * 65 + 32 * ph + pp) * 64 + n]; }
        __syncthreads();
        const int pair = tid & 255, co = pair >> 4, ci = pair & 15, dir = tid >> 8;
        const float* cre = gin(a.in[lidx(I_CRE)]) + ((size_t)((l * 2 + dir) * 64 + g) * 16 + co) * 64; const float* cim = gin(a.in[lidx(I_CIM)]) + ((size_t)((l * 2 + dir) * 64 + g) * 16 + co) * 64;
        const f32x2* bb = bbar + ((size_t)(g * 2 + dir) * 64) * 16 + ci;
        float acc[32];
#pragma unroll
        for (int pp = 0; pp < 32; ++pp) acc[pp] = 0.f;
        for (int n = 0; n < 64; ++n) {
            const f32x2 b = bb[n * 16]; const float cr = cre[n], cm = cim[n];
            const float xr = cr * b.x - cm * b.y, xi = cr * b.y + cm * b.x;
            const f32x2* lq = lps + dir * 2048 + n;
            f32x2 lpv[32];
#pragma unroll
            for (int pp = 0; pp < 32; ++pp) lpv[pp] = lq[pp * 64];
            __builtin_amdgcn_sched_barrier(0);
#pragma unroll
            for (int pp = 0; pp < 32; ++pp) acc[pp] += xr * lpv[pp].x - xi * lpv[pp].y;
            __builtin_amdgcn_sched_barrier(0);
        }
        if (ph == 0 && dir == 1) ex[pair] = acc[0];
        __syncthreads();
        bf16_t* kc = KC + (size_t)g * 128 * 256 + pair;
#pragma unroll
        for (int pp = 0; pp < 32; ++pp) {
            const int p = 32 * ph + pp;
            if (p == 0) { if (dir == 0) { const float v = acc[0] + ex[pair] + (co == ci ? gin(a.in[lidx(I_S5D)])[l * 1024 + g * 16 + co] : 0.f); kc[63 * 256] = (bf16_t)(cvt_pk(v, 0.f) & 0xffffu); kc[127 * 256] = 0; } }
            else kc[(dir == 0 ? 63 + p : 63 - p) * 256] = (bf16_t)(cvt_pk(acc[pp], 0.f) & 0xffffu);
        }
      }
      __syncthreads(); }
    }
    if (mode != 1) {
    norm_mod_rows(xl, xc, gin(a.in[lidx(I_NORMG)]) + (size_t)(l * 2 + 0) * DM, (const float*)(ws + O_MOD) + (size_t)l * 5 * 12288, 0, (bf16_t*)(ws + O_HX), MROWS, gw, NGW, lane);
    }
}

__device__ __forceinline__ void mla_norm(const Args& a, unsigned char* ws, int l, int gw, int NGW, int lane) {
    bf16_t* z1 = (bf16_t*)(ws + O_Z1);
    for (int it = gw; it < MROWS * 2; it += NGW) {
        const int row = it >> 1, which = it & 1;
        bf16_t* p = z1 + (size_t)row * LDZ + (which ? ZKVA : ZQA) + lane * 8;
        float v[8]; unpack8(*(const bf16x8*)p, v);
        float s = 0.f;
#pragma unroll
        for (int e = 0; e < 8; ++e) s += v[e] * v[e];
        const float rs = rsqrtf(wave_sum(s) * (1.f / 512.f) + EPS);
        const float* g = (which ? gin(a.in[lidx(I_KVAG)]) : gin(a.in[lidx(I_QAG)])) + l * 512 + lane * 8;
#pragma unroll
        for (int e = 0; e < 8; ++e) v[e] = v[e] * rs * g[e];
        *(bf16x8*)p = pack8(v);
    }
}
__device__ __forceinline__ float logsigmoidf_(float x) { return fminf(x, 0.f) - log1pf(__expf(-fabsf(x))); }
__device__ __forceinline__ float scan_add_incl(float v, int lane) {
#pragma unroll
    for (int o = 1; o < 64; o <<= 1) { const float t = __shfl_up(v, o); if (lane >= o) v += t; }
    return v;
}
__device__ __forceinline__ float scan_max_incl(float v, int lane) {
#pragma unroll
    for (int o = 1; o < 64; o <<= 1) { const float t = __shfl_up(v, o); if (lane >= o) v = fmaxf(v, t); }
    return v;
}
__device__ __forceinline__ void ml_state_pass(const Args& a, unsigned char* ws, float* sm, int l, int tid) {
    const int w = tid >> 6, lane = tid & 63, cidx = lane & 15, q = lane >> 4;
    const float* misc = (const float*)(ws + O_MISC); const bf16_t* KVt = (const bf16_t*)(ws + O_KVT);
    bf16_t* Cst = (bf16_t*)(ws + O_BR + BRSZ); float* MLG = (float*)(ws + O_MLG); float* MLN = (float*)(ws + O_MLN); float* MLM = (float*)(ws + O_MLM);
    float* wsh = sm + w * 128;
    constexpr int SP = 136, BUFB = (128 + 32) * SP * 2 + 1024;
    unsigned char* sbase = (unsigned char*)sm + 4096;
#define MLS_ROW0(ci_) ({ const int _oc = dir == 0 ? (ci_) : ((ci_) < 2 ? 1 - (ci_) : 35 - (ci_)); _oc < 2 ? NLAT + b * CTXL + _oc * MLCH : b * SEQ + (_oc - 2) * MLCH; })
#define MLS_LOAD(ci_) do { const int _r0 = MLS_ROW0(ci_); \
        _Pragma("unroll") for (int k = 0; k < 4; ++k) { const int c = tid + 512 * k, r = c >> 4, cc = c & 15; kreg[k] = *(const u32x4*)(KVt + (size_t)(h * 128 + r) * MROWS + _r0 + cc * 8); } \
        { const int r = tid >> 4, cc = tid & 15; vreg = *(const u32x4*)(KVt + (size_t)(512 + h * 256 + slice * 32 + r) * MROWS + _r0 + cc * 8); } \
        greg = 0.f; if (tid < 256) greg = misc[(size_t)(_r0 + (tid & 127)) * NMISC + 64 + (dir * 2 + (tid >> 7)) * 4 + h]; } while (0)
#define MLS_STORE(buf_) do { unsigned char* _b = sbase + (buf_) * BUFB; \
        _Pragma("unroll") for (int k = 0; k < 4; ++k) { const int c = tid + 512 * k, r = c >> 4, cc = c & 15; *(u32x4*)(_b + (r * SP + cc * 8) * 2) = kreg[k]; } \
        { const int r = tid >> 4, cc = tid & 15; *(u32x4*)(_b + ((128 + r) * SP + cc * 8) * 2) = vreg; } \
        if (tid < 256) ((float*)(_b + 160 * SP * 2))[tid] = greg; } while (0)
    for (int u = vbid(); u < 256; u += lidx((int)gridDim.x)) {
        const int chain = u >> 3, slice = u & 7, dir = chain & 1, h = (chain >> 1) & 3, b = chain >> 3;
        const float bi = gin(a.in[lidx(I_MLGB)])[l * 16 + (dir * 2 + 0) * 4 + h], bf = gin(a.in[lidx(I_MLGB)])[l * 16 + (dir * 2 + 1) * 4 + h];
        const int i0 = 2 * lane, j0 = dir ? 127 - i0 : i0, j1 = dir ? 126 - i0 : i0 + 1;
        f32x4 acc[2] = {(f32x4){0.f, 0.f, 0.f, 0.f}, (f32x4){0.f, 0.f, 0.f, 0.f}};
        float nv = 0.f, m = 0.f;
        u32x4 kreg[4], vreg; float greg;
        __syncthreads();
        MLS_LOAD(0); __builtin_amdgcn_sched_barrier(0); MLS_STORE(0); __syncthreads();
#pragma unroll 1
        for (int ci = 0; ci < MLNC; ++ci) {
            const int row0 = MLS_ROW0(ci);
            if (ci + 1 < MLNC) MLS_LOAD(ci + 1);
            __builtin_amdgcn_sched_barrier(0);
            const unsigned char* cb_ = sbase + (ci & 1) * BUFB;
            const bf16_t* Ksh = (const bf16_t*)cb_; const bf16_t* Vsh = Ksh + 128 * SP; const float* gs = (const float*)(cb_ + 160 * SP * 2);
            const float li0 = gs[j0] + bi, li1 = gs[j1] + bi;
            const float lf0 = logsigmoidf_(gs[128 + j0] + bf), lf1 = logsigmoidf_(gs[128 + j1] + bf);
            const float S = scan_add_incl(lf0 + lf1, lane);
            const float G1 = S, G0 = S - lf1, a0 = li0 - G0, a1 = li1 - G1;
            const float pmx = scan_max_incl(fmaxf(a0, a1), lane);
            float prev = __shfl_up(pmx, 1); if (lane == 0) prev = -1e30f;
            const float pm0 = fmaxf(prev, a0), pm1 = pmx;
            const float Ftot = __shfl(S, 63), Ac = __shfl(pmx, 63);
            const float Mx = fmaxf(m, Ac), decay = __expf(m - Mx);
            asm volatile("s_waitcnt lgkmcnt(0)" ::: "memory");
            wsh[j0] = __expf(a0 - Mx); wsh[j1] = __expf(a1 - Mx);
            if (slice == 0 && w == 0) { const size_t o = (size_t)(dir * 4 + h) * MROWS + row0;
                MLG[o + j0] = G0; MLG[o + j1] = G1; MLG[(size_t)8 * MROWS + o + j0] = a0; MLG[(size_t)8 * MROWS + o + j1] = a1; MLG[(size_t)16 * MROWS + o + j0] = pm0; MLG[(size_t)16 * MROWS + o + j1] = pm1;
                if (lane == 0) MLM[chain * MLNC + ci] = m; }
            if (slice == 0 && q == 0) MLN[((size_t)chain * MLNC + ci) * 128 + 16 * w + cidx] = nv;
#pragma unroll
            for (int i = 0; i < 2; ++i)
#pragma unroll
                for (int r = 0; r < 4; ++r) Cst[(((size_t)chain * MLNC + ci) * 256 + slice * 32 + 16 * i + 4 * q + r) * 128 + 16 * w + cidx] = (bf16_t)(cvt_pk(acc[i][r], 0.f) & 0xffffu);
            asm volatile("s_waitcnt lgkmcnt(0)" ::: "memory");
            acc[0] *= decay; acc[1] *= decay;
            float nsum = 0.f;
#pragma unroll
            for (int ks = 0; ks < 4; ++ks) {
                const f32x4 w0 = *(const f32x4*)(wsh + 32 * ks + 8 * q), w1 = *(const f32x4*)(wsh + 32 * ks + 8 * q + 4);
                float kf[8]; unpack8(*(const bf16x8*)(Ksh + (16 * w + cidx) * SP + 32 * ks + 8 * q), kf);
#pragma unroll
                for (int e = 0; e < 4; ++e) { kf[e] *= w0[e]; kf[4 + e] *= w1[e]; nsum += kf[e] + kf[4 + e]; }
                const bf16x8 kb = pack8(kf);
#pragma unroll
                for (int i = 0; i < 2; ++i) acc[i] = mfma16(*(const bf16x8*)(Vsh + (16 * i + cidx) * SP + 32 * ks + 8 * q), kb, acc[i]);
            }
            nsum += __shfl_xor(nsum, 16); nsum += __shfl_xor(nsum, 32);
            nv = decay * nv + nsum;
            m = Ftot + Mx;
            __builtin_amdgcn_sched_barrier(0);
            if (ci + 1 < MLNC) MLS_STORE((ci + 1) & 1);
            __syncthreads();
        }
    }
#undef MLS_LOAD
#undef MLS_STORE
#undef MLS_ROW0
    __syncthreads();
}
__device__ __forceinline__ int s5_rowbase(int cc) { const int b = cc / S5NCH, ch = cc - b * S5NCH; const int r1 = NLAT + b * CTXL + ch * 64, r2 = b * SEQ + (ch - 4) * 64; return __builtin_amdgcn_readfirstlane(0) + ((ch < 4) ? r1 : r2); }
constexpr int UPITCH = 1032, XPITCH = 264;
__device__ __forceinline__ void s5_stage_u(const bf16_t* z1, bf16_t* Us, int g, int cb, int tid) {
    u32x4 tmp[4];
#pragma unroll
    for (int i = 0; i < 4; ++i) { const int c = tid + 512 * i, cc = c >> 7, j = (c >> 1) & 63, hf = c & 1;
        const int rowb = s5_rowbase(cb * 16 + cc);
        tmp[i] = *(const u32x4*)(z1 + (size_t)(rowb + j) * LDZ + ZU + g * 16 + 8 * hf); }
    __builtin_amdgcn_sched_barrier(0);
#pragma unroll
    for (int i = 0; i < 4; ++i) { const int c = tid + 512 * i, cc = c >> 7, j = (c >> 1) & 63, hf = c & 1;
        *(u32x4*)(Us + cc * UPITCH + j * 16 + 8 * hf) = tmp[i]; }
}
__device__ __forceinline__ void s5_pass1(unsigned char* ws, unsigned char* sm, int tid) {
    const int w = tid >> 6, lane = tid & 63, cidx = lane & 15, q = lane >> 4;
    const bf16_t* z1 = (const bf16_t*)(ws + O_Z1); const bf16_t* T1 = (const bf16_t*)(ws + O_T1); float* E = (float*)(ws + O_E);
    bf16_t* Us = (bf16_t*)sm;
    for (int u = vbid(); u < 64 * 17; u += lidx((int)gridDim.x)) {
        const int cb = u % 17, g = u / 17;
        __syncthreads();
        s5_stage_u(z1, Us, g, cb, tid);
        __syncthreads();
        f32x4 acc[2] = {(f32x4){0.f, 0.f, 0.f, 0.f}, (f32x4){0.f, 0.f, 0.f, 0.f}};
        const bf16_t* tp = T1 + (size_t)g * 256 * 1024 + (size_t)(2 * w) * 32 * 512 + lane * 8;
        const bf16_t* up = Us + cidx * UPITCH + 8 * q;
#pragma unroll 1
        for (int ks0 = 0; ks0 < 32; ks0 += 8) {
            bf16x8 af[8][2];
#pragma unroll
            for (int i = 0; i < 8; ++i) { af[i][0] = ldg8(tp + 512 * (ks0 + i)); af[i][1] = ldg8(tp + 32 * 512 + 512 * (ks0 + i)); }
            __builtin_amdgcn_sched_barrier(0);
#pragma unroll
            for (int i = 0; i < 8; ++i) { const bf16x8 bfr = *(const bf16x8*)(up + 32 * (ks0 + i)); acc[0] = mfma16(af[i][0], bfr, acc[0]); acc[1] = mfma16(af[i][1], bfr, acc[1]); }
            __builtin_amdgcn_sched_barrier(0);
        }
        const int cc = cb * 16 + cidx;
        *(f32x4*)(E + ((size_t)g * S5COLS + cc) * 256 + (w * 2) * 16 + 4 * q) = acc[0];
        *(f32x4*)(E + ((size_t)g * S5COLS + cc) * 256 + (w * 2 + 1) * 16 + 4 * q) = acc[1];
    }
    __syncthreads();
}
__device__ __forceinline__ void s5_scan(unsigned char* ws, int l, int tid) {
    const f32x2* lamp = (const f32x2*)(ws + O_LAMP) + (size_t)l * 64 * 2 * 65 * 64; const float* E = (const float*)(ws + O_E); bf16_t* X = (bf16_t*)(ws + O_X);
    for (int idx = lidx((int)blockIdx.x) * 512 + tid; idx < 64 * 4 * 2 * 64; idx += lidx((int)gridDim.x) * 512) {
        const int n = idx & 63, dir = (idx >> 6) & 1, b = (idx >> 7) & 3, g = idx >> 9;
        const f32x2 l64 = lamp[((g * 2 + dir) * 65 + 64) * 64 + n];
        float xr = 0.f, xi = 0.f;
#pragma unroll 1
        for (int s0 = 0; s0 < S5NCH; s0 += 17) {
            f32x2 ev[17];
#pragma unroll
            for (int k = 0; k < 17; ++k) { const int step = s0 + k, ch = dir == 0 ? step : (step < 4 ? 3 - step : 71 - step);
                ev[k] = *(const f32x2*)(E + ((size_t)g * S5COLS + b * S5NCH + ch) * 256 + dir * 128 + 2 * n); }
            __builtin_amdgcn_sched_barrier(0);
#pragma unroll
            for (int k = 0; k < 17; ++k) { const int step = s0 + k, ch = dir == 0 ? step : (step < 4 ? 3 - step : 71 - step);
                const size_t o = ((size_t)g * S5COLS + b * S5NCH + ch) * 256 + dir * 128 + 2 * n;
                *(unsigned*)(X + o) = cvt_pk(xr, xi);
                const float nr = l64.x * xr - l64.y * xi + ev[k].x, ni = l64.x * xi + l64.y * xr + ev[k].y; xr = nr; xi = ni; }
        }
    }
}
__device__ __forceinline__ float gelu_tanh(float x) { const float u = 0.7978845608028654f * (x + 0.044715f * x * x * x); return 0.5f * x * (1.f + tanhf(u)); }
__device__ __forceinline__ void s5_pass2(unsigned char* ws, unsigned char* sm, int tid) {
    const int w = tid >> 6, lane = tid & 63, cidx = lane & 15, q = lane >> 4;
    const bf16_t* z1 = (const bf16_t*)(ws + O_Z1); const bf16_t* T2 = (const bf16_t*)(ws + O_T2); const bf16_t* KC = (const bf16_t*)(ws + O_KC); const bf16_t* X = (const bf16_t*)(ws + O_X);
    bf16_t* Gs = (bf16_t*)(ws + O_GS);
    bf16_t* Us = (bf16_t*)sm; bf16_t* Xs = Us + 16 * UPITCH; bf16_t* KCs = Xs + 16 * XPITCH;
    for (int u = vbid(); u < 64 * 17; u += lidx((int)gridDim.x)) {
        const int cb = u % 17, g = u / 17;
        __syncthreads();
        s5_stage_u(z1, Us, g, cb, tid);
        { u32x4 kt[8]; const int cc = tid >> 5, part = tid & 31; const u32x4 xt = *(const u32x4*)(X + ((size_t)g * S5COLS + cb * 16 + cc) * 256 + part * 8);
#pragma unroll
          for (int i = 0; i < 8; ++i) { const int c = tid + 512 * i; kt[i] = *(const u32x4*)(KC + (size_t)g * 128 * 256 + c * 8); }
          __builtin_amdgcn_sched_barrier(0);
          *(u32x4*)(Xs + cc * XPITCH + part * 8) = xt;
#pragma unroll
          for (int i = 0; i < 8; ++i) { const int c = tid + 512 * i; *(u32x4*)(KCs + c * 8) = kt[i]; } }
        __syncthreads();
        f32x4 acc[8];
#pragma unroll
        for (int i = 0; i < 8; ++i) acc[i] = (f32x4){0.f, 0.f, 0.f, 0.f};
        const bf16_t* kp = KCs + (63 - (q >> 1) + 8 * w) * 256 + cidx * 16 + 8 * (q & 1);
        const bf16_t* up = Us + cidx * UPITCH + 8 * q;
#pragma unroll 8
        for (int ks = 0; ks < 32; ++ks) {
            const bf16x8 bfr = *(const bf16x8*)(up + 32 * ks);
#pragma unroll
            for (int tb = 0; tb < 8; ++tb) acc[tb] = mfma16(*(const bf16x8*)(kp + (tb - 2 * ks) * 256), bfr, acc[tb]);
        }
        const bf16_t* xp = Xs + cidx * XPITCH + 8 * q;
        const bf16_t* tp = T2 + (size_t)g * 1024 * 256 + (size_t)(8 * w) * 8 * 512 + lane * 8;
#pragma unroll 1
        for (int ks0 = 0; ks0 < 8; ks0 += 2) {
            bf16x8 af[2][8];
#pragma unroll
            for (int i = 0; i < 2; ++i)
#pragma unroll
                for (int tb = 0; tb < 8; ++tb) af[i][tb] = ldg8(tp + (size_t)tb * 8 * 512 + 512 * (ks0 + i));
            __builtin_amdgcn_sched_barrier(0);
#pragma unroll
            for (int i = 0; i < 2; ++i) { const bf16x8 bfr = *(const bf16x8*)(xp + 32 * (ks0 + i));
#pragma unroll
                for (int tb = 0; tb < 8; ++tb) acc[tb] = mfma16(af[i][tb], bfr, acc[tb]); }
            __builtin_amdgcn_sched_barrier(0);
        }
        const int rowb = s5_rowbase(cb * 16 + cidx);
#pragma unroll
        for (int tb = 0; tb < 8; ++tb) { u32x2 o; o.x = cvt_pk(gelu_tanh(acc[tb][0]), gelu_tanh(acc[tb][1])); o.y = cvt_pk(gelu_tanh(acc[tb][2]), gelu_tanh(acc[tb][3]));
            *(u32x2*)(Gs + (size_t)(rowb + 8 * w + tb) * 1024 + g * 16 + 4 * q) = o; }
    }
    __syncthreads();
}
__device__ __forceinline__ void qk_prep(const Args& a, unsigned char* ws, int l, int gw, int NGW, int lane) {
    const int h = lane >> 3, sub = lane & 7;
    const float* misc = (const float*)(ws + O_MISC);
    for (int it = gw; it < MROWS * 2; it += NGW) {
        const int row = it >> 1, which = it & 1;
        bf16_t* p = (bf16_t*)(ws + (which ? O_K : O_Q)) + (size_t)row * 1536 + h * 192 + 8 * sub;
        const float* gn = (which ? gin(a.in[lidx(I_KNG)]) : gin(a.in[lidx(I_QNG)])) + l * 192 + 8 * sub;
        float v[3][8];
        unpack8(*(const bf16x8*)p, v[0]); unpack8(*(const bf16x8*)(p + 64), v[1]);
        if (which) { const f32x4 k0 = *(const f32x4*)(misc + (size_t)row * NMISC + 8 * sub), k1 = *(const f32x4*)(misc + (size_t)row * NMISC + 8 * sub + 4);
#pragma unroll
            for (int e = 0; e < 4; ++e) { v[2][e] = k0[e]; v[2][4 + e] = k1[e]; } }
        else unpack8(*(const bf16x8*)(p + 128), v[2]);
        float s = 0.f;
#pragma unroll
        for (int j = 0; j < 3; ++j)
#pragma unroll
            for (int e = 0; e < 8; ++e) s += v[j][e] * v[j][e];
        s += __shfl_xor(s, 1); s += __shfl_xor(s, 2); s += __shfl_xor(s, 4);
        const float rs = rsqrtf(s * (1.f / 192.f) + EPS);
#pragma unroll
        for (int j = 0; j < 3; ++j)
#pragma unroll
            for (int e = 0; e < 8; ++e) v[j][e] = v[j][e] * rs * gn[64 * j + e];
        if (row < NLAT) {
            const int t = row & (SEQ - 1);
            const int pos = (sub >> 2) ? (t & 63) : (t >> 6);
            const f32x2* rp = (const f32x2*)(ws + O_ROPE) + pos * 16 + 8 * (sub & 1);
            f32x2 cs8[8];
#pragma unroll
            for (int e = 0; e < 8; ++e) cs8[e] = rp[e];
#pragma unroll
            for (int e = 0; e < 8; ++e) {
                const float partner = __shfl_xor(v[2][e], 2);
                v[2][e] = (sub & 2) ? (v[2][e] * cs8[e].x + partner * cs8[e].y) : (v[2][e] * cs8[e].x - partner * cs8[e].y);
            }
        }
        *(bf16x8*)p = pack8(v[0]); *(bf16x8*)(p + 64) = pack8(v[1]); *(bf16x8*)(p + 128) = pack8(v[2]);
    }
}

__device__ __forceinline__ void ml_out_pass(const Args& a, unsigned char* ws, unsigned char* sm, int l, bool with_ctx, int tid) {
    const int w = tid >> 6, lane = tid & 63, cidx = lane & 15, q = lane >> 4;
    const bf16_t* z1 = (const bf16_t*)(ws + O_Z1); const bf16_t* KVt = (const bf16_t*)(ws + O_KVT); const bf16_t* Cst = (const bf16_t*)(ws + O_BR + BRSZ);
    const float* MLG = (const float*)(ws + O_MLG); const float* MLN = (const float*)(ws + O_MLN); const float* MLM = (const float*)(ws + O_MLM);
    bf16_t* BRa = (bf16_t*)(ws + O_BR);
    constexpr int KP = 136;
    bf16_t* Ks = (bf16_t*)sm; float* As = (float*)(sm + 128 * KP * 2);
    const float scale = 0.08838834764831845f;
    for (int u = vbid(); u < 4 * 4 * MLNC; u += lidx((int)gridDim.x)) {
        const int oc = u % MLNC, h = (u / MLNC) & 3, b = u / (4 * MLNC);
        if (!with_ctx && oc < 2) continue;
        const int row0 = oc < 2 ? NLAT + b * CTXL + oc * MLCH : b * SEQ + (oc - 2) * MLCH;
        const int rb = w, t = 16 * rb + cidx;
        __syncthreads();
        { u32x4 kt[4];
#pragma unroll
          for (int i = 0; i < 4; ++i) { const int c = tid + 512 * i, r = c >> 4, cc = c & 15; kt[i] = *(const u32x4*)(z1 + (size_t)(row0 + r) * LDZ + ZK + h * 128 + cc * 8); }
          float av = 0.f; if (tid < 256) av = MLG[(size_t)(8 + (tid >> 7) * 4 + h) * MROWS + row0 + (tid & 127)];
          __builtin_amdgcn_sched_barrier(0);
#pragma unroll
          for (int i = 0; i < 4; ++i) { const int c = tid + 512 * i, r = c >> 4, cc = c & 15; *(u32x4*)(Ks + r * KP + cc * 8) = kt[i]; }
          if (tid < 256) As[tid] = av; }
        bf16x8 qf[4];
#pragma unroll
        for (int ks = 0; ks < 4; ++ks) qf[ks] = ldg8(z1 + (size_t)(row0 + t) * LDZ + ZQ + h * 128 + 32 * ks + 8 * q);
        __syncthreads();
        bf16x8 pf[2][4]; float inv2[2], wsc2[2];
#pragma unroll
        for (int dir = 0; dir < 2; ++dir) {
            const int chain = (b * 4 + h) * 2 + dir, ci = dir == 0 ? oc : (oc < 2 ? 1 - oc : 35 - oc);
            const float mc = MLM[chain * MLNC + ci];
            const float* Gp = MLG + (size_t)(dir * 4 + h) * MROWS + row0; const float* pp = Gp + (size_t)16 * MROWS;
            const float Gt = Gp[t], Mt = fmaxf(mc, pp[t]);
            f32x4 nq[4][2];
            { const float* np = MLN + ((size_t)chain * MLNC + ci) * 128 + 8 * q;
#pragma unroll
              for (int ks = 0; ks < 4; ++ks) { nq[ks][0] = *(const f32x4*)(np + 32 * ks); nq[ks][1] = *(const f32x4*)(np + 32 * ks + 4); } }
            __builtin_amdgcn_sched_barrier(0);
            const float winter = __expf(mc - Mt);
            float qn = 0.f;
#pragma unroll
            for (int ks = 0; ks < 4; ++ks) { float qv[8]; unpack8(qf[ks], qv);
#pragma unroll
                for (int e = 0; e < 4; ++e) qn += qv[e] * nq[ks][0][e] + qv[4 + e] * nq[ks][1][e]; }
            qn += __shfl_xor(qn, 16); qn += __shfl_xor(qn, 32);
            float rsum = 0.f;
#pragma unroll
            for (int i = 0; i < 4; ++i) {
                float pv[8];
#pragma unroll
                for (int hb = 0; hb < 2; ++hb) {
                    const int kb = 2 * i + hb;
                    const bool skip = dir == 0 ? (kb > rb) : (kb < rb);
                    f32x4 sacc = (f32x4){0.f, 0.f, 0.f, 0.f};
                    if (!(a.sub & 16))
#pragma unroll
                    for (int ks = 0; ks < 4; ++ks) sacc = mfma16(*(const bf16x8*)(Ks + (16 * kb + cidx) * KP + 32 * ks + 8 * q), qf[ks], sacc);
                    const f32x4 a4 = *(const f32x4*)(As + dir * 128 + 16 * kb + 4 * q);
#pragma unroll
                    for (int r = 0; r < 4; ++r) {
                        const int sidx = 16 * kb + 4 * q + r;
                        const bool valid = !skip && (dir == 0 ? (sidx <= t) : (sidx >= t));
                        const float e = __expf(fminf(a4[r] - Mt, 0.f));
                        const float val = valid ? sacc[r] * scale * e : 0.f;
                        pv[hb * 4 + r] = val; rsum += val;
                    }
                }
                pf[dir][i] = pack8(pv);
            }
            rsum += __shfl_xor(rsum, 16); rsum += __shfl_xor(rsum, 32);
            const float den = winter * qn * scale + rsum;
            inv2[dir] = 1.f / fmaxf(fabsf(den), __expf(-(Gt + Mt)));
            wsc2[dir] = winter * scale;
        }
        float ss = 0.f;
        bf16_t* dp = BRa + (size_t)(row0 + t) * 1024 + h * 256 + 4 * q;
        const int ci0 = oc, ci1 = oc < 2 ? 1 - oc : 35 - oc;
        constexpr int SP = 136, SBUF = 64 * SP;
        bf16_t* stg = (bf16_t*)(sm + 36864);
        const bf16_t* cg0 = Cst + ((size_t)((b * 4 + h) * 2 + 0) * MLNC + ci0) * 256 * 128;
        const bf16_t* cg1 = Cst + ((size_t)((b * 4 + h) * 2 + 1) * MLNC + ci1) * 256 * 128;
        const bf16_t* vg = KVt + (size_t)(512 + h * 256) * MROWS + row0;
        u32x4 sreg[6];
#define MLO_SLOAD(s_) do { _Pragma("unroll") for (int k = 0; k < 6; ++k) { const int c = tid + 512 * k, which = c >> 10, idx = c & 1023, r = idx >> 4, cc = idx & 15; \
            const bf16_t* src = which == 0 ? cg0 + (size_t)(64 * (s_) + r) * 128 + cc * 8 : (which == 1 ? cg1 + (size_t)(64 * (s_) + r) * 128 + cc * 8 : vg + (size_t)(64 * (s_) + r) * MROWS + cc * 8); \
            sreg[k] = *(const u32x4*)src; } } while (0)
#define MLO_SSTORE(buf_) do { _Pragma("unroll") for (int k = 0; k < 6; ++k) { const int c = tid + 512 * k, which = c >> 10, idx = c & 1023, r = idx >> 4, cc = idx & 15; \
            *(u32x4*)(stg + (buf_) * 3 * SBUF + which * SBUF + r * SP + cc * 8) = sreg[k]; } } while (0)
        MLO_SLOAD(0); __builtin_amdgcn_sched_barrier(0); MLO_SSTORE(0); __syncthreads();
#pragma unroll 1
        for (int st = 0; st < ((a.sub & 8) ? 0 : 4); ++st) {
            if (st + 1 < 4) MLO_SLOAD(st + 1);
            __builtin_amdgcn_sched_barrier(0);
            const bf16_t* sb = stg + (st & 1) * 3 * SBUF;
#pragma unroll
            for (int d4 = 0; d4 < 4; ++d4) {
                f32x4 hsum = (f32x4){0.f, 0.f, 0.f, 0.f};
                const bf16_t* vrow = sb + 2 * SBUF + (16 * d4 + cidx) * SP + 4 * q;
#pragma unroll
                for (int dir = 0; dir < 2; ++dir) {
                    const bf16_t* crow = sb + dir * SBUF + (16 * d4 + cidx) * SP + 8 * q;
                    f32x4 acc = (f32x4){0.f, 0.f, 0.f, 0.f};
#pragma unroll
                    for (int ks = 0; ks < 4; ++ks) acc = mfma16(*(const bf16x8*)(crow + 32 * ks), qf[ks], acc);
                    acc *= wsc2[dir];
#pragma unroll
                    for (int i = 0; i < 4; ++i) { const u32x2 lo = *(const u32x2*)(vrow + 32 * i); asm volatile("" ::: "memory"); const u32x2 hi = *(const u32x2*)(vrow + 32 * i + 16); asm volatile("" ::: "memory");
                        const u32x4 av = (u32x4){lo.x, lo.y, hi.x, hi.y}; acc = mfma16(__builtin_bit_cast(bf16x8, av), pf[dir][i], acc); }
                    hsum += acc * inv2[dir];
                }
                ss += hsum[0] * hsum[0] + hsum[1] * hsum[1] + hsum[2] * hsum[2] + hsum[3] * hsum[3];
                u32x2 r_; r_.x = cvt_pk(hsum[0], hsum[1]); r_.y = cvt_pk(hsum[2], hsum[3]); *(u32x2*)(dp + 16 * (4 * st + d4)) = r_;
            }
            __builtin_amdgcn_sched_barrier(0);
            if (st + 1 < 4) MLO_SSTORE((st + 1) & 1);
            __syncthreads();
        }
#undef MLO_SLOAD
#undef MLO_SSTORE
        ss += __shfl_xor(ss, 16); ss += __shfl_xor(ss, 32);
        const float rs = rsqrtf(ss * (1.f / 256.f) + EPS);
        const float* ng = gin(a.in[lidx(I_MLNG)]) + (size_t)l * 1024 + h * 256 + 4 * q;
        const bf16_t* op = z1 + (size_t)(row0 + t) * LDZ + ZO + h * 256 + 4 * q;
#pragma unroll 1
        for (int i0 = 0; i0 < 16; i0 += 4) {
            u32x2 ov[4], hv[4]; f32x4 g4[4];
#pragma unroll
            for (int k = 0; k < 4; ++k) { ov[k] = *(const u32x2*)(op + 16 * (i0 + k)); g4[k] = *(const f32x4*)(ng + 16 * (i0 + k)); hv[k] = *(const u32x2*)(dp + 16 * (i0 + k)); }
            __builtin_amdgcn_sched_barrier(0);
#pragma unroll
            for (int k = 0; k < 4; ++k) {
                const float o0 = __uint_as_float(ov[k].x << 16), o1 = __uint_as_float(ov[k].x & 0xffff0000u), o2 = __uint_as_float(ov[k].y << 16), o3 = __uint_as_float(ov[k].y & 0xffff0000u);
                const float h0 = __uint_as_float(hv[k].x << 16), h1 = __uint_as_float(hv[k].x & 0xffff0000u), h2 = __uint_as_float(hv[k].y << 16), h3 = __uint_as_float(hv[k].y & 0xffff0000u);
                u32x2 r; r.x = cvt_pk(h0 * rs * g4[k][0] * sigmoidf_(o0), h1 * rs * g4[k][1] * sigmoidf_(o1)); r.y = cvt_pk(h2 * rs * g4[k][2] * sigmoidf_(o2), h3 * rs * g4[k][3] * sigmoidf_(o3));
                *(u32x2*)(dp + 16 * (i0 + k)) = r;
            }
        }
    }
    __syncthreads();
}

constexpr int VPITCH = 72, KTILE_B = 64 * 24 * 16, VTILE_B = 128 * VPITCH * 2;
__device__ __forceinline__ void attn_phase(unsigned char* ws, unsigned char* sm, bool with_ctx, int tid) {
    const int w = tid >> 6, lane = tid & 63, cidx = lane & 15, q = lane >> 4;
    const bf16_t* Q = (const bf16_t*)(ws + O_Q); const bf16_t* K = (const bf16_t*)(ws + O_K); const bf16_t* Vt = (const bf16_t*)(ws + O_VTA);
    bf16_t* out = (bf16_t*)(ws + O_BR + BRSZ);
    const float C = 0.07216878364870322f * 1.4426950408889634f;
    const int nunits = 512 + (with_ctx ? 32 : 0);
    for (int u = vbid(); u < nunits; u += lidx((int)gridDim.x)) {
        int b, h, qrow0, ntiles;
        if (u < 512) { b = u >> 7; h = (u >> 4) & 7; qrow0 = b * SEQ + (u & 15) * 256; ntiles = 68; }
        else { const int uu = u - 512; b = uu >> 3; h = uu & 7; qrow0 = NLAT + b * CTXL; ntiles = 4; }
        bf16x8 qf[2][6];
#pragma unroll
        for (int qq = 0; qq < 2; ++qq)
#pragma unroll
            for (int ks = 0; ks < 6; ++ks) qf[qq][ks] = ldg8(Q + (size_t)(qrow0 + 32 * w + 16 * qq + cidx) * 1536 + h * 192 + 32 * ks + 8 * q);
        f32x4 o[8][2];
#pragma unroll
        for (int i = 0; i < 8; ++i) { o[i][0] = (f32x4){0.f, 0.f, 0.f, 0.f}; o[i][1] = (f32x4){0.f, 0.f, 0.f, 0.f}; }
        float mrun[2] = {-1e30f, -1e30f}, lsum[2] = {0.f, 0.f};
        unsigned koff[4], voff[3];
#pragma unroll
        for (int i = 0; i < 3; ++i) { const int L = (w + 8 * i) * 64 + lane, r = L / 24, cl = L - r * 24, cc = cl ^ (r & 7); koff[i] = (unsigned)((r * 1536 + h * 192 + cc * 8) * 2); }
        koff[3] = 0u;
#pragma unroll
        for (int i = 0; i < 3; ++i) { const int c = (w + 8 * i) * 64 + lane, r = c / 9; int cc = c - r * 9; if (cc == 8) cc = 0; voff[i] = (unsigned)(((h * 128 + r) * MROWS + cc * 8) * 2); }
#define ATT_LOAD(j, buf) do { const int _kr = (j) < 4 ? NLAT + b * CTXL + 64 * (j) : b * SEQ + 64 * ((j) - 4); \
        const char* _kg = (const char*)(K + (size_t)_kr * 1536); const char* _vg = (const char*)(Vt + _kr); \
        LAS unsigned char* _kb = (LAS unsigned char*)sm + (buf) * (KTILE_B + VTILE_B); LAS unsigned char* _vb = _kb + KTILE_B; \
        _Pragma("unroll") for (int _i = 0; _i < 3; ++_i) __builtin_amdgcn_global_load_lds((const unsigned*)(_kg + koff[_i]), (LAS unsigned*)(_kb + (w + 8 * _i) * 1024), 16, 0, 0); \
        _Pragma("unroll") for (int _i = 0; _i < 3; ++_i) if (w + 8 * _i < 18) __builtin_amdgcn_global_load_lds((const unsigned*)(_vg + voff[_i]), (LAS unsigned*)(_vb + (w + 8 * _i) * 1024), 16, 0, 0); } while (0)
#define ATT_STORE(buf) do { } while (0)
        ATT_LOAD(0, 0); asm volatile("s_waitcnt vmcnt(0)" ::: "memory"); __syncthreads();
        for (int j = 0; j < ntiles; ++j) {
            if (j + 1 < ntiles) ATT_LOAD(j + 1, (j + 1) & 1);
            const unsigned char* kb_ = sm + (j & 1) * (KTILE_B + VTILE_B); const unsigned char* vb_ = kb_ + KTILE_B;
            f32x4 s[4][2];
#pragma unroll
            for (int kb = 0; kb < 4; ++kb) { s[kb][0] = (f32x4){0.f, 0.f, 0.f, 0.f}; s[kb][1] = (f32x4){0.f, 0.f, 0.f, 0.f};
#pragma unroll
                for (int ks = 0; ks < 6; ++ks) { const bf16x8 af = *(const bf16x8*)(kb_ + ((16 * kb + cidx) * 24 + ((4 * ks + q) ^ (cidx & 7))) * 16);
                    s[kb][0] = mfma16(af, qf[0][ks], s[kb][0]); s[kb][1] = mfma16(af, qf[1][ks], s[kb][1]); } }
            bf16x8 pf[2][2];
#pragma unroll
            for (int qq = 0; qq < 2; ++qq) {
                float mx = fmaxf(fmaxf(s[0][qq][0], s[0][qq][1]), fmaxf(s[0][qq][2], s[0][qq][3]));
#pragma unroll
                for (int kb = 1; kb < 4; ++kb) mx = fmaxf(mx, fmaxf(fmaxf(s[kb][qq][0], s[kb][qq][1]), fmaxf(s[kb][qq][2], s[kb][qq][3])));
                if (!__all(mx - mrun[qq] <= 110.851251684f)) {
                    mx = fmaxf(mx, __shfl_xor(mx, 16)); mx = fmaxf(mx, __shfl_xor(mx, 32));
                    const float mnew = fmaxf(mrun[qq], mx), alpha = __builtin_amdgcn_exp2f((mrun[qq] - mnew) * C);
                    mrun[qq] = mnew; lsum[qq] *= alpha;
#pragma unroll
                    for (int i = 0; i < 8; ++i) o[i][qq] *= alpha;
                }
                const float mc = mrun[qq] * C;
                float ps = 0.f; float pv[4][4];
#pragma unroll
                for (int kb = 0; kb < 4; ++kb)
#pragma unroll
                    for (int r = 0; r < 4; ++r) { pv[kb][r] = __builtin_amdgcn_exp2f(fmaf(s[kb][qq][r], C, -mc)); ps += pv[kb][r]; }
                lsum[qq] += ps;
#pragma unroll
                for (int i = 0; i < 2; ++i) { u32x4 pw; pw.x = cvt_pk(pv[2 * i][0], pv[2 * i][1]); pw.y = cvt_pk(pv[2 * i][2], pv[2 * i][3]); pw.z = cvt_pk(pv[2 * i + 1][0], pv[2 * i + 1][1]); pw.w = cvt_pk(pv[2 * i + 1][2], pv[2 * i + 1][3]);
                    pf[qq][i] = __builtin_bit_cast(bf16x8, pw); }
            }
#pragma unroll
            for (int dvb = 0; dvb < 8; ++dvb)
#pragma unroll
                for (int i = 0; i < 2; ++i) {
                    const unsigned char* vq = vb_ + ((16 * dvb + cidx) * VPITCH + 32 * i + 4 * q) * 2;
                    const u32x2 lo = *(const u32x2*)vq; asm volatile("" ::: "memory"); const u32x2 hi = *(const u32x2*)(vq + 32); asm volatile("" ::: "memory");
                    const bf16x8 af = __builtin_bit_cast(bf16x8, ((u32x4){lo.x, lo.y, hi.x, hi.y}));
                    o[dvb][0] = mfma16(af, pf[0][i], o[dvb][0]); o[dvb][1] = mfma16(af, pf[1][i], o[dvb][1]);
                }
            asm volatile("s_waitcnt vmcnt(0)" ::: "memory");
            __syncthreads();
        }
#pragma unroll
        for (int qq = 0; qq < 2; ++qq) {
            float lt = lsum[qq]; lt += __shfl_xor(lt, 16); lt += __shfl_xor(lt, 32);
            const float inv = 1.f / lt;
            bf16_t* dp = out + (size_t)(qrow0 + 32 * w + 16 * qq + cidx) * 1024 + h * 128 + 4 * q;
#pragma unroll
            for (int dvb = 0; dvb < 8; ++dvb) { u32x2 r; r.x = cvt_pk(o[dvb][qq][0] * inv, o[dvb][qq][1] * inv); r.y = cvt_pk(o[dvb][qq][2] * inv, o[dvb][qq][3] * inv); *(u32x2*)(dp + 16 * dvb) = r; }
        }
    }
#undef ATT_LOAD
#undef ATT_STORE
}


#define XB_TMO      128
#define XB_XCNT(j)  (256  + 64 * (j))
#define XB_XSUB(j)  (1280 + 64 * (j))
#define XB_XGEN(j)  (2304 + 64 * (j))
#define XB_TOP      3328
#define XB_TOPGEN   3392
#define XCD_BAR_WORDS 3456
#define XB_SPIN_CAP (1u << 18)
__device__ __forceinline__ unsigned xb_ld(unsigned* p)              { return __hip_atomic_load(p, __ATOMIC_RELAXED, __HIP_MEMORY_SCOPE_AGENT); }
__device__ __forceinline__ unsigned xb_add(unsigned* p, unsigned v) { return __hip_atomic_fetch_add(p, v, __ATOMIC_RELAXED, __HIP_MEMORY_SCOPE_AGENT); }
__device__ __forceinline__ unsigned xb_xcc_id() { return (unsigned)__builtin_amdgcn_s_getreg((3 << 11) | 20) & 0xFu; }
#define XB_SPIN(cond, bar) do { unsigned _sp = 0; while (cond) { __builtin_amdgcn_s_sleep(1); \
    if ((++_sp & 255u) == 0u) { if (xb_ld(&(bar)[XB_TMO])) break; if (_sp > XB_SPIN_CAP) { atomicAdd(&(bar)[XB_TMO], 1u); break; } } } } while (0)
struct XcdBarrier { unsigned* bar; unsigned x; volatile LAS unsigned* st; };
__device__ __forceinline__ XcdBarrier xcd_barrier_post(unsigned* bar, volatile LAS unsigned* st) {
    XcdBarrier b; b.bar = bar; b.x = xb_xcc_id(); b.st = st;
    if (threadIdx.x == 0) (void)xb_add(&bar[XB_XCNT(b.x)], 1u);
    return b;
}
__device__ __forceinline__ void xcd_barrier_complete(unsigned* bar, unsigned x, unsigned& nloc, unsigned& nx) {
    const unsigned G = gridDim.x * gridDim.y * gridDim.z;
    unsigned sum, cnt, mine, sp = 0u;
    for (;;) {
        sum = 0u; cnt = 0u; mine = 0u;
#pragma unroll
        for (unsigned j = 0; j < 16; ++j) { const unsigned c = xb_ld(&bar[XB_XCNT(j)]); sum += c; cnt += (c > 0u) ? 1u : 0u; mine = (j == x) ? c : mine; }
        if (sum == G) break;
        __builtin_amdgcn_s_sleep(1);
        if ((++sp & 255u) == 0u) { if (xb_ld(&bar[XB_TMO])) break; if (sp > XB_SPIN_CAP) { atomicAdd(&bar[XB_TMO], 1u); break; } }
    }
    nloc = mine > 0u ? mine : 1u; nx = cnt > 0u ? cnt : 1u;
}
__device__ __forceinline__ void xcd_barrier(const XcdBarrier& b) {
    asm volatile("s_waitcnt vmcnt(0)" ::: "memory");
    __syncthreads();
    if (threadIdx.x == 0) {
        unsigned* bar = b.bar;
        __builtin_amdgcn_s_waitcnt(0);
        unsigned nloc = b.st[0], nx = b.st[1];
        if (nloc == 0u) { xcd_barrier_complete(bar, b.x, nloc, nx); b.st[0] = nloc; b.st[1] = nx; }
        const unsigned old = xb_add(&bar[XB_XSUB(b.x)], 1u);
        const unsigned gen = old / nloc;
        if (old + 1u == (gen + 1u) * nloc) {
            __builtin_amdgcn_fence(__ATOMIC_RELEASE, "agent");
            asm volatile("s_waitcnt vmcnt(0)" ::: "memory");
            const unsigned og = xb_add(&bar[XB_TOP], 1u);
            const unsigned tg = og / nx;
            if (og + 1u == (tg + 1u) * nx) xb_add(&bar[XB_TOPGEN], 1u);
            else XB_SPIN(xb_ld(&bar[XB_TOPGEN]) == tg, bar);
            __builtin_amdgcn_fence(__ATOMIC_ACQUIRE, "agent");
            xb_add(&bar[XB_XGEN(b.x)], 1u);
            asm volatile("s_waitcnt vmcnt(0)" ::: "memory");
        } else {
            XB_SPIN(xb_ld(&bar[XB_XGEN(b.x)]) == gen, bar);
            __builtin_amdgcn_fence(__ATOMIC_ACQUIRE, "agent");
            asm volatile("s_waitcnt vmcnt(0)" ::: "memory");
        }
    }
    __syncthreads();
}

constexpr int LDS_BYTES = 147456;
constexpr int NPHASE = 25;
constexpr int PROBE_LO = -1, PROBE_HI = -1, PROBE_SUB = 7;
__global__ void __launch_bounds__(512, 2) mega(Args a) {
    extern __shared__ __attribute__((aligned(16))) unsigned char lds[];
    cg::grid_group grid = cg::this_grid();
    const int NGW = lidx((int)gridDim.x) * 8;
#define tid (ltid())
#define lane (ltid() & 63)
#define gw ((int)(lidx((int)blockIdx.x) * 8 + (ltid() >> 6)))
unsigned char* const wsraw_ = (unsigned char*)a.ws;
#define ws (lptr(a.ws))
    LAS unsigned char* ldsl = (LAS unsigned char*)lds;
    const int lo = a.ph_lo, hi = a.ph_hi;
#define IN(p) ((p) >= lo && (p) < hi)
    volatile LAS unsigned* xst = (volatile LAS unsigned*)(ldsl + LDS_BYTES - 64);
    if (threadIdx.x < 2) xst[threadIdx.x] = 0u;
    __syncthreads();
    const XcdBarrier xbar = xcd_barrier_post((unsigned*)(wsraw_ + O_BARW) + a.bar_region * 4096, xst);
#define SEAM(p) do { if ((p) + 1 < hi) { if ((p) == 0) grid.sync(); else xcd_barrier(xbar); } } while (0)
    if (IN(0)) { phase0(a, ws, (float*)lds, tid); SEAM(0); }
    const int G = lidx((int)gridDim.x), cb = lidx((int)blockIdx.x);
    float* outl = (float*)a.out; float* outc = (float*)(ws + O_CTXX);
#pragma unroll 1
    for (int l = 0; l < 2; ++l) {
        const int P = 1 + 12 * l;
        const bool wctx = (l == 0);
        const int Mlate = wctx ? MROWS : NLAT;
        const float* xl = l == 0 ? gin(a.in[lidx(I_X)]) : outl; const float* xc = l == 0 ? gin(a.in[lidx(I_CTX)]) : outc;
        const float* modl = (const float*)(ws + O_MOD) + (size_t)l * 5 * 12288;
        const bf16_t* HX = (const bf16_t*)(ws + O_HX); const bf16_t* Z1 = (const bf16_t*)(ws + O_Z1);
        if (IN(P + 0)) { phaseA(a, ws, lds, l, xl, xc, tid, (l == 0 || G <= 64) ? 0 : 2, 0, G); SEAM(P + 0); }
        if (IN(P + 1)) {
            { pg8::Gemm g{HX, (const bf16_t*)(ws + O_WZ1), DM, DM, DM, 0, 0}; pg8::Order<1> S; S.init(MROWS, NZ1, G, cb);
              pg8::Epi<FZ1> E{{(bf16_t*)(ws + O_Z1), (float*)(ws + O_MISC), (const float*)(ws + O_BIAS)}};
#ifndef NO_G0
            pg8::gemm_phase(ldsl, g, S, E);
#endif
 }
            { pg8::Gemm g{(const bf16_t*)(ws + O_WKV), HX, DM, DM, DM, 0, 0}; pg8::Order<1> S; S.init(1536, MROWS, G, cb);
              pg8::Epi<FRowBias> E{{(bf16_t*)(ws + O_KVT), MROWS, (const float*)(ws + O_BIAS) + 4352}};
#ifndef NO_G1
            pg8::gemm_phase(ldsl, g, S, E);
#endif
 }
            SEAM(P + 1);
        }
        if (IN(P + 2)) { if (a.sub & 1) mla_norm(a, ws, l, gw, NGW, lane); if (a.sub & 2) s5_pass1(ws, lds, tid); if (a.sub & 4) ml_state_pass(a, ws, (float*)lds, l, tid); SEAM(P + 2); }
        if (IN(P + 3)) {
            { pg8::Gemm g{Z1 + ZQA, (const bf16_t*)(ws + O_WUQ), LDZ, 512, 512, 0, 0}; pg8::Order<1> S; S.init(MROWS, 1536, G, cb);
              pg8::Epi<FPlain> E{{(bf16_t*)(ws + O_Q), 1536}};
#ifndef NO_G2
            pg8::gemm_phase(ldsl, g, S, E);
#endif
 }
            { pg8::Gemm g{Z1 + ZKVA, (const bf16_t*)(ws + O_WUKVK), LDZ, 512, 512, 0, 0}; pg8::Order<1> S; S.init(MROWS, 1024, G, cb);
              pg8::Epi<FKn> E{{(bf16_t*)(ws + O_K)}};
#ifndef NO_G3
            pg8::gemm_phase(ldsl, g, S, E);
#endif
 }
            { pg8::Gemm g{(const bf16_t*)(ws + O_WUKVV), Z1 + ZKVA, 512, LDZ, 512, 0, 0}; pg8::Order<1> S; S.init(1024, MROWS, G, cb);
              pg8::Epi<FRowBias> E{{(bf16_t*)(ws + O_VTA), MROWS, nullptr}};
#ifndef NO_G4
            pg8::gemm_phase(ldsl, g, S, E);
#endif
 }
            s5_scan(ws, l, tid);
            SEAM(P + 3);
        }
        if (IN(P + 4)) { if (a.sub & 1) qk_prep(a, ws, l, gw, NGW, lane); if (a.sub & 2) s5_pass2(ws, lds, tid); if (a.sub & 4) ml_out_pass(a, ws, lds, l, wctx, tid); SEAM(P + 4); }
        if (IN(P + 5)) {
            attn_phase(ws, lds, wctx, tid);
            { pg8::Gemm g{(const bf16_t*)(ws + O_GS), (const bf16_t*)(ws + O_WGLU), 1024, 1024, 1024, 0, 0}; pg8::Order<1> S; S.init(Mlate, 1024, G, cb);
              pg8::Epi<FGlu> E{{(bf16_t*)(ws + O_BR + 2 * BRSZ), (const bf16_t*)(ws + O_GS), gin(a.in[lidx(I_BGLU)]) + l * 1024}};
#ifndef NO_G5
            pg8::gemm_phase(ldsl, g, S, E);
#endif
 }
            SEAM(P + 5);
        }
        if (IN(P + 6)) {
            pg8::Gemm g{HX, (const bf16_t*)(ws + O_WG), DM, DM, DM, 0, 0}; pg8::Order<1> S; S.init(Mlate, 6144, G, cb);
            pg8::Epi<FGate> E{{(bf16_t*)(ws + O_GATES), (const float*)(ws + O_BIAS) + 4352 + 1536}};
#ifndef NO_G6
            pg8::gemm_phase(ldsl, g, S, E);
#endif

            SEAM(P + 6);
        }
        if (IN(P + 7)) {
            pg8::Gemm g{(const bf16_t*)(ws + O_BR), (const bf16_t*)(ws + O_WBR), 1024, 1024, 1024, (size_t)MROWS * 1024, (size_t)2048 * 1024}; pg8::Order<3> S; S.init(Mlate, DM, G, cb);
            pg8::Epi<FMerge> E{{(bf16_t*)(ws + O_HX), (const bf16_t*)(ws + O_GATES)}};
#ifndef NO_G7
            pg8::gemm_phase(ldsl, g, S, E);
#endif

            SEAM(P + 7);
        }
        if (IN(P + 8)) {
            pg8::Gemm g{HX, (const bf16_t*)(ws + O_WOUT), DM, DM, DM, 0, 0}; pg8::Order<1> S; S.init(Mlate, DM, G, cb);
            pg8::Epi<FResid> E{{xl, xc, outl, outc, modl, 2}};
#ifndef NO_G8
            pg8::gemm_phase(ldsl, g, S, E);
#endif

            SEAM(P + 8);
        }
        if (IN(P + 9)) { norm_mod_rows(outl, outc, gin(a.in[lidx(I_NORMG)]) + (size_t)(l * 2 + 1) * DM, modl, 3, (bf16_t*)(ws + O_HX), Mlate, gw, NGW, lane); SEAM(P + 9); }
        if (IN(P + 10)) {
            pg8::Gemm g{HX, (const bf16_t*)(ws + O_W1), DM, DM, DM, 0, 0}; pg8::Order<1> S; S.init(Mlate, DFF, G, cb);
            pg8::Epi<FFF1> E{{(bf16_t*)(ws + O_HID)}};
#ifndef NO_G9
            pg8::gemm_phase(ldsl, g, S, E);
#endif

            SEAM(P + 10);
        }
        if (IN(P + 11)) {
            pg8::Gemm g{(const bf16_t*)(ws + O_HID), (const bf16_t*)(ws + (l == 0 ? O_W2 : O_W2B)), DFF, DFF, DFF, 0, 0}; pg8::Order<1> S; S.init(Mlate, DM, G, cb);
            pg8::Epi<FResid> E{{outl, outc, outl, outc, modl, 5}};
#ifndef NO_G10
            pg8::gemm_phase(ldsl, g, S, E);
#endif
            if (wctx && cb >= 32 && G > 64) phaseA(a, ws, lds, 1, nullptr, nullptr, tid, 1, 32, G - 32);

            SEAM(P + 11);
        }
    }
#undef IN
#undef SEAM
#undef tid
#undef lane
#undef gw
#undef ws
}

extern "C" void kernel_launch(void* const* d_in, const int* in_sizes, int n_in, void* d_out, int out_size, void* d_ws, size_t ws_size, hipStream_t stream) {
    static int grid = 0;
    if (grid == 0) {
        int dev = 0, cus = 0, per_cu = 0;
        (void)hipGetDevice(&dev);
        (void)hipDeviceGetAttribute(&cus, hipDeviceAttributeMultiprocessorCount, dev);
        (void)hipFuncSetAttribute((const void*)mega, hipFuncAttributeMaxDynamicSharedMemorySize, LDS_BYTES);
        (void)hipOccupancyMaxActiveBlocksPerMultiprocessor(&per_cu, (const void*)mega, 512, LDS_BYTES);
        if (per_cu < 1) per_cu = 1;
        grid = cus * per_cu;
        if (ws_size < O_END2) fprintf(stderr, "kernel_launch: workspace too small: %zu < %zu\n", ws_size, (size_t)O_END2);
    }
    (void)hipMemsetAsync((unsigned char*)d_ws + O_BARW, 0, 2 * 16384, stream);
    Args a{};
    for (int i = 0; i < 31 && i < n_in; ++i) a.in[i] = (GAS const float*)d_in[i];
    a.out = (GAS float*)d_out; a.ws = (GAS unsigned char*)d_ws; a.ph_lo = 0; a.ph_hi = NPHASE; a.sub = 7;
    void* args[] = {&a};
    hipError_t e = hipLaunchCooperativeKernel((const void*)mega, dim3(grid), dim3(512), args, LDS_BYTES, stream);
    if (e != hipSuccess) fprintf(stderr, "cooperative launch failed: %s (grid %d)\n", hipGetErrorString(e), grid);
    if (PROBE_LO >= 0) { Args b2 = a; b2.ph_lo = PROBE_LO; b2.ph_hi = PROBE_HI; b2.sub = PROBE_SUB; b2.bar_region = 1; void* args2[] = {&b2};
        (void)hipLaunchCooperativeKernel((const void*)mega, dim3(grid), dim3(512), args2, LDS_BYTES, stream); }
}
```
